# Optimizing an MI355X kernel written in HIP

```python
import math
import jax, jax.numpy as jnp
from jax import lax
import numpy as np

D_MODEL = 1024
BATCH = 2
SEQ = 8192
DEPTH = 1

ATTN_HEADS = 8
ATTN_QK_DIM = 64
ATTN_V_DIM = 2 * ATTN_QK_DIM
ATTN_QK_COLS = ATTN_HEADS * 2 * ATTN_QK_DIM
ATTN_WIDTH = ATTN_HEADS * ATTN_V_DIM
ROPE_DIM = ATTN_QK_DIM // 4
ROPE_THETA = 500000.0
Q_BLOCK = 128
SSD_INNER = 2 * D_MODEL
SSD_HEAD_DIM = 64
SSD_HEADS = SSD_INNER // SSD_HEAD_DIM
SSD_GROUPS = 4
SSD_STATE = 128
SSD_CONV = 4
SSD_CHUNK = 128
SSD_CONV_CH = SSD_INNER + 2 * SSD_GROUPS * SSD_STATE
N_EXPERTS = 256
TOP_K = 8
N_EXPERT_GROUPS = 8
TOPK_GROUPS = 4
EXPERT_FF = 256
SHARED_FF = 256
ROUTED_SCALE = 2.5
MOE_BLOCK = 128
NORM_EPS = 1e-6
IN_SIZES = (ATTN_QK_COLS, ATTN_QK_COLS, ATTN_WIDTH, SSD_INNER, SSD_CONV_CH, SSD_HEADS, 2 * D_MODEL)
IN_COLS = int(sum(IN_SIZES))
IN_SPLITS = [int(s) for s in np.cumsum(IN_SIZES)[:-1]]

kernel_name = 'hybrid_diffattn_ssd_moe_block'


def rms_norm(x, gain):
    xf = x.astype(jnp.float32)
    y = xf * lax.rsqrt(jnp.mean(xf * xf, axis=-1, keepdims=True) + NORM_EPS)
    return (y * gain.astype(jnp.float32)).astype(x.dtype)


def partial_rope(t, positions):
    half = ROPE_DIM // 2
    inv_freq = 1.0 / (ROPE_THETA ** (jnp.arange(0, ROPE_DIM, 2, dtype=jnp.float32) / ROPE_DIM))
    ang = positions.astype(jnp.float32)[..., None] * inv_freq
    cos = jnp.cos(ang)[:, :, None, None, :]
    sin = jnp.sin(ang)[:, :, None, None, :]
    r1 = t[..., :half].astype(jnp.float32)
    r2 = t[..., half:ROPE_DIM].astype(jnp.float32)
    rot = jnp.concatenate([r1 * cos - r2 * sin, r2 * cos + r1 * sin], axis=-1).astype(t.dtype)
    return jnp.concatenate([rot, t[..., ROPE_DIM:]], axis=-1)


def diff_attention(q, k, v, lam, head_gain, lambda_init):
    bsz, seq = q.shape[0], q.shape[1]
    nq = seq // Q_BLOCK
    scale = ATTN_QK_DIM ** -0.5
    qb = jnp.moveaxis(q.reshape(bsz, nq, Q_BLOCK, ATTN_HEADS, 2, ATTN_QK_DIM), 1, 0)
    key_pos = jnp.arange(seq)

    def one_block(args):
        q_blk, blk = args
        s = jnp.einsum('bqhcd,bkhcd->bhcqk', q_blk, k, preferred_element_type=jnp.float32) * scale
        q_pos = blk * Q_BLOCK + jnp.arange(Q_BLOCK)
        mask = key_pos[None, :] <= q_pos[:, None]
        p = jax.nn.softmax(jnp.where(mask, s, -jnp.inf), axis=-1)
        a = p[:, :, 0] - lam * p[:, :, 1]
        return jnp.einsum('bhqk,bkhd->bqhd', a.astype(v.dtype), v)

    o = lax.map(one_block, (qb, jnp.arange(nq)))
    o = jnp.moveaxis(o, 0, 1).reshape(bsz, seq, ATTN_HEADS, ATTN_V_DIM)
    o = rms_norm(o, head_gain) * (1.0 - lambda_init)
    return o.reshape(bsz, seq, ATTN_WIDTH)


def causal_depthwise_conv(u, w, b):
    out = lax.conv_general_dilated(u, w[:, None, :], window_strides=(1,), padding=[(SSD_CONV - 1, 0)],
                                   dimension_numbers=('NWC', 'WIO', 'NWC'), feature_group_count=u.shape[-1])
    return out + b


def ssd_scan(xh, dt, a_neg, b_in, c_in):
    bsz, seq = xh.shape[0], xh.shape[1]
    nc = seq // SSD_CHUNK
    e = SSD_HEADS // SSD_GROUPS

    def chunks(t):
        return jnp.moveaxis(t.reshape(bsz, nc, SSD_CHUNK, *t.shape[2:]), 1, 0)

    xdt = (xh.astype(jnp.float32) * dt[..., None]).reshape(bsz, seq, SSD_GROUPS, e, SSD_HEAD_DIM)
    a = (dt * a_neg).reshape(bsz, seq, SSD_GROUPS, e)
    causal = jnp.tril(jnp.ones((SSD_CHUNK, SSD_CHUNK), dtype=bool))

    def step(state, inp):
        x_c, a_c, b_c, c_c = inp
        a_cum = lax.cumsum(a_c, axis=1)
        seg = a_cum[:, :, None] - a_cum[:, None, :]
        decay = jnp.exp(jnp.where(causal[None, :, :, None, None], seg, -jnp.inf))
        cb = jnp.einsum('blgn,bsgn->blsg', c_c, b_c)
        y_diag = jnp.einsum('blsg,blsge,bsgep->blgep', cb, decay, x_c)
        y_off = jnp.einsum('blgn,bgepn,blge->blgep', c_c, state, jnp.exp(a_cum))
        to_end = jnp.exp(a_cum[:, -1:] - a_cum)
        new_state = (state * jnp.exp(a_cum[:, -1])[..., None, None]
                     + jnp.einsum('blgn,blge,blgep->bgepn', b_c, to_end, x_c))
        return new_state, y_diag + y_off

    state0 = jnp.zeros((bsz, SSD_GROUPS, e, SSD_HEAD_DIM, SSD_STATE), jnp.float32)
    _, y = lax.scan(step, state0, (chunks(xdt), chunks(a), chunks(b_in.astype(jnp.float32)),
                                   chunks(c_in.astype(jnp.float32))))
    return jnp.moveaxis(y, 0, 1).reshape(bsz, seq, SSD_HEADS, SSD_HEAD_DIM)


def route(h, w_router, router_bias):
    n = h.shape[0]
    scores = jax.nn.sigmoid(jnp.einsum('nd,de->ne', h, w_router, preferred_element_type=jnp.float32))
    choice = scores + router_bias.astype(jnp.float32)
    per_group = N_EXPERTS // N_EXPERT_GROUPS
    group_score = lax.top_k(choice.reshape(n, N_EXPERT_GROUPS, per_group), 2)[0].sum(-1)
    _, top_groups = lax.top_k(group_score, TOPK_GROUPS)
    group_mask = jnp.any(top_groups[..., None] == jnp.arange(N_EXPERT_GROUPS), axis=-2)
    masked = jnp.where(jnp.repeat(group_mask, per_group, axis=-1), choice, -jnp.inf)
    _, idx = lax.top_k(masked, TOP_K)
    w = jnp.take_along_axis(scores, idx, axis=-1)
    w = w / (jnp.sum(w, axis=-1, keepdims=True) + 1e-20) * ROUTED_SCALE
    return idx, w


def routed_experts(h, idx, wts, w_gate, w_up, w_down):
    n, d = h.shape
    n_pairs = n * TOP_K
    n_blocks = -(-n_pairs // MOE_BLOCK) + N_EXPERTS
    flat_e = idx.reshape(-1)
    flat_t = jnp.arange(n_pairs, dtype=jnp.int32) // TOP_K
    flat_w = wts.reshape(-1)
    order = jnp.argsort(flat_e)
    e_sorted = flat_e[order]
    counts = jnp.bincount(flat_e, length=N_EXPERTS)
    padded = (counts + MOE_BLOCK - 1) // MOE_BLOCK * MOE_BLOCK
    padded_end = jnp.cumsum(padded)
    padded_start = padded_end - padded
    start = jnp.cumsum(counts) - counts
    dest = padded_start[e_sorted] + jnp.arange(n_pairs) - start[e_sorted]
    slots = n_blocks * MOE_BLOCK
    slot_tok = jnp.full((slots,), n, jnp.int32).at[dest].set(flat_t[order])
    slot_w = jnp.zeros((slots,), h.dtype).at[dest].set(flat_w[order].astype(h.dtype))
    block_e = jnp.minimum(jnp.searchsorted(padded_end, jnp.arange(n_blocks) * MOE_BLOCK, side='right'),
                          N_EXPERTS - 1)
    h_pad = jnp.concatenate([h, jnp.zeros((1, d), h.dtype)], axis=0)

    def step(acc, inp):
        tok, wt, e = inp
        xb = h_pad[tok]
        y = (jax.nn.silu(xb @ w_gate[e]) * (xb @ w_up[e])) @ w_down[e]
        return acc.at[tok].add(y * wt[:, None]), None

    acc, _ = lax.scan(step, jnp.zeros((n + 1, d), h.dtype),
                      (slot_tok.reshape(n_blocks, MOE_BLOCK), slot_w.reshape(n_blocks, MOE_BLOCK), block_e))
    return acc[:n]


def swiglu(h, wg, wu, wd):
    return (jax.nn.silu(h @ wg) * (h @ wu)) @ wd


def setup_inputs(seed: int = 0) -> dict:
    key = jax.random.key(seed)
    ks = jax.random.split(key, 32)
    f32 = jnp.float32
    L = DEPTH

    def nrm(k, shape, scale):
        return jax.random.normal(k, shape, f32) * scale

    dt0 = jnp.exp(jax.random.uniform(ks[14], (L, SSD_HEADS), f32, math.log(1e-3), math.log(1e-1)))
    return {
        'x': nrm(ks[0], (BATCH, SEQ, D_MODEL), 1.0),
        'c': nrm(ks[1], (BATCH, D_MODEL), 1.0),
        'positions': jnp.broadcast_to(jnp.arange(SEQ, dtype=jnp.int32), (BATCH, SEQ)),
        'w_ada': nrm(ks[2], (L, D_MODEL, 6 * D_MODEL), 0.5 * D_MODEL ** -0.5),
        'b_ada': nrm(ks[3], (L, 6 * D_MODEL), 0.02),
        'norm_mix': 1.0 + nrm(ks[4], (L, D_MODEL), 0.02),
        'w_in': nrm(ks[5], (L, D_MODEL, IN_COLS), D_MODEL ** -0.5),
        'b_gate': nrm(ks[6], (L, 2 * D_MODEL), 0.02),
        'lambda_q1': nrm(ks[7], (L, ATTN_QK_DIM), 0.1),
        'lambda_k1': nrm(ks[8], (L, ATTN_QK_DIM), 0.1),
        'lambda_q2': nrm(ks[9], (L, ATTN_QK_DIM), 0.1),
        'lambda_k2': nrm(ks[10], (L, ATTN_QK_DIM), 0.1),
        'attn_head_norm': 1.0 + nrm(ks[11], (L, ATTN_V_DIM), 0.02),
        'conv_w': nrm(ks[12], (L, SSD_CONV, SSD_CONV_CH), SSD_CONV ** -0.5),
        'conv_b': nrm(ks[13], (L, SSD_CONV_CH), 0.02),
        'dt_bias': dt0 + jnp.log(-jnp.expm1(-dt0)),
        'a_log': jnp.log(jax.random.uniform(ks[15], (L, SSD_HEADS), f32, 1.0, 16.0)),
        'd_skip': 1.0 + nrm(ks[16], (L, SSD_HEADS), 0.02),
        'ssd_norm': 1.0 + nrm(ks[17], (L, SSD_INNER), 0.02),
        'w_branch_attn': nrm(ks[18], (L, ATTN_WIDTH, D_MODEL), ATTN_WIDTH ** -0.5),
        'w_branch_ssd': nrm(ks[19], (L, SSD_INNER, D_MODEL), SSD_INNER ** -0.5),
        'w_out': nrm(ks[20], (L, D_MODEL, D_MODEL), D_MODEL ** -0.5),
        'norm_ffn': 1.0 + nrm(ks[21], (L, D_MODEL), 0.02),
        'w_router': nrm(ks[22], (L, D_MODEL, N_EXPERTS), D_MODEL ** -0.5),
        'router_bias': nrm(ks[23], (L, N_EXPERTS), 0.01),
        'w_exp_gate': nrm(ks[24], (L, N_EXPERTS, D_MODEL, EXPERT_FF), D_MODEL ** -0.5),
        'w_exp_up': nrm(ks[25], (L, N_EXPERTS, D_MODEL, EXPERT_FF), D_MODEL ** -0.5),
        'w_exp_down': nrm(ks[26], (L, N_EXPERTS, EXPERT_FF, D_MODEL), EXPERT_FF ** -0.5),
        'w_sh_gate': nrm(ks[27], (L, D_MODEL, SHARED_FF), D_MODEL ** -0.5),
        'w_sh_up': nrm(ks[28], (L, D_MODEL, SHARED_FF), D_MODEL ** -0.5),
        'w_sh_down': nrm(ks[29], (L, SHARED_FF, D_MODEL), SHARED_FF ** -0.5),
        'norm_final': 1.0 + nrm(ks[30], (D_MODEL,), 0.02),
    }


def reference(x, c, positions, w_ada, b_ada, norm_mix, w_in, b_gate, lambda_q1, lambda_k1, lambda_q2,
              lambda_k2, attn_head_norm, conv_w, conv_b, dt_bias, a_log, d_skip, ssd_norm, w_branch_attn,
              w_branch_ssd, w_out, norm_ffn, w_router, router_bias, w_exp_gate, w_exp_up, w_exp_down,
              w_sh_gate, w_sh_up, w_sh_down, norm_final):
    bsz, seq, d = x.shape
    for l in range(DEPTH):
        mod = jax.nn.silu(c) @ w_ada[l] + b_ada[l]
        shift_m, scale_m, gate_m, shift_f, scale_f, gate_f = jnp.split(mod[:, None, :], 6, axis=-1)

        h = rms_norm(x, norm_mix[l]) * (1.0 + scale_m) + shift_m
        proj = h @ w_in[l]
        q, k, v, z, xbc, dt_raw, gates = jnp.split(proj, IN_SPLITS, axis=-1)

        q = partial_rope(q.reshape(bsz, seq, ATTN_HEADS, 2, ATTN_QK_DIM), positions)
        k = partial_rope(k.reshape(bsz, seq, ATTN_HEADS, 2, ATTN_QK_DIM), positions)
        v = v.reshape(bsz, seq, ATTN_HEADS, ATTN_V_DIM)
        lambda_init = 0.8 - 0.6 * math.exp(-0.3 * l)
        lam = (jnp.exp(jnp.sum(lambda_q1[l].astype(jnp.float32) * lambda_k1[l].astype(jnp.float32)))
               - jnp.exp(jnp.sum(lambda_q2[l].astype(jnp.float32) * lambda_k2[l].astype(jnp.float32)))
               + lambda_init)
        y_attn = diff_attention(q, k, v, lam, attn_head_norm[l], lambda_init)

        xbc = jax.nn.silu(causal_depthwise_conv(xbc, conv_w[l], conv_b[l]))
        xs, b_in, c_in = jnp.split(xbc, [SSD_INNER, SSD_INNER + SSD_GROUPS * SSD_STATE], axis=-1)
        dt = jax.nn.softplus(dt_raw.astype(jnp.float32) + dt_bias[l].astype(jnp.float32))
        a_neg = -jnp.exp(a_log[l].astype(jnp.float32))
        xh = xs.reshape(bsz, seq, SSD_HEADS, SSD_HEAD_DIM)
        y = ssd_scan(xh, dt, a_neg, b_in.reshape(bsz, seq, SSD_GROUPS, SSD_STATE),
                     c_in.reshape(bsz, seq, SSD_GROUPS, SSD_STATE))
        y = y + d_skip[l].astype(jnp.float32)[:, None] * xh.astype(jnp.float32)
        y = y.reshape(bsz, seq, SSD_INNER) * jax.nn.silu(z.astype(jnp.float32))
        y = rms_norm(y.reshape(bsz, seq, SSD_GROUPS, SSD_INNER // SSD_GROUPS),
                     ssd_norm[l].reshape(SSD_GROUPS, SSD_INNER // SSD_GROUPS))
        y_ssd = y.reshape(bsz, seq, SSD_INNER).astype(x.dtype)

        g_attn, g_ssd = jnp.split(jax.nn.sigmoid(gates + b_gate[l]), 2, axis=-1)
        mixed = g_attn * (y_attn @ w_branch_attn[l]) + g_ssd * (y_ssd @ w_branch_ssd[l])
        x = x + gate_m * (mixed @ w_out[l])

        h2 = rms_norm(x, norm_ffn[l]) * (1.0 + scale_f) + shift_f
        flat = h2.reshape(bsz * seq, d)
        idx, wts = route(flat, w_router[l], router_bias[l])
        routed = routed_experts(flat, idx, wts, w_exp_gate[l], w_exp_up[l], w_exp_down[l])
        shared = swiglu(flat, w_sh_gate[l], w_sh_up[l], w_sh_down[l])
        x = x + gate_f * (routed + shared).reshape(bsz, seq, d)
    return rms_norm(x, norm_final)
```

```cpp
#include <hip/hip_runtime.h>
#include <hip/hip_bf16.h>
#include <cstdio>
#include <cstdint>
#include <cmath>

#ifndef MK_N_LAUNCHES
#define MK_N_LAUNCHES 1
#endif

#ifndef MK_DUPMASK
#define MK_DUPMASK 0
#endif

#define LAS __attribute__((address_space(3)))
#define GAS __attribute__((address_space(1)))
typedef unsigned short bf16;
typedef unsigned v4u __attribute__((ext_vector_type(4)));
typedef unsigned v2u __attribute__((ext_vector_type(2)));
typedef float f32x4 __attribute__((ext_vector_type(4)));
typedef float f32x2 __attribute__((ext_vector_type(2)));
typedef short bf16x8 __attribute__((ext_vector_type(8)));
typedef short s16x4 __attribute__((ext_vector_type(4)));
typedef GAS unsigned gu32;
typedef GAS unsigned long long gu64;
#define RLX_AGENT __ATOMIC_RELAXED, __HIP_MEMORY_SCOPE_AGENT
#define LDS_WAIT() asm volatile("s_waitcnt lgkmcnt(0)" ::: "memory")
#define VM_WAIT() asm volatile("s_waitcnt vmcnt(0)" ::: "memory")

constexpr int BATCH = 2, SEQ = 8192, D = 1024, M = BATCH * SEQ;
constexpr int IN_COLS = 10272, NIN = 10496;
constexpr int NEXP = 256, TOPK = 8, EFF = 256;
constexpr int NPAIR = M * TOPK;
constexpr int MAXTILES = NPAIR / 256 + NEXP;
constexpr float EPS = 1e-6f;
constexpr float LAMBDA_INIT = 0.2f;
constexpr float QSCALE = 0.125f * 1.4426950408889634f;

constexpr size_t MiB = 1u << 20;
constexpr size_t WS_CTL = 0, CTL_ZERO_BYTES = 1 * MiB;
constexpr size_t WS_WIN = 2 * MiB;
constexpr size_t WS_WA = 23 * MiB;
constexpr size_t WS_WS = 25 * MiB;
constexpr size_t WS_WO = 29 * MiB;
constexpr size_t WS_WRS = 31 * MiB;
constexpr size_t WS_WSHD = 33 * MiB;
constexpr size_t WS_MOD = 34 * MiB;
constexpr size_t WS_CS = 35 * MiB;
constexpr size_t WS_WEGU = 36 * MiB;
constexpr size_t WS_WED = 292 * MiB;
constexpr size_t WS_H = 420 * MiB;
constexpr size_t WS_Q = 452 * MiB, WS_K = 484 * MiB, WS_V = 516 * MiB;
constexpr size_t WS_YCAT = 452 * MiB;
constexpr size_t WS_YA = 420 * MiB;
constexpr size_t WS_MIXED = 676 * MiB;
constexpr size_t WS_ZS = 548 * MiB;
constexpr size_t WS_TMP = 548 * MiB;
constexpr size_t WS_XBC = 612 * MiB;
constexpr size_t WS_O = 612 * MiB;
constexpr size_t WS_GATES = 708 * MiB;
constexpr size_t WS_DT = 772 * MiB;
constexpr size_t WS_ACUM = 774 * MiB;
constexpr size_t WS_XS = 776 * MiB;
constexpr size_t WS_BC = 840 * MiB;
constexpr size_t WS_CHST = 872 * MiB;
constexpr size_t WS_STIN = 936 * MiB;
constexpr size_t WS_LOGITS = 452 * MiB;
constexpr size_t WS_HS = 468 * MiB;
constexpr size_t WS_SHARED = 476 * MiB;
constexpr size_t WS_LIST = 508 * MiB;
constexpr size_t WS_PAIRW = 524 * MiB;
constexpr size_t WS_HE = 548 * MiB;
constexpr size_t WS_YPAIR = 644 * MiB;
constexpr size_t WS_X1H = 776 * MiB;
constexpr size_t WS_RSTD = 1000 * MiB;
constexpr size_t WS_END = 1001 * MiB;
constexpr int CW_TMO = 0, CW_CODE = 1;
constexpr int CW_BAR = 4096;
constexpr int CW_CNT = 16384;
constexpr int CW_LAM = 17000;
constexpr int CW_QCONV = 18432;

constexpr int RING_BYTES = 131072;
constexpr int TAB_OFF = RING_BYTES;
constexpr int TAB_BYTES = 12800;
constexpr int LDSCTL_OFF = TAB_OFF + TAB_BYTES, MISC_OFF = LDSCTL_OFF + 64;
constexpr int LDS_BYTES = 147456;
static_assert(MISC_OFF + 128 <= LDS_BYTES, "LDS map");
constexpr int NWAVES = 8;

__device__ __forceinline__ unsigned f2bf(float f) { unsigned u = __builtin_bit_cast(unsigned, f); return (u + 0x7fffu + ((u >> 16) & 1u)) >> 16; }
typedef float f32x2_t_ __attribute__((ext_vector_type(2))); typedef __bf16 bf16x2_t_ __attribute__((ext_vector_type(2)));
__device__ __forceinline__ unsigned pk2(float lo, float hi) { f32x2_t_ v = {lo, hi}; bf16x2_t_ b = __builtin_convertvector(v, bf16x2_t_); return __builtin_bit_cast(unsigned, b); }
__device__ __forceinline__ float bf2f(unsigned short h) { return __builtin_bit_cast(float, (unsigned)h << 16); }
__device__ __forceinline__ float bflo(unsigned w) { return __builtin_bit_cast(float, w << 16); }
__device__ __forceinline__ float bfhi(unsigned w) { return __builtin_bit_cast(float, w & 0xffff0000u); }
__device__ __forceinline__ float silu_f(float v) { return v * __builtin_amdgcn_rcpf(1.f + __expf(-v)); }
__device__ __forceinline__ float sigmoid_f(float v) { return __builtin_amdgcn_rcpf(1.f + __expf(-v)); }
__device__ __forceinline__ float softplus_f(float v) { return fmaxf(v, 0.f) + log1pf(__expf(-fabsf(v))); }
__device__ __forceinline__ int lane_id() { int l; asm volatile("v_mbcnt_lo_u32_b32 %0, -1, 0\n\tv_mbcnt_hi_u32_b32 %0, -1, %0" : "=v"(l)); return l; }
__device__ __forceinline__ float wave_sum(float v) {
#pragma unroll
    for (int o = 1; o < 64; o <<= 1) v += __shfl_xor(v, o);
    return v;
}
namespace pg8 {
#define PG8_LAS __attribute__((address_space(3)))
typedef unsigned short bf16_t;
typedef short bf16x8 __attribute__((ext_vector_type(8)));
typedef float f32x4 __attribute__((ext_vector_type(4)));
typedef unsigned u32x4 __attribute__((ext_vector_type(4)));
constexpr int BM = 256, BK = 64, HALF = 128, HTB = HALF * BK * 2  , STAGE_BYTES = 8 * HTB, NXCD = 8, WGM = 8;

__host__ __device__ __forceinline__ int lds_byte(int r, int c) { const int st = (r >> 4) * 2 + (c >> 5), rr = r & 15, cc = c & 31, ob = rr * 64 + cc * 2; return st * 1024 + (ob ^ (((ob >> 9) & 1) << 5)); }
__host__ __device__ __forceinline__ void stage_rc(int b, int& R, int& C) { const int st = b / 1024, sb = b % 1024, swz = sb ^ (((sb >> 9) & 1) << 5); R = (st >> 1) * 16 + swz / 64; C = (st & 1) * 32 + (swz % 64) / 2; }
__host__ __device__ __forceinline__ int perm32(int rho) { const int n = rho >> 4, i = rho & 15; return 8 * (i >> 2) + 4 * n + (i & 3); }

struct Unit { int pm, pn, aux, ui; };
struct GemmDesc { int lda, ldb, K; };

struct GridOrder {
    const char* A; const char* Bt; size_t tstepA, tstepB;
    int nM, nN, nwg, G, c;
    static constexpr bool GATHER = false;
    __device__ __forceinline__ void init(const void* A_, const void* Bt_, int lda, int ldb, int M, int N, int G_, int c_) {
        A = (const char*)A_; Bt = (const char*)Bt_; tstepA = (size_t)BM * lda * 2; tstepB = (size_t)BM * ldb * 2; nM = M / BM; nN = N / BM; nwg = nM * nN; G = G_; c = c_; }
    __device__ __forceinline__ bool next(int i, Unit& u) const {
        const long L = (long)i * G + c; if (L >= nwg) return false;
        int wgid = (int)L; { const int q = nwg / NXCD, r = nwg % NXCD, xcd = wgid % NXCD, off = wgid / NXCD; wgid = (xcd < r ? xcd * (q + 1) : r * (q + 1) + (xcd - r) * q) + off; }
        const int nig = WGM * nN, gid = wgid / nig, fm = gid * WGM, gsz = (nM - fm) < WGM ? (nM - fm) : WGM;
        u.pm = fm + ((wgid % nig) % gsz); u.pn = (wgid % nig) / gsz; u.aux = 0; u.ui = i; return true;
    }
    __device__ __forceinline__ const char* abase(const Unit& u) const { return A + (size_t)u.pm * tstepA; }
    __device__ __forceinline__ const char* bbase(const Unit& u) const { return Bt + (size_t)u.pn * tstepB; }
    __device__ __forceinline__ unsigned rowoff(int, int) const { return 0u; }
    __device__ __forceinline__ bool full(const Unit&) const { return true; }
};

__device__ __forceinline__ unsigned cvt_pk_bf16(float lo, float hi) { unsigned r; asm volatile("v_cvt_pk_bf16_f32 %0, %1, %2" : "=v"(r) : "v"(lo), "v"(hi)); return r; }

struct NoHook { static constexpr bool ON = false; __device__ __forceinline__ void operator()(f32x4 (&)[2][2][4][2], int, int) const {} };
template <class Epi, class Sched, bool ALIGN_EPI, class Hook = NoHook>
__device__ __forceinline__ void gemm_phase(PG8_LAS unsigned char* lds, const GemmDesc g, const Sched& S, const Epi& E, int wave_, const Hook H = Hook()) {
    const int lane = lane_id(), wid = wave_, tid = wid * 64 + lane,
              wr = wid >> 2, wc = wid & 3, fr = lane & 15, fq = lane >> 4;
    int K = g.K; asm volatile("" : "+s"(K)); const int nt = K / BK;
    constexpr bool GATHER = Sched::GATHER;
    unsigned voffA0[2], voffA1[2], voffB0[2], voffB1[2], nvA0[2], nvA1[2]; int Rr[2]; unsigned Cb[2];
#pragma unroll
    for (int i = 0; i < 2; ++i) { int R, C; stage_rc(tid * 16 + i * 8192, R, C); const int Rb = ((R & ~31) + perm32(R & 31));
        Rr[i] = R; Cb[i] = (unsigned)C * 2u;
        voffA0[i] = (unsigned)(R * g.lda + C) * 2u; voffA1[i] = voffA0[i] + (unsigned)(HALF * g.lda) * 2u;
        voffB0[i] = (unsigned)(Rb * g.ldb + C) * 2u; voffB1[i] = voffB0[i] + (unsigned)(HALF * g.ldb) * 2u;
        nvA0[i] = voffA0[i]; nvA1[i] = voffA1[i]; }
    const size_t kstep = (size_t)(BK * 2);
    const unsigned ldsw = (unsigned)wid * 1024u;
    const int aoff = lds_byte(wr * 64 + fr, fq * 8), boff = lds_byte(wc * 32 + fr, fq * 8);
#define PG8_SA(b, h) (((b) * 2 + (h)) * HTB)
#define PG8_SB(b, h) ((4 + (b) * 2 + (h)) * HTB)
#define PG8_STAGE(bufoff, gbase, voff) do { _Pragma("unroll") for (int _i = 0; _i < 2; ++_i) \
        __builtin_amdgcn_global_load_lds((const unsigned*)((const char*)(gbase) + (voff)[_i]), (PG8_LAS unsigned*)(lds + (bufoff) + ldsw + _i * 8192), 16, 0, 0); } while (0)
#define PG8_LDA(dst, b, h) do { _Pragma("unroll") for (int m = 0; m < 4; ++m) _Pragma("unroll") for (int k = 0; k < 2; ++k) dst[m][k] = *(const PG8_LAS bf16x8*)(lds + PG8_SA(b, h) + aoff + m * 2048 + k * 1024); } while (0)
#define PG8_LDB(dst, b, h) do { _Pragma("unroll") for (int n = 0; n < 2; ++n) _Pragma("unroll") for (int k = 0; k < 2; ++k) dst[n][k] = *(const PG8_LAS bf16x8*)(lds + PG8_SB(b, h) + boff + n * 2048 + k * 1024); } while (0)
#define PG8_MMA(ai, bj, At, Bt) do { __builtin_amdgcn_s_setprio(1); _Pragma("unroll") for (int m = 0; m < 4; ++m) _Pragma("unroll") for (int n = 0; n < 2; ++n) _Pragma("unroll") for (int k = 0; k < 2; ++k) \
        acc[ai][bj][m][n] = __builtin_amdgcn_mfma_f32_16x16x32_bf16(Bt[n][k], At[m][k], acc[ai][bj][m][n], 0, 0, 0); __builtin_amdgcn_s_setprio(0); } while (0)
#define PG8_WAIT_V(n) asm volatile("s_waitcnt vmcnt(" #n ")" ::: "memory")
#define PG8_WAIT_L(n) asm volatile("s_waitcnt lgkmcnt(" #n ")" ::: "memory")
#define PG8_BAR __builtin_amdgcn_s_barrier()
#define PG8_SCHED __builtin_amdgcn_sched_barrier(0)
    Unit cur, nxt; int ui = 0;
    if (!S.next(0, cur)) return;
    if constexpr (GATHER) {
#pragma unroll
        for (int i = 0; i < 2; ++i) { voffA0[i] = S.rowoff(0, Rr[i]) + Cb[i]; voffA1[i] = S.rowoff(0, HALF + Rr[i]) + Cb[i]; }
    }
    f32x4 acc[2][2][4][2];
#pragma unroll
    for (int a = 0; a < 2; ++a)
#pragma unroll
        for (int b = 0; b < 2; ++b)
#pragma unroll
            for (int m = 0; m < 4; ++m)
#pragma unroll
                for (int n = 0; n < 2; ++n) acc[a][b][m][n] = (f32x4){0.f, 0.f, 0.f, 0.f};
    bf16x8 At[4][2], B0[2][2], B1[2][2];
    const char* cA = S.abase(cur); const char* cB = S.bbase(cur);
    PG8_STAGE(PG8_SB(0, 0), cB, voffB0); PG8_STAGE(PG8_SB(0, 1), cB, voffB1); PG8_STAGE(PG8_SA(0, 0), cA, voffA0); PG8_STAGE(PG8_SA(0, 1), cA, voffA1);
    if (wr == 1) PG8_BAR;
    PG8_WAIT_V(2); PG8_BAR;
    PG8_STAGE(PG8_SB(1, 0), cB + kstep, voffB0); PG8_STAGE(PG8_SA(1, 0), cA + kstep, voffA0); PG8_STAGE(PG8_SB(1, 1), cB + kstep, voffB1);
    PG8_WAIT_V(6); PG8_BAR;
    for (;;) {
        const bool has_next = S.next(ui + 1, nxt);
        const char* nA = has_next ? S.abase(nxt) : cA; const char* nB = has_next ? S.bbase(nxt) : cB;
        if constexpr (GATHER) {
            if (has_next) {
#pragma unroll
                for (int i = 0; i < 2; ++i) { nvA0[i] = S.rowoff(ui + 1, Rr[i]) + Cb[i]; nvA1[i] = S.rowoff(ui + 1, HALF + Rr[i]) + Cb[i]; }
            } else {
#pragma unroll
                for (int i = 0; i < 2; ++i) { nvA0[i] = voffA0[i]; nvA1[i] = voffA1[i]; }
            }
        }
        for (int t = 0; t < nt; t += 2) {
            if constexpr (Hook::ON) H(acc, t, wr);
            const bool last = (t == nt - 2);
            const char* a1 = cA + (size_t)(t + 1) * kstep;
            const char* a2 = last ? nA : cA + (size_t)(t + 2) * kstep; const char* b2 = last ? nB : cB + (size_t)(t + 2) * kstep;
            const char* a3 = a2 + kstep; const char* b3 = b2 + kstep;
            unsigned sA0[2], sA1[2];
#pragma unroll
            for (int i = 0; i < 2; ++i) { sA0[i] = (GATHER && last) ? nvA0[i] : voffA0[i]; sA1[i] = (GATHER && last) ? nvA1[i] : voffA1[i]; }
            PG8_LDB(B0, 0, 0); PG8_LDB(B1, 0, 1); PG8_SCHED; PG8_LDA(At, 0, 0); PG8_STAGE(PG8_SA(1, 1), a1, voffA1);
            PG8_WAIT_V(8); PG8_WAIT_L(0); PG8_BAR; PG8_MMA(0, 0, At, B0); PG8_MMA(0, 1, At, B1); PG8_BAR; PG8_SCHED;
            PG8_LDA(At, 0, 1); PG8_STAGE(PG8_SB(0, 0), b2, voffB0); PG8_STAGE(PG8_SB(0, 1), b2, voffB1); PG8_STAGE(PG8_SA(0, 0), a2, sA0);
            PG8_WAIT_V(8); PG8_WAIT_L(0); PG8_BAR; PG8_MMA(1, 0, At, B0); PG8_MMA(1, 1, At, B1); PG8_BAR; PG8_SCHED;
            PG8_LDB(B0, 1, 0); PG8_LDB(B1, 1, 1); PG8_SCHED; PG8_LDA(At, 1, 0); PG8_STAGE(PG8_SA(0, 1), a2, sA1);
            PG8_WAIT_V(8); PG8_WAIT_L(0); PG8_BAR; PG8_MMA(0, 0, At, B0); PG8_MMA(0, 1, At, B1); PG8_BAR; PG8_SCHED;
            PG8_LDA(At, 1, 1); PG8_STAGE(PG8_SB(1, 0), b3, voffB0); PG8_STAGE(PG8_SB(1, 1), b3, voffB1); PG8_STAGE(PG8_SA(1, 0), a3, sA0);
            PG8_WAIT_V(8); PG8_WAIT_L(0); PG8_BAR; PG8_MMA(1, 0, At, B0); PG8_MMA(1, 1, At, B1); PG8_BAR; PG8_SCHED;
        }
        if constexpr (ALIGN_EPI) { if (wr == 0) PG8_BAR; }
        E(acc, cur, wr, wc, fr, fq);
        if (!has_next) break;
#pragma unroll
        for (int a = 0; a < 2; ++a)
#pragma unroll
            for (int b = 0; b < 2; ++b)
#pragma unroll
                for (int m = 0; m < 4; ++m)
#pragma unroll
                    for (int n = 0; n < 2; ++n) acc[a][b][m][n] = (f32x4){0.f, 0.f, 0.f, 0.f};
        cur = nxt; cA = nA; cB = nB; ++ui;
        if constexpr (GATHER) {
#pragma unroll
            for (int i = 0; i < 2; ++i) { voffA0[i] = nvA0[i]; voffA1[i] = nvA1[i]; }
        }
        if constexpr (ALIGN_EPI) { if (wr == 1) PG8_BAR; }
    }
    PG8_WAIT_V(0);
    if constexpr (!ALIGN_EPI) { if (wr == 0) PG8_BAR; }
    PG8_BAR;
#undef PG8_SA
#undef PG8_SB
#undef PG8_STAGE
#undef PG8_LDA
#undef PG8_LDB
#undef PG8_MMA
#undef PG8_WAIT_V
#undef PG8_WAIT_L
#undef PG8_BAR
#undef PG8_SCHED
}
}
namespace attn_body {
using bf16=__hip_bfloat16;
using bf16x8=__attribute__((ext_vector_type(8)))short;
using s16x4=__attribute__((ext_vector_type(4)))short;
using f32x16=__attribute__((ext_vector_type(16)))float;
using u32x4=__attribute__((ext_vector_type(4)))unsigned;
constexpr int BATCH=2,NHEAD=16,SEQ=8192,D=64,DM=NHEAD*D;
constexpr int NW=8,QBLK=32,QB=QBLK*NW,KVBLK=64,NQB=SEQ/QB;
constexpr int ATTN_PITCH=DM, ATTN_UNIT_ROWS=QB, OPITCH=2048;
__device__ __forceinline__ int crow(int r,int hi){return (r&3)+8*(r>>2)+4*hi;}
#define SBAR() __builtin_amdgcn_sched_barrier(0)
__device__ __forceinline__ void cmask(f32x16&p0,f32x16&p1,int jb,int qrel,int hi){
  const float NEG=-INFINITY; int dq=qrel-(64*jb+4*hi); asm volatile("":"+v"(dq));
  #pragma unroll
  for(int r=0;r<16;++r){const int cr=(r&3)+8*(r>>2); if(cr>dq)p0[r]=NEG; if(cr+32>dq)p1[r]=NEG;}
}

constexpr int NSLOT=3, SLOTB=8192;
constexpr int VSLOTB=2*SLOTB;
constexpr int LDS_K=0, LDS_V=NSLOT*SLOTB, LDS_WS=LDS_V+NSLOT*VSLOTB, LDS_OST=LDS_WS+NW*64*4, LDS_BYTES=LDS_OST+NW*4096;
constexpr float C2=0.125f*1.4426950408889634f;
__device__ __forceinline__ void glds16(const void*gsrc,unsigned lds_dst){unsigned keep;
  asm volatile("s_mov_b32 %0, m0\n\ts_mov_b32 m0, %2\n\ts_nop 0\n\tglobal_load_lds_dwordx4 %1, off\n\ts_mov_b32 m0, %0":"=&s"(keep):"v"(gsrc),"s"(lds_dst):"memory");}
__device__ __forceinline__ float max3f(float a,float b,float c){float r;asm("v_max3_f32 %0, %1, %2, %3":"=v"(r):"v"(a),"v"(b),"v"(c));return r;}
__device__ __forceinline__ float max2f(float a,float b){float r;asm("v_max_f32_e32 %0, %1, %2":"=v"(r):"v"(a),"v"(b));return r;}
__device__ __forceinline__ float fadd_s(float a,float b){float r;asm("v_add_f32_e32 %0, %1, %2":"=v"(r):"v"(a),"v"(b));return r;}
__device__ __forceinline__ float fsub_s(float a,float b){float r;asm("v_sub_f32_e32 %0, %1, %2":"=v"(r):"v"(a),"v"(b));return r;}
typedef float f32x2_t __attribute__((ext_vector_type(2))); typedef __bf16 bf16x2_t __attribute__((ext_vector_type(2)));
__device__ __forceinline__ unsigned cvtpk_s(float lo,float hi){f32x2_t v={lo,hi};bf16x2_t b=__builtin_convertvector(v,bf16x2_t);return __builtin_bit_cast(unsigned,b);}
#define WAIT_BAR(N) asm volatile("s_waitcnt vmcnt(" #N ") lgkmcnt(0)\n\ts_barrier":::"memory")

__device__ __forceinline__ void qkt(f32x16&p0,f32x16&p1,const char*Kslot,const bf16x8*qr,const f32x16&negm,int r32,int hi){
  const char*kb=Kslot+hi*1024+r32*16;
  #pragma unroll
  for(int d0=0;d0<4;++d0){
    const bf16x8 b0=*reinterpret_cast<const bf16x8*>(kb+d0*2048);
    const bf16x8 b1=*reinterpret_cast<const bf16x8*>(kb+d0*2048+512);
    if(d0==0){p0=__builtin_amdgcn_mfma_f32_32x32x16_bf16(b0,qr[0],negm,0,0,0);p1=__builtin_amdgcn_mfma_f32_32x32x16_bf16(b1,qr[0],negm,0,0,0);}
    else{p0=__builtin_amdgcn_mfma_f32_32x32x16_bf16(b0,qr[d0],p0,0,0,0);p1=__builtin_amdgcn_mfma_f32_32x32x16_bf16(b1,qr[d0],p1,0,0,0);}}
}
typedef __attribute__((address_space(3))) const char* lds_cptr;
typedef short v4i16_t __attribute__((ext_vector_type(4)));
__device__ __forceinline__ void kload8(bf16x8*kf,lds_cptr kp){
  kf[0]=*(const __attribute__((address_space(3))) bf16x8*)(kp);      kf[1]=*(const __attribute__((address_space(3))) bf16x8*)(kp+512);
  kf[2]=*(const __attribute__((address_space(3))) bf16x8*)(kp+2048); kf[3]=*(const __attribute__((address_space(3))) bf16x8*)(kp+2560);
  kf[4]=*(const __attribute__((address_space(3))) bf16x8*)(kp+4096); kf[5]=*(const __attribute__((address_space(3))) bf16x8*)(kp+4608);
  kf[6]=*(const __attribute__((address_space(3))) bf16x8*)(kp+6144); kf[7]=*(const __attribute__((address_space(3))) bf16x8*)(kp+6656);
}
__device__ __forceinline__ void kload2(bf16x8*kf,lds_cptr kp,int j){ kf[2*j]=*(const __attribute__((address_space(3))) bf16x8*)(kp+j*2048); kf[2*j+1]=*(const __attribute__((address_space(3))) bf16x8*)(kp+j*2048+512); }
__device__ __forceinline__ s16x4 vtr(lds_cptr p){ return __builtin_bit_cast(s16x4,__builtin_amdgcn_ds_read_tr16_b64_v4i16((__attribute__((address_space(3))) v4i16_t*)p)); }
__device__ __forceinline__ float rowmax(const f32x16&p0,const f32x16&p1){
  float a=max3f(p0[0],p0[1],p1[0]),b=max3f(p0[2],p0[3],p1[1]);a=max3f(a,p1[2],p1[3]);
  #pragma unroll
  for(int r=4;r<16;r+=4){a=max3f(a,p0[r],p0[r+1]);b=max3f(b,p0[r+2],p0[r+3]);a=max3f(a,p1[r],p1[r+1]);b=max3f(b,p1[r+2],p1[r+3]);}
  const float m=max2f(a,b);
  auto rr=__builtin_amdgcn_permlane32_swap(__float_as_uint(m),__float_as_uint(m),false,false);
  return max2f(__uint_as_float(rr[0]),__uint_as_float(rr[1]));
}
__device__ __forceinline__ void pv(f32x16*o,int vb,bf16x8 pa0,bf16x8 pa1,bf16x8 pa2,bf16x8 pa3){
  #pragma unroll
  for(int d0=0;d0<4;++d0){s16x4 lo[4],hi[4];
    #pragma unroll
    for(int ks=0;ks<4;++ks){
      asm volatile("ds_read_b64_tr_b16 %0,%1 offset:%c2":"=&v"(lo[ks]):"v"(vb),"i"(d0*4096+ks*1024):"memory");
      asm volatile("ds_read_b64_tr_b16 %0,%1 offset:%c2":"=&v"(hi[ks]):"v"(vb),"i"(d0*4096+ks*1024+512):"memory");}
    asm volatile("s_waitcnt lgkmcnt(0)":::"memory");SBAR();
    #define PK(k) (bf16x8){lo[k][0],lo[k][1],lo[k][2],lo[k][3],hi[k][0],hi[k][1],hi[k][2],hi[k][3]}
    o[d0]=__builtin_amdgcn_mfma_f32_32x32x16_bf16(pa0,PK(0),o[d0],0,0,0);
    o[d0]=__builtin_amdgcn_mfma_f32_32x32x16_bf16(pa1,PK(1),o[d0],0,0,0);
    o[d0]=__builtin_amdgcn_mfma_f32_32x32x16_bf16(pa2,PK(2),o[d0],0,0,0);
    o[d0]=__builtin_amdgcn_mfma_f32_32x32x16_bf16(pa3,PK(3),o[d0],0,0,0);
    #undef PK
  }
}

#ifndef ATTN_STORE16
#define ATTN_STORE16(p,v) (*(u32x4*)(p)=(v))
#endif
template<int THRL,bool COMB> __device__ __forceinline__ void attn_unit(int b,int cq,int cv,int co,int qb,const bf16*Q,const bf16*__restrict__ K,const bf16*__restrict__ V,bf16*O,char*shm,float lam,const float*gain,bf16*YC,int yc,int wave_){
  const int lane=lane_id(),r32=lane&31,hi=lane>>5; const int wid=wave_; const int tid=wid*64+lane; (void)tid;
  const long rowbase=(long)b*SEQ; const int q0=qb*QB;
  const bf16*Qw=Q+(rowbase+q0+wid*QBLK)*DM+cq;
  const bf16*Kh=K+rowbase*DM+cq,*Vh=V+rowbase*DM+cv;
  const unsigned lds0=(unsigned)(uintptr_t)shm;
  float*wsf=(float*)(shm+LDS_WS)+wid*64;
  const bf16*ksrc=Kh+(long)lane*DM+wid*8;
  const bf16*vsrc=Vh+(long)(16*(wid&3)+(lane>>2))*DM+(wid>>2)*32+(lane&3)*8;
  const unsigned kdst=lds0+LDS_K+wid*1024, vdst=lds0+LDS_V+wid*1024;
  #define DMA_K(t,slot) glds16(ksrc+(long)(t)*KVBLK*DM,(unsigned)__builtin_amdgcn_readfirstlane(kdst+(slot)))
  #define DMA_V(t,slot) do{ glds16(vsrc+(long)(t)*KVBLK*DM,(unsigned)__builtin_amdgcn_readfirstlane(vdst+2*(slot))); glds16(vsrc+64+(long)(t)*KVBLK*DM,(unsigned)__builtin_amdgcn_readfirstlane(vdst+2*(slot)+8192)); }while(0)
  const char*Kbase=shm+LDS_K; bf16x8 kf[8];
  const lds_cptr shm3=(lds_cptr)shm; const lds_cptr kp0=shm3+LDS_K+hi*1024+r32*16; const lds_cptr vp0=shm3+LDS_V+((lane>>4)&1)*32+(lane&3)*8+(4*hi+((lane&15)>>2))*64;
  const int NT=(q0+QB)/KVBLK;
  DMA_K(0,0);DMA_V(0,0);DMA_K(1,SLOTB);
  bf16x8 qr[4];
  #pragma unroll
  for(int d0=0;d0<4;++d0)qr[d0]=*reinterpret_cast<const bf16x8*>(&Qw[(long)r32*DM+d0*16+hi*8]);
  float mhat=0.f,l_reg=0.f;f32x16 o[4];o[0]=f32x16{};o[1]=f32x16{};o[2]=f32x16{};o[3]=f32x16{};f32x16 negm=f32x16{};asm volatile("":"+v"(negm));
  const int qrel=wid*QBLK+r32;
  #define CMASK(P0,P1,t) do{int jb_=(t)-(NT-4); if(jb_>=0)cmask(P0,P1,jb_,qrel,hi);}while(0)
  bool resc=false;
  #define START(P0,P1) do{ const float rm=rowmax(P0,P1); resc=false; \
    { const float dl=rm; mhat=fadd_s(mhat,dl); \
      _Pragma("unroll") for(int r=0;r<16;++r){P0[r]=fsub_s(P0[r],dl);P1[r]=fsub_s(P1[r],dl);} \
      _Pragma("unroll") for(int r=0;r<16;++r)negm[r]=-mhat; asm volatile("":"+v"(negm)); } \
    _Pragma("unroll") for(int r=0;r<16;++r){P0[r]=__builtin_amdgcn_exp2f(P0[r]);P1[r]=__builtin_amdgcn_exp2f(P1[r]);} }while(0)
  #define RESC() do{ if(resc){ asm volatile("s_waitcnt lgkmcnt(0)":::"memory"); \
      _Pragma("unroll") for(int d_=0;d_<4;++d_) _Pragma("unroll") for(int r=0;r<16;++r)o[d_][r]*=wsf[crow(r,hi)]; } }while(0)
  f32x16 pA0,pA1,pB0,pB1;
  int sl_prev=0,sl_cur=0,sl_next=SLOTB;
  #define ROT() do{sl_prev=sl_cur;sl_cur=sl_next;sl_next=(sl_next==(NSLOT-1)*SLOTB)?0:sl_next+SLOTB;}while(0)
  DMA_K(2,2*SLOTB);
  WAIT_BAR(4);
  qkt(pA0,pA1,Kbase,qr,negm,r32,hi);asm volatile("s_nop 15\n\ts_nop 7":"+v"(pA0),"+v"(pA1));CMASK(pA0,pA1,0);
  START(pA0,pA1);
  WAIT_BAR(0);
  DMA_K(3,0);DMA_V(1,SLOTB);
  ROT();
  kload8(kf,kp0+sl_cur);
  WAIT_BAR(3);
  s16x4 vlo[4],vhi[4]; u32x4 pw0,pw1,pw2,pw3;
  #define PKW(P,B) cvtpk_s(P[B],P[B+1])
  #define PAF(k) __builtin_bit_cast(bf16x8,pw##k)
  #define VFR(i) (bf16x8){vlo[i][0],vlo[i][1],vlo[i][2],vlo[i][3],vhi[i][0],vhi[i][1],vhi[i][2],vhi[i][3]}
  #define PIN(x) asm volatile("":"+v"(x))
  #define MX3(a,b,c) __builtin_fmaxf(__builtin_fmaxf((a),(b)),(c))
  #define GAPA(MF,A0,A1,A2,A3,W0,W1,PW) do{ MF; sacc+=A0; sacc+=A1; sacc+=A2; sacc+=A3; PIN(sacc); W0; W1; PIN(PW); SBAR(); }while(0)
  #define EX(v) __builtin_amdgcn_exp2f(v)
  #define GAPB(MF,X,B) do{ MF; X[B]=EX(X[B]); X[B+1]=EX(X[B+1]); PIN(X); SBAR(); }while(0)
  #define VRD(sl,m) do{ vlo[sl]=vtr(vp_+((((m)&3))*4096+((m)>>2)*1024)); vhi[sl]=vtr(vp_+((((m)&3))*4096+((m)>>2)*1024+512)); }while(0)
  #define KRD(G,j) do{ if(G){ kload2(kf,kp0+sl_next,j); SBAR(); } }while(0)
  #define ZC (f32x16{})
  #define STEP(C0,C1,P0,P1,t,GK,GV,GL) do{ SBAR(); \
    const lds_cptr vp_=vp0+2*sl_prev; \
    float sacc=(P0[0]+P0[1]); \
    GAPA(C0=__builtin_amdgcn_mfma_f32_32x32x16_bf16(kf[0],qr[0],negm,0,0,0), P0[2],P0[3],P0[4],P0[5],     pw0[0]=PKW(P0,0), pw0[1]=PKW(P0,2), pw0); \
    GAPA(C1=__builtin_amdgcn_mfma_f32_32x32x16_bf16(kf[1],qr[0],negm,0,0,0), P0[6],P0[7],P0[8],P0[9],     pw0[2]=PKW(P0,4), pw0[3]=PKW(P0,6), pw0); \
    GAPA(C0=__builtin_amdgcn_mfma_f32_32x32x16_bf16(kf[2],qr[1],C0,0,0,0),   P0[10],P0[11],P0[12],P0[13], pw1[0]=PKW(P0,8), pw1[1]=PKW(P0,10), pw1); \
    GAPA(C1=__builtin_amdgcn_mfma_f32_32x32x16_bf16(kf[3],qr[1],C1,0,0,0),   P0[14],P0[15],P1[0],P1[1],   pw1[2]=PKW(P0,12),pw1[3]=PKW(P0,14), pw1); \
    GAPA(C0=__builtin_amdgcn_mfma_f32_32x32x16_bf16(kf[4],qr[2],C0,0,0,0),   P1[2],P1[3],P1[4],P1[5],     pw2[0]=PKW(P1,0), pw2[1]=PKW(P1,2), pw2); \
    GAPA(C1=__builtin_amdgcn_mfma_f32_32x32x16_bf16(kf[5],qr[2],C1,0,0,0),   P1[6],P1[7],P1[8],P1[9],     pw2[2]=PKW(P1,4), pw2[3]=PKW(P1,6), pw2); \
    GAPA(C0=__builtin_amdgcn_mfma_f32_32x32x16_bf16(kf[6],qr[3],C0,0,0,0),   P1[10],P1[11],P1[12],P1[13], pw3[0]=PKW(P1,8), pw3[1]=PKW(P1,10), pw3); \
    GAPA(C1=__builtin_amdgcn_mfma_f32_32x32x16_bf16(kf[7],qr[3],C1,0,0,0),   P1[14],P1[15],0.f,0.f,       pw3[2]=PKW(P1,12),pw3[3]=PKW(P1,14), pw3); \
    l_reg+=sacc; \
    VRD(0,0); VRD(1,1); VRD(2,2); VRD(3,3); SBAR(); \
    if(GK){DMA_K((t)+3,sl_cur);} if(GV){DMA_V((t)+1,sl_next);} \
    CMASK(C0,C1,t); \
    { float a=MX3(C0[0],C0[1],C1[0]),b=MX3(C0[2],C0[3],C1[1]); a=MX3(a,C1[2],C1[3]); \
      _Pragma("unroll") for(int r=4;r<16;r+=4){a=MX3(a,C0[r],C0[r+1]);b=MX3(b,C0[r+2],C0[r+3]);a=MX3(a,C1[r],C1[r+1]);b=MX3(b,C1[r+2],C1[r+3]);} \
      float rm=__builtin_fmaxf(a,b); { auto rr=__builtin_amdgcn_permlane32_swap(__float_as_uint(rm),__float_as_uint(rm),false,false); rm=__builtin_fmaxf(__uint_as_float(rr[0]),__uint_as_float(rr[1])); } \
      resc=false; \
      if(__builtin_expect(__any(rm>(float)THRL),0)){ const float dl=__builtin_fmaxf(rm,0.f); mhat+=dl; \
        _Pragma("unroll") for(int r=0;r<16;++r){C0[r]-=dl;C1[r]-=dl;} \
        _Pragma("unroll") for(int r=0;r<16;++r)negm[r]=-mhat; asm volatile("":"+v"(negm)); \
        const float f=__builtin_amdgcn_exp2f(-dl); l_reg*=f; if(hi==0)wsf[r32]=f; resc=true; } } \
    SBAR(); \
    GAPB(o[0]=__builtin_amdgcn_mfma_f32_32x32x16_bf16(PAF(0),VFR(0),o[0],0,0,0), C0,0);  VRD(0,4);  SBAR(); \
    GAPB(o[1]=__builtin_amdgcn_mfma_f32_32x32x16_bf16(PAF(0),VFR(1),o[1],0,0,0), C0,2);  VRD(1,5);  SBAR(); \
    GAPB(o[2]=__builtin_amdgcn_mfma_f32_32x32x16_bf16(PAF(0),VFR(2),o[2],0,0,0), C0,4);  VRD(2,6);  SBAR(); \
    GAPB(o[3]=__builtin_amdgcn_mfma_f32_32x32x16_bf16(PAF(0),VFR(3),o[3],0,0,0), C0,6);  VRD(3,7);  SBAR(); \
    GAPB(o[0]=__builtin_amdgcn_mfma_f32_32x32x16_bf16(PAF(1),VFR(0),o[0],0,0,0), C0,8);  VRD(0,8);  SBAR(); \
    GAPB(o[1]=__builtin_amdgcn_mfma_f32_32x32x16_bf16(PAF(1),VFR(1),o[1],0,0,0), C0,10);  VRD(1,9);  SBAR(); \
    KRD(GL,0); GAPB(o[2]=__builtin_amdgcn_mfma_f32_32x32x16_bf16(PAF(1),VFR(2),o[2],0,0,0), C0,12);  VRD(2,10);  SBAR(); \
    KRD(GL,1); GAPB(o[3]=__builtin_amdgcn_mfma_f32_32x32x16_bf16(PAF(1),VFR(3),o[3],0,0,0), C0,14);  VRD(3,11);  SBAR(); \
    KRD(GL,2); GAPB(o[0]=__builtin_amdgcn_mfma_f32_32x32x16_bf16(PAF(2),VFR(0),o[0],0,0,0), C1,0);  VRD(0,12);  SBAR(); \
    KRD(GL,3); GAPB(o[1]=__builtin_amdgcn_mfma_f32_32x32x16_bf16(PAF(2),VFR(1),o[1],0,0,0), C1,2);  VRD(1,13);  SBAR(); \
    GAPB(o[2]=__builtin_amdgcn_mfma_f32_32x32x16_bf16(PAF(2),VFR(2),o[2],0,0,0), C1,4);  VRD(2,14);  SBAR(); \
    GAPB(o[3]=__builtin_amdgcn_mfma_f32_32x32x16_bf16(PAF(2),VFR(3),o[3],0,0,0), C1,6);  VRD(3,15);  SBAR(); \
    GAPB(o[0]=__builtin_amdgcn_mfma_f32_32x32x16_bf16(PAF(3),VFR(0),o[0],0,0,0), C1,8); \
    GAPB(o[1]=__builtin_amdgcn_mfma_f32_32x32x16_bf16(PAF(3),VFR(1),o[1],0,0,0), C1,10); \
    GAPB(o[2]=__builtin_amdgcn_mfma_f32_32x32x16_bf16(PAF(3),VFR(2),o[2],0,0,0), C1,12); \
    GAPB(o[3]=__builtin_amdgcn_mfma_f32_32x32x16_bf16(PAF(3),VFR(3),o[3],0,0,0), C1,14); \
    }while(0)
  int t=1;
  #undef CMASK
  #define CMASK(P0,P1,t) do{}while(0)
  for(;t+5<NT;t+=2){
    STEP(pB0,pB1,pA0,pA1,t,true,true,true);     WAIT_BAR(3); RESC(); ROT();
    STEP(pA0,pA1,pB0,pB1,t+1,true,true,true);   WAIT_BAR(3); RESC(); ROT();
  }
  #undef CMASK
  #define CMASK(P0,P1,t) do{int jb_=(t)-(NT-4); if(jb_>=0)cmask(P0,P1,jb_,qrel,hi);}while(0)
  #define ENDW(tt) do{ if((tt)+3<NT){WAIT_BAR(3);} else if((tt)+2<NT){WAIT_BAR(2);} else {WAIT_BAR(0);} }while(0)
  for(;t+1<NT;t+=2){
    STEP(pB0,pB1,pA0,pA1,t,(t+3<NT),(t+1<NT),(t+1<NT));       ENDW(t);   RESC(); ROT();
    STEP(pA0,pA1,pB0,pB1,t+1,(t+4<NT),(t+2<NT),(t+2<NT));     ENDW(t+1); RESC(); ROT();
  }
  STEP(pB0,pB1,pA0,pA1,NT-1,false,false,false); RESC();
  { float sacc=pB0[0]+pB0[1]; _Pragma("unroll") for(int r=2;r<16;++r)sacc+=pB0[r]; _Pragma("unroll") for(int r=0;r<16;++r)sacc+=pB1[r]; l_reg+=sacc;
    pw0=(u32x4){PKW(pB0,0),PKW(pB0,2),PKW(pB0,4),PKW(pB0,6)};pw1=(u32x4){PKW(pB0,8),PKW(pB0,10),PKW(pB0,12),PKW(pB0,14)};pw2=(u32x4){PKW(pB1,0),PKW(pB1,2),PKW(pB1,4),PKW(pB1,6)};pw3=(u32x4){PKW(pB1,8),PKW(pB1,10),PKW(pB1,12),PKW(pB1,14)};
    const int le_=lane_id();
    const int vb0=(int)(lds0+LDS_V)+((le_>>4)&1)*32+(le_&3)*8+(4*(le_>>5)+((le_&15)>>2))*64;
    SBAR(); pv(o,vb0+2*sl_cur,PAF(0),PAF(1),PAF(2),PAF(3)); }
  #undef PKW
  #undef PAF
  #undef VFR
  #undef PIN
  #undef MX3
  #undef GAPA
  #undef GAPB
  #undef EX
  #undef VRD
  #undef KRD
  #undef ZC
  #undef STEP
  #undef ENDW
  {auto rr=__builtin_amdgcn_permlane32_swap(__float_as_uint(l_reg),__float_as_uint(l_reg),false,false);l_reg=__uint_as_float(rr[0])+__uint_as_float(rr[1]);}
  const int le=lane_id(); const int r32e=le&31,hie=le>>5;
  if(hie==0)wsf[32+r32e]=l_reg;asm volatile("s_waitcnt lgkmcnt(0)":::"memory");
  float rli[16];
  #pragma unroll
  for(int r=0;r<16;++r)rli[r]=__builtin_amdgcn_rcpf(wsf[32+crow(r,hie)]);
  bf16*Ow=O+(rowbase+q0+wid*QBLK)*OPITCH+co;
  { bf16*stg=(bf16*)(shm+LDS_OST)+wid*2048;
    float dd[2][4][8]; float ssq[4]={0.f,0.f,0.f,0.f};
    #pragma unroll
    for(int h2=0;h2<2;++h2){
      #pragma unroll
      for(int r=0;r<16;++r){const int orow=crow(r,hie);
        #pragma unroll
        for(int d0=0;d0<2;++d0)stg[orow*64+d0*32+r32e]=__float2bfloat16(o[2*h2+d0][r]*rli[r]);}
      asm volatile("s_waitcnt lgkmcnt(0)":::"memory");
      #pragma unroll
      for(int i=0;i<4;++i){const int row=i*8+(le>>3),ch=le&7; const u32x4 v=*(const u32x4*)(stg+row*64+ch*8);
        if(!COMB){ ATTN_STORE16(Ow+(long)row*OPITCH+h2*64+ch*8,v); }
        else{ const u32x4 w=*(const u32x4*)(Ow-128+(long)row*OPITCH+h2*64+ch*8);
          #pragma unroll
          for(int k=0;k<4;++k){ const float a0=__uint_as_float(w[k]<<16),a1=__uint_as_float(w[k]&0xffff0000u),b0=__uint_as_float(v[k]<<16),b1=__uint_as_float(v[k]&0xffff0000u);
            const float e0=a0-lam*b0,e1=a1-lam*b1; dd[h2][i][2*k]=e0; dd[h2][i][2*k+1]=e1; ssq[i]+=e0*e0+e1*e1; } } }
      asm volatile("s_waitcnt lgkmcnt(0)":::"memory"); }
    if(COMB){
      #pragma unroll
      for(int i=0;i<4;++i){ float sq=ssq[i]; sq+=__shfl_xor(sq,1); sq+=__shfl_xor(sq,2); sq+=__shfl_xor(sq,4);
        const float rs=0.8f/sqrtf(sq*(1.f/128.f)+1e-6f); const int row=i*8+(le>>3),ch=le&7;
        #pragma unroll
        for(int h2=0;h2<2;++h2){ const float*gp=gain+h2*64+ch*8; u32x4 y;
          #pragma unroll
          for(int k=0;k<4;++k) y[k]=cvtpk_s(dd[h2][i][2*k]*rs*gp[2*k],dd[h2][i][2*k+1]*rs*gp[2*k+1]);
          *(u32x4*)(YC+(rowbase+q0+wid*QBLK+row)*1024+yc+h2*64+ch*8)=y; } } } }
  asm volatile("s_waitcnt lgkmcnt(0)\n\ts_barrier":::"memory");
  #undef DMA_K
  #undef DMA_V
  #undef CMASK
  #undef START
  #undef RESC
  #undef ROT
}
constexpr int ATTN_LDS_BYTES=LDS_BYTES;
struct AttnTensors { const bf16* Q; const bf16* K; const bf16* V; bf16* O; float lam; const float* gain; bf16* YC; };
struct AttnUnit { int grp; int qb; };
struct StaticOrder {
  int vcu, G, bx;
  __device__ __forceinline__ explicit StaticOrder(int grid,int block):vcu((grid%8==0)?(block%8)*(grid/8)+block/8:block),G(grid),bx(block){}
  __device__ __forceinline__ bool next(int i,AttnUnit&u)const{
    if(G==256){ if(i>=2)return false; const int s=vcu&15; u.grp=vcu>>4; u.qb=(i==0)?s:31-s; return true; }
    const int idx=bx+i*G; if(idx>=512)return false; u.grp=idx>>5; u.qb=idx&31; return true; }
};
template<class Sched,int THRL=8> __device__ __forceinline__ void attn_phase(char*lds,const AttnTensors&T,const Sched&S,int wave_){
  AttnUnit u;
  for(int i=0;S.next(i,u);++i){ const int b=u.grp>>3,vh=(u.grp&7)*2;
    attn_unit<THRL,false>(b,vh*64,(vh>>1)*128,vh*128,u.qb,T.Q,T.K,T.V,T.O,lds,0.f,nullptr,nullptr,0,wave_);
    attn_unit<THRL,true>(b,(vh+1)*64,(vh>>1)*128,(vh+1)*128,u.qb,T.Q,T.K,T.V,T.O,lds,T.lam,T.gain,T.YC,(vh>>1)*128,wave_); }
}
#undef SBAR
#undef WAIT_BAR
}
#define XB_TMO      128
#define XB_XCNT(j)  (256  + 64 * (j))
#define XB_XSUB(j)  (1280 + 64 * (j))
#define XB_XGEN(j)  (2304 + 64 * (j))
#define XB_TOP      3328
#define XB_TOPGEN   3392
#define XCD_BAR_WORDS 3456
#define XB_SPIN_CAP (1u << 18)

__device__ __forceinline__ unsigned xb_ld(unsigned* p)              { return __hip_atomic_load(p, __ATOMIC_RELAXED, __HIP_MEMORY_SCOPE_AGENT); }
__device__ __forceinline__ unsigned xb_add(unsigned* p, unsigned v) { return __hip_atomic_fetch_add(p, v, __ATOMIC_RELAXED, __HIP_MEMORY_SCOPE_AGENT); }
__device__ __forceinline__ unsigned xb_xcc_id() { return (unsigned)__builtin_amdgcn_s_getreg((3 << 11) | 20) & 0xFu; }
#define XB_SPIN(cond, bar) do { unsigned _sp = 0; while (cond) { __builtin_amdgcn_s_sleep(1); \
    if ((++_sp & 255u) == 0u) { if (xb_ld(&(bar)[XB_TMO])) break; if (_sp > XB_SPIN_CAP) { atomicAdd(&(bar)[XB_TMO], 1u); break; } } } } while (0)

struct XcdBarrier {
    unsigned* bar; unsigned x;
    volatile LAS unsigned* st;
};

__device__ __forceinline__ XcdBarrier xcd_barrier_post(unsigned* bar, volatile LAS unsigned* st, bool leader) {
    XcdBarrier b; b.bar = bar; b.x = xb_xcc_id(); b.st = st;
    if (leader) (void)xb_add(&bar[XB_XCNT(b.x)], 1u);
    return b;
}
__device__ __forceinline__ void xcd_barrier_complete(unsigned* bar, unsigned x, unsigned& nloc, unsigned& nx) {
    const unsigned G = gridDim.x * gridDim.y * gridDim.z;
    unsigned sum, cnt, mine, sp = 0u;
    for (;;) {
        sum = 0u; cnt = 0u; mine = 0u;
#pragma unroll
        for (unsigned j = 0; j < 16; ++j) { const unsigned c = xb_ld(&bar[XB_XCNT(j)]); sum += c; cnt += (c > 0u) ? 1u : 0u; mine = (j == x) ? c : mine; }
        if (sum == G) break;
        __builtin_amdgcn_s_sleep(1);
        if ((++sp & 255u) == 0u) { if (xb_ld(&bar[XB_TMO])) break; if (sp > XB_SPIN_CAP) { atomicAdd(&bar[XB_TMO], 1u); break; } }
    }
    nloc = mine > 0u ? mine : 1u; nx = cnt > 0u ? cnt : 1u;
}

__device__ __forceinline__ void xcd_barrier(const XcdBarrier& b, bool leader) {
    asm volatile("s_waitcnt vmcnt(0)" ::: "memory");
    __syncthreads();
    if (leader) {
        unsigned* bar = b.bar;
        __builtin_amdgcn_s_waitcnt(0);
        unsigned nloc = b.st[0], nx = b.st[1];
        if (nloc == 0u) { xcd_barrier_complete(bar, b.x, nloc, nx); b.st[0] = nloc; b.st[1] = nx; }
        const unsigned old = xb_add(&bar[XB_XSUB(b.x)], 1u);
        const unsigned gen = old / nloc;
        if (old + 1u == (gen + 1u) * nloc) {
            __builtin_amdgcn_fence(__ATOMIC_RELEASE, "agent");
            asm volatile("s_waitcnt vmcnt(0)" ::: "memory");
            const unsigned og = xb_add(&bar[XB_TOP], 1u);
            const unsigned tg = og / nx;
            if (og + 1u == (tg + 1u) * nx) xb_add(&bar[XB_TOPGEN], 1u);
            else XB_SPIN(xb_ld(&bar[XB_TOPGEN]) == tg, bar);
            __builtin_amdgcn_fence(__ATOMIC_ACQUIRE, "agent");
            xb_add(&bar[XB_XGEN(b.x)], 1u);
            asm volatile("s_waitcnt vmcnt(0)" ::: "memory");
        } else {
            XB_SPIN(xb_ld(&bar[XB_XGEN(b.x)]) == gen, bar);
            __builtin_amdgcn_fence(__ATOMIC_ACQUIRE, "agent");
            asm volatile("s_waitcnt vmcnt(0)" ::: "memory");
        }
    }
    __syncthreads();
}
struct Args { const void* in[32]; float* out; unsigned char* ws; int ph_lo, ph_hi, G, pad; };
typedef const __attribute__((address_space(4))) Args* KA;
__device__ __forceinline__ KA ka_fresh() { KA p = (KA)__builtin_amdgcn_kernarg_segment_ptr(); asm volatile("" : "+s"(p)); return p; }
__device__ __forceinline__ int tid_fresh(int wave) { return wave * 64 + lane_id(); }
#define INF(k) ((const float*)a->in[k])
enum { I_X = 0, I_C, I_POS, I_WADA, I_BADA, I_NMIX, I_WIN, I_BGATE, I_LQ1, I_LK1, I_LQ2, I_LK2, I_HNORM, I_CONVW, I_CONVB, I_DTB, I_ALOG, I_DSKIP, I_SSDN,
       I_WBA, I_WBS, I_WOUT, I_NFFN, I_WR, I_RB, I_WEG, I_WEU, I_WED, I_WSG, I_WSU, I_WSD, I_NFIN };

__device__ __forceinline__ void ph0_mod(KA a, LAS unsigned char* lds, int tid) {
    const float* c = INF(I_C); const float* w_ada = INF(I_WADA); const float* b_ada = INF(I_BADA); float* mod = (float*)(a->ws + WS_MOD);
    LAS float* scr = (LAS float*)lds;
    for (int wg = blockIdx.x; wg < 192; wg += gridDim.x) {
        const int kg = tid >> 3, cq = tid & 7;
        f32x4 a0 = {0.f, 0.f, 0.f, 0.f}, a1 = {0.f, 0.f, 0.f, 0.f};
#pragma unroll 4
        for (int it = 0; it < 16; ++it) { const int k = kg + 64 * it; const f32x4 w = *(const f32x4*)(w_ada + (size_t)k * 6144 + 32 * wg + 4 * cq);
            const float s0 = silu_f(c[k]), s1 = silu_f(c[1024 + k]); a0 += s0 * w; a1 += s1 * w; }
        *(LAS f32x4*)(scr + (kg * 8 + cq) * 8) = a0; *(LAS f32x4*)(scr + (kg * 8 + cq) * 8 + 4) = a1;
        __syncthreads();
        if (tid < 64) { const int b = tid >> 5, col = tid & 31; float s = 0.f;
            for (int g = 0; g < 64; ++g) s += scr[(g * 8 + (col >> 2)) * 8 + b * 4 + (col & 3)];
            mod[b * 6144 + 32 * wg + col] = s + b_ada[32 * wg + col]; }
        __syncthreads();
    }
}
__device__ __forceinline__ void ph0_misc(KA a, gu32* ctl, int gtid, int gthreads) {
    const int* pos = (const int*)a->in[I_POS]; float* cs = (float*)(a->ws + WS_CS);
    const float invf[8] = {1.0f, 0.193922758102417f, 0.03760603070259094f, 0.00729266507551074f, 0.001414213445968926f, 0.00027424818836152554f, 5.318296462064609e-05f, 1.0313385246263351e-05f};
    for (int it = gtid; it < M * 8; it += gthreads) {
        const int tok = it >> 3, i = it & 7;
        float f = invf[0];
#pragma unroll
        for (int j = 1; j < 8; ++j) f = (i == j) ? invf[j] : f;
        const float ang = (float)pos[tok] * f;
        const double ad = (double)ang; const double kk = rint(ad * 0.15915494309189535); const float r = (float)(ad - kk * 6.283185307179586);
        cs[tok * 16 + i] = __cosf(r); cs[tok * 16 + 8 + i] = __sinf(r);
    }
    if (gtid == 0) {
        float s1 = 0.f, s2 = 0.f;
        for (int i = 0; i < 64; ++i) { s1 += INF(I_LQ1)[i] * INF(I_LK1)[i]; s2 += INF(I_LQ2)[i] * INF(I_LK2)[i]; }
        const float lam = expf(s1) - expf(s2) + LAMBDA_INIT;
        ctl[CW_LAM] = __builtin_bit_cast(unsigned, lam);
    }
}
struct TrDesc { const float* src; bf16* dst; const float* ksc; int ldw, ldo; };
__device__ __forceinline__ int gu_row(int n0, int is_up) { return (n0 < 128 ? n0 : 256 + (n0 - 128)) + (is_up ? 128 : 0); }
constexpr int TR_I1 = 16 * 321, TR_I2 = 16 * 32, TR_I3 = 32 * 32, TR_I4 = 16 * 32, TR_I5 = 16 * 8, TR_I5B = 16 * 8, TR_I6 = 2 * 16 * 8, TR_I7 = 4 * 32, TR_I8 = 256 * 2 * 16 * 8, TR_I9 = 256 * 4 * 32;
constexpr int TR_NSMALL = TR_I1 + TR_I2 + TR_I3 + TR_I4 + TR_I5 + TR_I5B + TR_I6 + TR_I7;
constexpr int TR_NITEMS = TR_NSMALL + TR_I8 + TR_I9;
__device__ __forceinline__ TrDesc tr_decode(KA a, int it) {
    unsigned char* ws = a->ws; TrDesc d; int r = it;
#define TRD(W_, ldw_, k0_, n0_, WT_, ldo_, orow_) do { d.src = (W_) + (size_t)(k0_) * (ldw_) + (n0_); d.ldw = (ldw_); d.dst = (WT_) + (size_t)(orow_) * (ldo_) + (k0_); d.ldo = (ldo_); d.ksc = nullptr; return d; } while (0)
    if (r < TR_I1) { const int kb = r / 321, nb = r % 321, n0 = 32 * nb; const int orow = n0 < 8192 ? n0 : (n0 < 8224 ? 10240 : n0 - 32);
        TRD(INF(I_WIN), IN_COLS, 64 * kb, n0, (bf16*)(ws + WS_WIN), 1024, orow); } r -= TR_I1;
    if (r < TR_I2) TRD(INF(I_WBA), 1024, 64 * (r / 32), 32 * (r % 32), (bf16*)(ws + WS_WA), 1024, 32 * (r % 32)); r -= TR_I2;
    if (r < TR_I3) { const int k0 = 64 * (r / 32), n0 = 32 * (r % 32);
        d.src = INF(I_WBS) + (size_t)k0 * 1024 + n0; d.ldw = 1024; d.dst = (bf16*)(ws + WS_WS) + (size_t)n0 * 2048 + k0; d.ldo = 2048; d.ksc = INF(I_SSDN) + k0; return d; } r -= TR_I3;
    if (r < TR_I4) TRD(INF(I_WOUT), 1024, 64 * (r / 32), 32 * (r % 32), (bf16*)(ws + WS_WO), 1024, 32 * (r % 32)); r -= TR_I4;
    if (r < TR_I5) TRD(INF(I_WR), 256, 64 * (r / 8), 32 * (r % 8), (bf16*)(ws + WS_WRS), 1024, 32 * (r % 8)); r -= TR_I5;
    if (r < TR_I5B) TRD(INF(I_WR), 256, 64 * (r / 8), 32 * (r % 8), (bf16*)(ws + WS_WRS), 1024, 768 + 32 * (r % 8)); r -= TR_I5B;
    if (r < TR_I6) { const int up = r / 128, q = r % 128, n0 = 32 * (q % 8); TRD(up ? INF(I_WSU) : INF(I_WSG), 256, 64 * (q / 8), n0, (bf16*)(ws + WS_WRS), 1024, 256 + gu_row(n0, up)); } r -= TR_I6;
    if (r < TR_I7) TRD(INF(I_WSD), 1024, 64 * (r / 32), 32 * (r % 32), (bf16*)(ws + WS_WSHD), 256, 32 * (r % 32)); r -= TR_I7;
    if (r < TR_I8) { const int e = r / 256, q = r % 256, up = q / 128, q2 = q % 128, n0 = 32 * (q2 % 8);
        TRD((up ? INF(I_WEU) : INF(I_WEG)) + (size_t)e * 1024 * 256, 256, 64 * (q2 / 8), n0, (bf16*)(ws + WS_WEGU) + (size_t)e * 512 * 1024, 1024, gu_row(n0, up)); } r -= TR_I8;
    { const int e = r / 128, q = r % 128; TRD(INF(I_WED) + (size_t)e * 256 * 1024, 1024, 64 * (q / 32), 32 * (q % 32), (bf16*)(ws + WS_WED) + (size_t)e * 1024 * 256, 256, 32 * (q % 32)); }
#undef TRD
}
__device__ __forceinline__ void tr_load(const TrDesc& d, float (&v)[32], int lane) {
#pragma unroll
    for (int i = 0; i < 32; ++i) { const int kk = 2 * i + (lane >> 5); v[i] = __builtin_nontemporal_load(d.src + (size_t)kk * d.ldw + (lane & 31)); }
    if (d.ksc) {
#pragma unroll
        for (int i = 0; i < 32; ++i) v[i] *= d.ksc[2 * i + (lane >> 5)]; }
}
__device__ __forceinline__ void tr_store(const TrDesc& d, const float (&v)[32], LAS float* scr, int lane) {
#pragma unroll
    for (int i = 0; i < 32; ++i) { const int kk = 2 * i + (lane >> 5); scr[kk * 33 + (lane & 31)] = v[i]; }
    LDS_WAIT(); asm volatile("" ::: "memory");
    const int c = lane & 7;
#pragma unroll
    for (int j = 0; j < 4; ++j) { const int n = (lane >> 3) + 8 * j; const LAS float* s = scr + (8 * c) * 33 + n;
        v4u o; o.x = pk2(s[0 * 33], s[1 * 33]); o.y = pk2(s[2 * 33], s[3 * 33]); o.z = pk2(s[4 * 33], s[5 * 33]); o.w = pk2(s[6 * 33], s[7 * 33]);
        *(GAS v4u*)(d.dst + (size_t)n * d.ldo + 8 * c) = o; }
    LDS_WAIT(); asm volatile("" ::: "memory");
}
constexpr int HELPER_CUS = 64;
constexpr int TR_SPLIT = TR_I1;
__device__ __forceinline__ void ph0_weights(KA a, LAS unsigned char* lds, int gw, int NGW, int wave, int lane, int it_lo, int it_hi) {
    LAS float* scr = (LAS float*)(lds + wave * 16384);
    for (int it = it_lo + gw; it < it_hi; it += 4 * NGW) {
        const int i1 = it + NGW, i2 = it + 2 * NGW, i3 = it + 3 * NGW;
        const bool h1 = i1 < it_hi, h2 = i2 < it_hi, h3 = i3 < it_hi;
        const TrDesc d0 = tr_decode(a, it), d1 = tr_decode(a, h1 ? i1 : it), d2 = tr_decode(a, h2 ? i2 : it), d3 = tr_decode(a, h3 ? i3 : it);
        float v0[32], v1[32], v2[32], v3[32];
        tr_load(d0, v0, lane); tr_load(d1, v1, lane); tr_load(d2, v2, lane); tr_load(d3, v3, lane);
        tr_store(d0, v0, scr, lane);
        if (h1) tr_store(d1, v1, scr, lane);
        if (h2) tr_store(d2, v2, scr, lane);
        if (h3) tr_store(d3, v3, scr, lane);
    }
}
__device__ __forceinline__ void convert_queue(KA a, LAS unsigned char* lds, gu32* qhead, int wave, int lane, int it_lo, int it_hi) {
    LAS float* scr = (LAS float*)(lds + wave * 16384);
    for (;;) {
        unsigned got = 0u; if (lane == 0) got = __hip_atomic_fetch_add(qhead, 16u, RLX_AGENT);
        const int base = it_lo + (int)__builtin_amdgcn_readfirstlane((int)got);
        if (base >= it_hi) break;
        for (int it = base; it < base + 16 && it < it_hi; it += 4) {
            const int i1 = it + 1, i2 = it + 2, i3 = it + 3;
            const bool h1 = i1 < it_hi, h2 = i2 < it_hi, h3 = i3 < it_hi;
            const TrDesc d0 = tr_decode(a, it), d1 = tr_decode(a, h1 ? i1 : it), d2 = tr_decode(a, h2 ? i2 : it), d3 = tr_decode(a, h3 ? i3 : it);
            float v0[32], v1[32], v2[32], v3[32];
            tr_load(d0, v0, lane); tr_load(d1, v1, lane); tr_load(d2, v2, lane); tr_load(d3, v3, lane);
            tr_store(d0, v0, scr, lane);
            if (h1) tr_store(d1, v1, scr, lane);
            if (h2) tr_store(d2, v2, scr, lane);
            if (h3) tr_store(d3, v3, scr, lane);
        }
    }
}
__device__ __forceinline__ v4u pack8(const f32x4 v0, const f32x4 v1) { v4u w; w.x = pk2(v0[0], v0[1]); w.y = pk2(v0[2], v0[3]); w.z = pk2(v1[0], v1[1]); w.w = pk2(v1[2], v1[3]); return w; }
__device__ __forceinline__ void unpack8(const v4u w, float* f) { f[0] = bflo(w.x); f[1] = bfhi(w.x); f[2] = bflo(w.y); f[3] = bfhi(w.y); f[4] = bflo(w.z); f[5] = bfhi(w.z); f[6] = bflo(w.w); f[7] = bfhi(w.w); }
template <bool BF16IN> __device__ __forceinline__ void norm_rows(const void* xin_, const float* gain, const float* mod, int shift_off, int scale_off, bf16* out, int gw, int NGW, int lane) {
    for (int b = 0; b < BATCH; ++b) {
        f32x4 ga[4], sh[4];
#pragma unroll
        for (int q = 0; q < 4; ++q) { const int col = 8 * lane + 512 * (q >> 1) + 4 * (q & 1);
            const f32x4 g = *(const f32x4*)(gain + col), sc = *(const f32x4*)(mod + b * 6144 + scale_off + col); sh[q] = *(const f32x4*)(mod + b * 6144 + shift_off + col); ga[q] = g * (1.f + sc); }
        int m = gw; while (m < b * SEQ) m += NGW;
        const int mend = (b + 1) * SEQ;
        f32x4 v[4], nx[4];
#define NR_LOAD(m_) do { if (BF16IN) { _Pragma("unroll") for (int jj = 0; jj < 2; ++jj) { float t_[8]; unpack8(*(const GAS v4u*)((const bf16*)xin_ + (size_t)(m_) * D + 8 * lane + 512 * jj), t_); \
                nx[2 * jj] = (f32x4){t_[0], t_[1], t_[2], t_[3]}; nx[2 * jj + 1] = (f32x4){t_[4], t_[5], t_[6], t_[7]}; } } \
            else { _Pragma("unroll") for (int q = 0; q < 4; ++q) nx[q] = *(const GAS f32x4*)((const float*)xin_ + (size_t)(m_) * D + 8 * lane + 512 * (q >> 1) + 4 * (q & 1)); } } while (0)
        if (m < mend) NR_LOAD(m);
        for (; m < mend; m += NGW) {
            float s = 0.f;
#pragma unroll
            for (int q = 0; q < 4; ++q) { v[q] = nx[q]; s += (v[q].x * v[q].x + v[q].y * v[q].y) + (v[q].z * v[q].z + v[q].w * v[q].w); }
            if (m + NGW < mend) NR_LOAD(m + NGW);
            const float rstd = 1.f / sqrtf(wave_sum(s) * (1.f / D) + EPS);
#pragma unroll
            for (int jj = 0; jj < 2; ++jj) { const f32x4 y0 = v[2 * jj] * rstd * ga[2 * jj] + sh[2 * jj], y1 = v[2 * jj + 1] * rstd * ga[2 * jj + 1] + sh[2 * jj + 1];
                v4u o; o.x = pk2(y0.x, y0.y); o.y = pk2(y0.z, y0.w); o.z = pk2(y1.x, y1.y); o.w = pk2(y1.z, y1.w);
                *(GAS v4u*)(out + (size_t)m * D + 8 * lane + 512 * jj) = o; }
        }
#undef NR_LOAD
    }
}
using pg8::Unit;

struct EpiInProj {
    KA a0;
    __device__ __forceinline__ void operator()(const f32x4 (&acc)[2][2][4][2], const Unit& u, int wr, int wc, int fr, int fq) const {
        KA a = a0; asm volatile("" : "+s"(a));
        unsigned char* ws = a->ws;
        const int pn = u.pn; const int row0 = u.pm * 256 + wr * 64 + fr, tc0 = 32 * wc + 8 * fq;
        if (pn < 8) {
            bf16* dst = (bf16*)(ws + (pn < 4 ? WS_Q : WS_K)) + (pn & 3) * 256; const float sc = pn < 4 ? QSCALE : 1.f;
            if ((wc & 1) == 0) {
                const float* cs = (const float*)(ws + WS_CS);
                constexpr int KD = 2; f32x4 c0[KD + 1], c1[KD + 1], s0[KD + 1], s1[KD + 1]; const float sg = (fq == 0) ? -1.f : 1.f; const bool rot = fq < 2;
#define EPI_LD(ir) do { const float* p_ = cs + (size_t)(row0 + ((ir) >> 2) * 128 + ((ir) & 3) * 16) * 16; c0[(ir) % (KD + 1)] = *(const f32x4*)(p_); c1[(ir) % (KD + 1)] = *(const f32x4*)(p_ + 4); \
                    s0[(ir) % (KD + 1)] = *(const f32x4*)(p_ + 8); s1[(ir) % (KD + 1)] = *(const f32x4*)(p_ + 12); } while (0)
#pragma unroll
                for (int ir = 0; ir < KD; ++ir) EPI_LD(ir);
#pragma unroll
                for (int ir = 0; ir < 8; ++ir) {
                    if (ir + KD < 8) EPI_LD(ir + KD);
                    const int ai = ir >> 2, m = ir & 3; const int row = row0 + ai * 128 + m * 16;
                    f32x4 cc0 = c0[ir % (KD + 1)], cc1 = c1[ir % (KD + 1)], ss0 = s0[ir % (KD + 1)], ss1 = s1[ir % (KD + 1)];
#pragma unroll
                    for (int jj = 0; jj < 4; ++jj) { cc0[jj] = rot ? cc0[jj] : 1.f; cc1[jj] = rot ? cc1[jj] : 1.f; ss0[jj] = rot ? ss0[jj] * sg : 0.f; ss1[jj] = rot ? ss1[jj] * sg : 0.f; }
#pragma unroll
                    for (int bj = 0; bj < 2; ++bj) {
                        f32x4 v0 = acc[ai][bj][m][0], v1 = acc[ai][bj][m][1], o0, o1;
#pragma unroll
                        for (int jj = 0; jj < 4; ++jj) { o0[jj] = __shfl_xor(v0[jj], 16); o1[jj] = __shfl_xor(v1[jj], 16); }
                        v0 = (v0 * cc0 + o0 * ss0) * sc; v1 = (v1 * cc1 + o1 * ss1) * sc;
                        *(v4u*)(dst + (size_t)row * 1024 + 128 * bj + tc0) = pack8(v0, v1);
                    }
                }
#undef EPI_LD
            } else {
#pragma unroll
                for (int it = 0; it < 16; ++it) { const int ai = it >> 3, m = (it >> 1) & 3, bj = it & 1; const int row = row0 + ai * 128 + m * 16;
                    *(v4u*)(dst + (size_t)row * 1024 + 128 * bj + tc0) = pack8(acc[ai][bj][m][0] * sc, acc[ai][bj][m][1] * sc); }
            }
        } else if (pn < 12) {
            bf16* V = (bf16*)(ws + WS_V) + (pn - 8) * 256;
#pragma unroll
            for (int it = 0; it < 16; ++it) { const int ai = it >> 3, m = (it >> 1) & 3, bj = it & 1; const int row = row0 + ai * 128 + m * 16;
                *(v4u*)(V + (size_t)row * 1024 + 128 * bj + tc0) = pack8(acc[ai][bj][m][0], acc[ai][bj][m][1]); }
        } else if (pn < 20) {
            bf16* ZS = (bf16*)(ws + WS_ZS) + (pn - 12) * 256;
#pragma unroll
            for (int it = 0; it < 16; ++it) { const int ai = it >> 3, m = (it >> 1) & 3, bj = it & 1; const int row = row0 + ai * 128 + m * 16;
                f32x4 v0 = acc[ai][bj][m][0], v1 = acc[ai][bj][m][1];
#pragma unroll
                for (int jj = 0; jj < 4; ++jj) { v0[jj] = silu_f(v0[jj]); v1[jj] = silu_f(v1[jj]); }
                *(v4u*)(ZS + (size_t)row * 2048 + 128 * bj + tc0) = pack8(v0, v1); }
        } else if (pn < 32) {
            bf16* XBC = (bf16*)(ws + WS_XBC) + (pn - 20) * 256;
#pragma unroll
            for (int it = 0; it < 16; ++it) { const int ai = it >> 3, m = (it >> 1) & 3, bj = it & 1; const int row = row0 + ai * 128 + m * 16;
                *(v4u*)(XBC + (size_t)row * 3072 + 128 * bj + tc0) = pack8(acc[ai][bj][m][0], acc[ai][bj][m][1]); }
        } else if (pn < 40) {
            bf16* GATES = (bf16*)(ws + WS_GATES) + (pn - 32) * 256; const float* b_gate = INF(I_BGATE) + (pn - 32) * 256 + tc0;
            f32x4 bg[2][2];
#pragma unroll
            for (int bj = 0; bj < 2; ++bj) { bg[bj][0] = *(const f32x4*)(b_gate + 128 * bj); bg[bj][1] = *(const f32x4*)(b_gate + 128 * bj + 4); }
#pragma unroll
            for (int it = 0; it < 16; ++it) { const int ai = it >> 3, m = (it >> 1) & 3, bj = it & 1; const int row = row0 + ai * 128 + m * 16;
                f32x4 v0 = acc[ai][bj][m][0], v1 = acc[ai][bj][m][1];
#pragma unroll
                for (int jj = 0; jj < 4; ++jj) { v0[jj] = sigmoid_f(v0[jj] + bg[bj][0][jj]); v1[jj] = sigmoid_f(v1[jj] + bg[bj][1][jj]); }
                *(v4u*)(GATES + (size_t)row * 2048 + 128 * bj + tc0) = pack8(v0, v1); }
        } else {
            if (wc == 0) {
                float* DT = (float*)(ws + WS_DT); const float* dt_bias = INF(I_DTB);
                const f32x4 b0 = *(const f32x4*)(dt_bias + tc0), b1 = *(const f32x4*)(dt_bias + tc0 + 4);
#pragma unroll
                for (int ir = 0; ir < 8; ++ir) { const int ai = ir >> 2, m = ir & 3; const int row = row0 + ai * 128 + m * 16;
                    f32x4 v0 = acc[ai][0][m][0], v1 = acc[ai][0][m][1];
#pragma unroll
                    for (int jj = 0; jj < 4; ++jj) { v0[jj] = softplus_f(v0[jj] + b0[jj]); v1[jj] = softplus_f(v1[jj] + b1[jj]); }
                    *(f32x4*)(DT + (size_t)row * 32 + tc0) = v0; *(f32x4*)(DT + (size_t)row * 32 + tc0 + 4) = v1; }
            }
        }
    }
};
struct EpiMixA {
    KA a0;
    __device__ __forceinline__ void operator()(const f32x4 (&acc)[2][2][4][2], const Unit& u, int wr, int wc, int fr, int fq) const {
        KA a = a0; asm volatile("" : "+s"(a));
        unsigned char* ws = a->ws; bf16* TMP = (bf16*)(ws + WS_TMP); const bf16* GATES = (const bf16*)(ws + WS_GATES);
        const int row0 = u.pm * 256 + wr * 64 + fr;
#pragma unroll
        for (int ai = 0; ai < 2; ++ai)
#pragma unroll
            for (int m = 0; m < 4; ++m) { const int row = row0 + ai * 128 + m * 16;
#pragma unroll
                for (int bj = 0; bj < 2; ++bj) { const int col = u.pn * 256 + 128 * bj + 32 * wc + 8 * fq;
                    float g[8]; unpack8(*(const v4u*)(GATES + (size_t)row * 2048 + col), g);
                    f32x4 v0 = acc[ai][bj][m][0], v1 = acc[ai][bj][m][1];
#pragma unroll
                    for (int j = 0; j < 4; ++j) { v0[j] *= g[j]; v1[j] *= g[4 + j]; }
                    *(v4u*)(TMP + (size_t)row * 1024 + col) = pack8(v0, v1); } }
    }
};
struct HookGrp {
    static constexpr bool ON = true; LAS const float* rs;
    __device__ __forceinline__ void operator()(f32x4 (&acc)[2][2][4][2], int t, int wr) const {
        if (t == 8 || t == 16 || t == 24) {
            const int gi = (t >> 3) - 1; const int fr = lane_id() & 15;
#pragma unroll
            for (int ai = 0; ai < 2; ++ai)
#pragma unroll
                for (int m = 0; m < 4; ++m) { const int rl = ai * 128 + wr * 64 + m * 16 + fr; const float f = rs[rl * 4 + gi] * __builtin_amdgcn_rcpf(rs[rl * 4 + gi + 1]);
#pragma unroll
                    for (int bj = 0; bj < 2; ++bj) { acc[ai][bj][m][0] = acc[ai][bj][m][0] * f; acc[ai][bj][m][1] = acc[ai][bj][m][1] * f; } }
        }
    }
};
struct EpiMixB {
    KA a0; LAS const float* rs;
    __device__ __forceinline__ void operator()(const f32x4 (&acc)[2][2][4][2], const Unit& u, int wr, int wc, int fr, int fq) const {
        KA a = a0; asm volatile("" : "+s"(a));
        unsigned char* ws = a->ws; const bf16* TMP = (const bf16*)(ws + WS_TMP); const bf16* GATES = (const bf16*)(ws + WS_GATES); bf16* MIXED = (bf16*)(ws + WS_MIXED);
        const int row0 = u.pm * 256 + wr * 64 + fr;
#pragma unroll
        for (int ai = 0; ai < 2; ++ai)
#pragma unroll
            for (int m = 0; m < 4; ++m) { const int row = row0 + ai * 128 + m * 16; const float r3 = rs[(ai * 128 + wr * 64 + m * 16 + fr) * 4 + 3];
#pragma unroll
                for (int bj = 0; bj < 2; ++bj) { const int col = u.pn * 256 + 128 * bj + 32 * wc + 8 * fq;
                    float g[8]; unpack8(*(const v4u*)(GATES + (size_t)row * 2048 + 1024 + col), g);
                    float tt[8]; unpack8(*(const v4u*)(TMP + (size_t)row * 1024 + col), tt);
                    f32x4 v0 = acc[ai][bj][m][0], v1 = acc[ai][bj][m][1];
#pragma unroll
                    for (int j = 0; j < 4; ++j) { v0[j] = tt[j] + v0[j] * g[j] * r3; v1[j] = tt[4 + j] + v1[j] * g[4 + j] * r3; }
                    *(v4u*)(MIXED + (size_t)row * 1024 + col) = pack8(v0, v1); } }
    }
};
struct EpiOut {
    KA a0;
    __device__ __forceinline__ void operator()(const f32x4 (&acc)[2][2][4][2], const Unit& u, int wr, int wc, int fr, int fq) const {
        KA a = a0; asm volatile("" : "+s"(a));
        const float* X = INF(I_X); const float* mod = (const float*)(a->ws + WS_MOD); bf16* X1 = (bf16*)(a->ws + WS_X1H);
        const int row0 = u.pm * 256 + wr * 64 + fr; const int b = (u.pm * 256) >> 13;
#pragma unroll
        for (int bj = 0; bj < 2; ++bj) { const int col = u.pn * 256 + 128 * bj + 32 * wc + 8 * fq;
            const f32x4 g0 = *(const f32x4*)(mod + b * 6144 + 2048 + col), g1 = *(const f32x4*)(mod + b * 6144 + 2048 + col + 4);
#pragma unroll
            for (int ai = 0; ai < 2; ++ai)
#pragma unroll
                for (int m = 0; m < 4; ++m) { const int row = row0 + ai * 128 + m * 16;
                    const f32x4 x0 = *(const f32x4*)(X + (size_t)row * 1024 + col), x1 = *(const f32x4*)(X + (size_t)row * 1024 + col + 4);
                    *(v4u*)(X1 + (size_t)row * 1024 + col) = pack8(x0 + g0 * acc[ai][bj][m][0], x1 + g1 * acc[ai][bj][m][1]); } }
    }
};
struct EpiRS {
    KA a0;
    __device__ __forceinline__ void operator()(const f32x4 (&acc)[2][2][4][2], const Unit& u, int wr, int wc, int fr, int fq) const {
        KA a = a0; asm volatile("" : "+s"(a));
        unsigned char* ws = a->ws; float* LOGITS = (float*)(ws + WS_LOGITS); bf16* HS = (bf16*)(ws + WS_HS);
        const int row0 = u.pm * 256 + wr * 64 + fr;
#pragma unroll
        for (int ai = 0; ai < 2; ++ai)
#pragma unroll
            for (int m = 0; m < 4; ++m) { const int row = row0 + ai * 128 + m * 16;
                if (u.pn == 0 || u.pn == 3) {
                    if (ai == (u.pn == 3 ? 1 : 0)) {
#pragma unroll
                        for (int bj = 0; bj < 2; ++bj) { const int col = 128 * bj + 32 * wc + 8 * fq;
                            *(f32x4*)(LOGITS + (size_t)row * 256 + col) = acc[ai][bj][m][0]; *(f32x4*)(LOGITS + (size_t)row * 256 + col + 4) = acc[ai][bj][m][1]; } }
                } else {
                    f32x4 v0, v1;
#pragma unroll
                    for (int j = 0; j < 4; ++j) { v0[j] = silu_f(acc[ai][0][m][0][j]) * acc[ai][1][m][0][j]; v1[j] = silu_f(acc[ai][0][m][1][j]) * acc[ai][1][m][1][j]; }
                    *(v4u*)(HS + (size_t)row * 256 + (u.pn - 1) * 128 + 32 * wc + 8 * fq) = pack8(v0, v1);
                }
            }
    }
};
struct EpiStore {
    KA a0; size_t off; int ldc;
    __device__ __forceinline__ void operator()(const f32x4 (&acc)[2][2][4][2], const Unit& u, int wr, int wc, int fr, int fq) const {
        KA a = a0; asm volatile("" : "+s"(a));
        bf16* O = (bf16*)(a->ws + off);
        const int row0 = u.pm * 256 + wr * 64 + fr;
#pragma unroll
        for (int ai = 0; ai < 2; ++ai)
#pragma unroll
            for (int m = 0; m < 4; ++m) { const int row = row0 + ai * 128 + m * 16;
#pragma unroll
                for (int bj = 0; bj < 2; ++bj) *(v4u*)(O + (size_t)row * ldc + u.pn * 256 + 128 * bj + 32 * wc + 8 * fq) = pack8(acc[ai][bj][m][0], acc[ai][bj][m][1]); }
    }
};
struct MoeTab { LAS int* tile; LAS unsigned* rowoff; int ntiles; };
__device__ __forceinline__ int moe_build_tiles(gu32* ctl, LAS unsigned char* lds, LAS int* tile, int tid) {
    LAS int* sc = (LAS int*)lds;
    int nt = 0;
    if (tid < 256) { const int c = (int)__hip_atomic_load(ctl + CW_CNT + tid, RLX_AGENT); nt = (c + 255) >> 8; sc[tid] = nt; ((LAS int*)(lds + 2048))[tid] = c; }
    __syncthreads();
    int cur = 0;
    for (int o = 1; o < 256; o <<= 1) {
        int v = 0;
        if (tid < 256) { v = sc[cur * 256 + tid]; if (tid >= o) v += sc[cur * 256 + tid - o]; sc[(cur ^ 1) * 256 + tid] = v; }
        __syncthreads(); cur ^= 1;
    }
    const int total = sc[cur * 256 + 255];
    if (tid < 256) { const int end = sc[cur * 256 + tid], start = end - nt; for (int t = 0; t < nt; ++t) tile[start + t] = tid | (t << 16); }
    __syncthreads();
    return total;
}
struct MoeOrder1 {
    const char* H2; const char* W; LAS const int* tile; LAS const unsigned* rtab; int ntiles, G, c;
    static constexpr bool GATHER = true;
    __device__ __forceinline__ bool next(int i, Unit& u) const { const int idx = i * G + c; if (idx >= 2 * ntiles) return false; const int t = tile[idx >> 1]; u.pm = idx >> 1; u.pn = idx & 1; u.aux = t; u.ui = i; return true; }
    __device__ __forceinline__ const char* abase(const Unit&) const { return H2; }
    __device__ __forceinline__ const char* bbase(const Unit& u) const { return W + ((size_t)(u.aux & 0xffff) * 512 + (size_t)u.pn * 256) * 1024 * 2; }
    __device__ __forceinline__ unsigned rowoff(int ui, int r) const { return rtab[ui * 256 + r]; }
    __device__ __forceinline__ bool full(const Unit& u) const { return ((u.aux >> 30) & 1) == 0; }
};
struct EpiMoe1 {
    KA a0;
    __device__ __forceinline__ void operator()(const f32x4 (&acc)[2][2][4][2], const Unit& u, int wr, int wc, int fr, int fq) const {
        KA a = a0; asm volatile("" : "+s"(a));
        bf16* HE = (bf16*)(a->ws + WS_HE);
        const int row0 = u.pm * 256 + wr * 64 + fr; const bool half = (u.aux >> 30) & 1;
#pragma unroll
        for (int ai = 0; ai < 2; ++ai)
#pragma unroll
            for (int m = 0; m < 4; ++m) { const int row = row0 + ai * 128 + m * 16;
                f32x4 v0, v1;
#pragma unroll
                for (int j = 0; j < 4; ++j) { v0[j] = silu_f(acc[ai][0][m][0][j]) * acc[ai][1][m][0][j]; v1[j] = silu_f(acc[ai][0][m][1][j]) * acc[ai][1][m][1][j]; }
                *(v4u*)(HE + (size_t)row * 256 + u.pn * 128 + 32 * wc + 8 * fq) = pack8(v0, v1); }
    }
};
constexpr int MOE2_MAXU = 12;
struct MoeOrder2 {
    const char* HE; const char* W; LAS const unsigned* utab; int ntiles, G, c;
    static constexpr bool GATHER = false;
    __device__ __forceinline__ bool next(int i, Unit& u) const { const int idx = i * G + c; if (i >= MOE2_MAXU || idx >= 4 * ntiles) return false; u.pm = idx >> 2; u.pn = idx & 3; u.aux = (int)utab[i * 257 + 256]; u.ui = i; return true; }
    __device__ __forceinline__ const char* abase(const Unit& u) const { return HE + (size_t)u.pm * 256 * 256 * 2; }
    __device__ __forceinline__ const char* bbase(const Unit& u) const { return W + ((size_t)(u.aux & 0xffff) * 1024 + (size_t)u.pn * 256) * 256 * 2; }
    __device__ __forceinline__ unsigned rowoff(int, int) const { return 0u; }
    __device__ __forceinline__ bool full(const Unit& u) const { return ((u.aux >> 30) & 1) == 0; }
};
struct EpiMoe2 {
    KA a0; LAS const unsigned* utab;
    __device__ __forceinline__ void operator()(const f32x4 (&acc)[2][2][4][2], const Unit& u, int wr, int wc, int fr, int fq) const {
        KA a = a0; asm volatile("" : "+s"(a));
        unsigned char* YPAIR = a->ws + WS_YPAIR + u.pn * 256 + 32 * wc + 8 * (fq & ~1);
        const bool odd = (fq & 1) != 0;
#pragma unroll
        for (int ai = 0; ai < 2; ++ai)
#pragma unroll
            for (int k = 0; k < 2; ++k) {
                const unsigned entA = utab[u.ui * 257 + ai * 128 + wr * 64 + (2 * k) * 16 + fr], entB = utab[u.ui * 257 + ai * 128 + wr * 64 + (2 * k + 1) * 16 + fr];
                const float wA = 16.f * (float)__builtin_bit_cast(_Float16, (unsigned short)(entA & 0x7fffu)), wB = 16.f * (float)__builtin_bit_cast(_Float16, (unsigned short)(entB & 0x7fffu));
                const unsigned ent = odd ? entB : entA;
#pragma unroll
                for (int bj = 0; bj < 2; ++bj) {
                    const f32x4 a0v = acc[ai][bj][2 * k][0] * wA, a1v = acc[ai][bj][2 * k][1] * wA, b0v = acc[ai][bj][2 * k + 1][0] * wB, b1v = acc[ai][bj][2 * k + 1][1] * wB;
                    int A0 = __builtin_amdgcn_cvt_pk_fp8_f32(a0v[0], a0v[1], 0, false); A0 = __builtin_amdgcn_cvt_pk_fp8_f32(a0v[2], a0v[3], A0, true);
                    int A1 = __builtin_amdgcn_cvt_pk_fp8_f32(a1v[0], a1v[1], 0, false); A1 = __builtin_amdgcn_cvt_pk_fp8_f32(a1v[2], a1v[3], A1, true);
                    int B0 = __builtin_amdgcn_cvt_pk_fp8_f32(b0v[0], b0v[1], 0, false); B0 = __builtin_amdgcn_cvt_pk_fp8_f32(b0v[2], b0v[3], B0, true);
                    int B1 = __builtin_amdgcn_cvt_pk_fp8_f32(b1v[0], b1v[1], 0, false); B1 = __builtin_amdgcn_cvt_pk_fp8_f32(b1v[2], b1v[3], B1, true);
                    const auto r0 = __builtin_amdgcn_permlane16_swap((unsigned)A0, (unsigned)B0, false, false), r1 = __builtin_amdgcn_permlane16_swap((unsigned)A1, (unsigned)B1, false, false);
                    if (ent != 0xffffffffu) *(v4u*)(YPAIR + (size_t)(ent >> 15) * 1024 + 128 * bj) = (v4u){r0[0], r1[0], r0[1], r1[1]};
                }
            }
    }
};
typedef short v4i16_t __attribute__((ext_vector_type(4)));
__device__ __forceinline__ s16x4 trd(const LAS bf16* p) { return __builtin_bit_cast(s16x4, __builtin_amdgcn_ds_read_tr16_b64_v4i16((LAS v4i16_t*)p)); }
__device__ __forceinline__ bf16x8 frag_tr(const LAS bf16* T, int pitch, int l0, int c0, int lane) {
    const int g4 = lane >> 4, i = lane & 15, q = i >> 2, pp = i & 3;
    const LAS bf16* p = T + (l0 + 8 * g4 + q) * pitch + c0 + 4 * pp;
    const s16x4 lo = trd(p), hi = trd(p + 4 * pitch);
    return (bf16x8){lo[0], lo[1], lo[2], lo[3], hi[0], hi[1], hi[2], hi[3]};
}
__device__ __forceinline__ bf16x8 frag_nat(const LAS bf16* T, int pitch, int r0, int k0, int lane) {
    return *(const LAS bf16x8*)(T + (r0 + (lane & 15)) * pitch + k0 + 8 * (lane >> 4));
}
#define MFMA16(a, b, c) __builtin_amdgcn_mfma_f32_16x16x32_bf16((a), (b), (c), 0, 0, 0)

constexpr int S_BP = 136;
constexpr int S_XP4 = 264;
constexpr int S_XP = 72;

__device__ __forceinline__ void conv_part(KA a, int tok0, int c, int g, int cg_lo, int ncg, LAS unsigned char* lds, int tid) {
    const bf16* XBC = (const bf16*)(a->ws + WS_XBC); bf16* XS = (bf16*)(a->ws + WS_XS); bf16* BC = (bf16*)(a->ws + WS_BC);
    LAS bf16* sB = (LAS bf16*)lds; LAS bf16* sX = (LAS bf16*)(lds + 34816); const LAS float* sW = (const LAS float*)(lds + 106496);
    const int cg = cg_lo + tid % ncg, tg = tid / ncg, ntok = 128 / (512 / ncg);
    int gch; if (cg < 64) gch = g * 512 + cg * 8; else if (cg < 80) gch = 2048 + g * 128 + (cg - 64) * 8; else gch = 2560 + g * 128 + (cg - 80) * 8;
    float w[4][8], bias[8];
    asm volatile("" ::: "memory");
#pragma unroll
    for (int j = 0; j < 4; ++j) { const f32x4 w0 = *(const f32x4*)(INF(I_CONVW) + j * 3072 + gch), w1 = *(const f32x4*)(INF(I_CONVW) + j * 3072 + gch + 4);
#pragma unroll
        for (int i = 0; i < 4; ++i) { w[j][i] = w0[i]; w[j][4 + i] = w1[i]; } }
    { const f32x4 b0 = *(const f32x4*)(INF(I_CONVB) + gch), b1 = *(const f32x4*)(INF(I_CONVB) + gch + 4);
#pragma unroll
        for (int i = 0; i < 4; ++i) { bias[i] = b0[i]; bias[4 + i] = b1[i]; } }
    const int l_lo = tg * ntok;
    v4u r0, r1, r2;
    const bf16* src = XBC + (size_t)(tok0 + l_lo) * 3072 + gch;
    { const int sp = c * 128 + l_lo;
      const v4u z = {0u, 0u, 0u, 0u};
      r0 = sp >= 3 ? *(const v4u*)(src - 3 * 3072) : z;
      r1 = sp >= 2 ? *(const v4u*)(src - 2 * 3072) : z;
      r2 = sp >= 1 ? *(const v4u*)(src - 1 * 3072) : z; }
    v4u rn[4];
#pragma unroll
    for (int k = 0; k < 4; ++k) rn[k] = *(const v4u*)(src + (size_t)k * 3072);
    for (int tb = 0; tb < ntok; tb += 4) {
        v4u rr[4];
#pragma unroll
        for (int k = 0; k < 4; ++k) rr[k] = rn[k];
        if (tb + 4 < ntok) {
#pragma unroll
            for (int k = 0; k < 4; ++k) rn[k] = *(const v4u*)(src + (size_t)(tb + 4 + k) * 3072);
        }
#pragma unroll
        for (int k = 0; k < 4; ++k) {
            const int l = l_lo + tb + k; const v4u r3 = rr[k];
            float x0[8], x1[8], x2[8], x3[8], o[8];
            unpack8(r0, x0); unpack8(r1, x1); unpack8(r2, x2); unpack8(r3, x3);
#pragma unroll
            for (int i = 0; i < 8; ++i) { const float v = bias[i] + w[0][i] * x0[i] + w[1][i] * x1[i] + w[2][i] * x2[i] + w[3][i] * x3[i]; o[i] = silu_f(v); }
            v4u pk; pk.x = pk2(o[0], o[1]); pk.y = pk2(o[2], o[3]); pk.z = pk2(o[4], o[5]); pk.w = pk2(o[6], o[7]);
            if (cg < 64) {
                *(v4u*)(XS + (size_t)(tok0 + l) * 2048 + g * 512 + cg * 8) = pk;
                const float sc = sW[(cg >> 3) * 128 + l];
                v4u ps; ps.x = pk2(o[0] * sc, o[1] * sc); ps.y = pk2(o[2] * sc, o[3] * sc); ps.z = pk2(o[4] * sc, o[5] * sc); ps.w = pk2(o[6] * sc, o[7] * sc);
                *(LAS v4u*)(sX + l * S_XP4 + (cg & 31) * 8) = ps;
            } else if (cg < 80) {
                *(v4u*)(BC + (size_t)(tok0 + l) * 1024 + g * 128 + (cg - 64) * 8) = pk;
                *(LAS v4u*)(sB + l * S_BP + (cg - 64) * 8) = pk;
            } else {
                *(v4u*)(BC + (size_t)(tok0 + l) * 1024 + 512 + g * 128 + (cg - 80) * 8) = pk;
            }
            r0 = r1; r1 = r2; r2 = r3;
        }
    }
}
__device__ __forceinline__ void ssd_s1_unit(KA a, int unit, LAS unsigned char* lds, int tid, int wave, int lane) {
    const int g = unit & 3, c = (unit >> 2) & 63, b = unit >> 8; const int tok0 = b * SEQ + c * 128;
    const float* DT = (const float*)(a->ws + WS_DT); float* ACUM = (float*)(a->ws + WS_ACUM); bf16* CHST = (bf16*)(a->ws + WS_CHST);
    LAS bf16* sB = (LAS bf16*)lds; LAS bf16* sX = (LAS bf16*)(lds + 34816); LAS float* sAc = (LAS float*)(lds + 102400); LAS float* sW = (LAS float*)(lds + 106496);
    { const int hh = g * 8 + wave; const float a_neg = -expf(INF(I_ALOG)[hh]);
      const float d0 = DT[(size_t)(tok0 + lane) * 32 + hh], d1 = DT[(size_t)(tok0 + 64 + lane) * 32 + hh];
      float v0 = d0 * a_neg, v1 = d1 * a_neg;
#pragma unroll
      for (int o = 1; o < 64; o <<= 1) { const float t0 = __shfl_up(v0, o), t1 = __shfl_up(v1, o); if (lane >= o) { v0 += t0; v1 += t1; } }
      v1 += __shfl(v0, 63);
      const float alast = __shfl(v1, 63);
      ACUM[(size_t)(tok0 + lane) * 32 + hh] = v0; ACUM[(size_t)(tok0 + 64 + lane) * 32 + hh] = v1;
      sAc[wave * 128 + lane] = v0; sAc[wave * 128 + 64 + lane] = v1;
      sW[wave * 128 + lane] = d0 * __expf(alast - v0); sW[wave * 128 + 64 + lane] = d1 * __expf(alast - v1); }
    __syncthreads();
    for (int pass = 0; pass < 2; ++pass) {
        if (pass == 0) conv_part(a, tok0, c, g, 0, 32, lds, tid);
        else           conv_part(a, tok0, c, g, 32, 32, lds, tid);
        if (pass == 0) conv_part(a, tok0, c, g, 64, 32, lds, tid);
        __syncthreads();
        const int hl = wave >> 1, pt0 = 2 * (wave & 1);
        f32x4 acc[2][8];
#pragma unroll
        for (int i = 0; i < 2; ++i)
#pragma unroll
            for (int j = 0; j < 8; ++j) acc[i][j] = (f32x4){0.f, 0.f, 0.f, 0.f};
#pragma unroll
        for (int ks = 0; ks < 4; ++ks) {
            bf16x8 bx[2];
#pragma unroll
            for (int i = 0; i < 2; ++i) bx[i] = frag_tr(sX, S_XP4, 32 * ks, hl * 64 + 16 * (pt0 + i), lane);
#pragma unroll
            for (int nt = 0; nt < 8; ++nt) { const bf16x8 an = frag_tr(sB, S_BP, 32 * ks, 16 * nt, lane);
#pragma unroll
                for (int i = 0; i < 2; ++i) acc[i][nt] = MFMA16(an, bx[i], acc[i][nt]); }
        }
        { const int hh = g * 8 + pass * 4 + hl; bf16* dst = CHST + ((size_t)((b * 64 + c) * 32 + hh) * 64) * 128;
          const int g4 = lane >> 4; bf16* drow = dst + (size_t)(16 * (pt0 + (g4 & 1)) + (lane & 15)) * 128 + 4 * (g4 & ~1);
#pragma unroll
          for (int nt = 0; nt < 8; ++nt) {
              const unsigned ax = pk2(acc[0][nt][0], acc[0][nt][1]), ay = pk2(acc[0][nt][2], acc[0][nt][3]), bx_ = pk2(acc[1][nt][0], acc[1][nt][1]), by = pk2(acc[1][nt][2], acc[1][nt][3]);
              const auto r0 = __builtin_amdgcn_permlane16_swap(ax, bx_, false, false), r1 = __builtin_amdgcn_permlane16_swap(ay, by, false, false);
              *(v4u*)(drow + 16 * nt) = (v4u){r0[0], r1[0], r0[1], r1[1]}; } }
        __syncthreads();
    }
}
__device__ __forceinline__ void ssd_s2_item(KA a, int item, int tid) {
    const int pq = item & 3, hh = (item >> 2) & 31, b = item >> 7;
    const bf16* CHST = (const bf16*)(a->ws + WS_CHST); bf16* STIN = (bf16*)(a->ws + WS_STIN); const float* ACUM = (const float*)(a->ws + WS_ACUM);
    const size_t off = (size_t)(pq * 16) * 128 + (size_t)tid * 4;
    float s[4] = {0.f, 0.f, 0.f, 0.f};
    v2u wn[8]; float decn[8];
#define S2_LOAD(c0_) do { _Pragma("unroll") for (int j = 0; j < 8; ++j) { const size_t base = ((size_t)((b * 64 + (c0_) + j) * 32 + hh) * 64) * 128 + off; \
        wn[j] = *(const v2u*)(CHST + base); decn[j] = ACUM[(size_t)(b * SEQ + ((c0_) + j) * 128 + 127) * 32 + hh]; } } while (0)
    S2_LOAD(0);
    for (int c0 = 0; c0 < 64; c0 += 8) {
        v2u w[8]; float dec[8];
#pragma unroll
        for (int j = 0; j < 8; ++j) { w[j] = wn[j]; dec[j] = decn[j]; }
        if (c0 + 8 < 64) S2_LOAD(c0 + 8);
#pragma unroll
        for (int j = 0; j < 8; ++j) { const size_t base = ((size_t)((b * 64 + c0 + j) * 32 + hh) * 64) * 128 + off;
            v2u o; o.x = pk2(s[0], s[1]); o.y = pk2(s[2], s[3]); *(v2u*)(STIN + base) = o;
            const float d = __expf(dec[j]);
            s[0] = s[0] * d + bflo(w[j].x); s[1] = s[1] * d + bfhi(w[j].x); s[2] = s[2] * d + bflo(w[j].y); s[3] = s[3] * d + bfhi(w[j].y); }
    }
#undef S2_LOAD
}
template <int NHEADS> __device__ __forceinline__ void ssd_s3_unit_t(KA a, int unit, LAS unsigned char* lds, int tid, int wave, int lane) {
    const int g = unit & 3, c = (unit >> 2) & 63, b = unit >> 8; const int tok0 = b * SEQ + c * 128;
    const bf16* XS = (const bf16*)(a->ws + WS_XS); const bf16* BC = (const bf16*)(a->ws + WS_BC); const bf16* ZS = (const bf16*)(a->ws + WS_ZS);
    const bf16* STIN = (const bf16*)(a->ws + WS_STIN); const float* DT = (const float*)(a->ws + WS_DT); const float* ACUM = (const float*)(a->ws + WS_ACUM);
    bf16* YC = (bf16*)(a->ws + WS_YCAT);
    LAS bf16* sBn = (LAS bf16*)lds; LAS bf16* sG = (LAS bf16*)lds; LAS bf16* sC = (LAS bf16*)(lds + 34816); LAS bf16* sX = (LAS bf16*)(lds + 69632); LAS bf16* sS = (LAS bf16*)(lds + 88064);
    LAS float* sAc = (LAS float*)(lds + 105472); LAS float* sDt = (LAS float*)(lds + 109568); LAS float* sSS = (LAS float*)(lds + 113664);
    const int g4 = lane >> 4, li_ = lane & 15;
    const int pt = wave & 3, par = wave >> 2;
    v4u px[2], ps[2];
#define S3_LOADHEAD(hg_) do { _Pragma("unroll") for (int k = 0; k < 2; ++k) { const int piece = tid + 512 * k; \
        px[k] = *(const v4u*)(XS + (size_t)(tok0 + (piece >> 3)) * 2048 + (hg_) * 64 + (piece & 7) * 8); \
        ps[k] = *(const v4u*)(STIN + ((size_t)((b * 64 + c) * 32 + (hg_)) * 64 + (piece >> 4)) * 128 + (piece & 15) * 8); } } while (0)
    S3_LOADHEAD(g * 8);
#pragma unroll
    for (int k = 0; k < 4; ++k) { const int piece = tid + 512 * k, row = piece >> 4, ch = piece & 15;
        *(LAS v4u*)(sBn + row * S_BP + ch * 8) = *(const v4u*)(BC + (size_t)(tok0 + row) * 1024 + g * 128 + ch * 8);
        *(LAS v4u*)(sC + row * S_BP + ch * 8) = *(const v4u*)(BC + (size_t)(tok0 + row) * 1024 + 512 + g * 128 + ch * 8); }
#pragma unroll
    for (int k = 0; k < 2; ++k) { const int idx = tid + 512 * k, hh = idx >> 7, l = idx & 127;
        sAc[idx] = ACUM[(size_t)(tok0 + l) * 32 + g * 8 + hh]; sDt[idx] = DT[(size_t)(tok0 + l) * 32 + g * 8 + hh]; }
    __syncthreads();
    f32x4 GT[5]; int pli[5], psi[5];
#pragma unroll
    for (int j = 0; j < 5; ++j) { const int q = wave + 8 * j; int L = 0; while ((L + 1) * (L + 2) / 2 <= q) ++L; pli[j] = L; psi[j] = q - L * (L + 1) / 2;
        GT[j] = (f32x4){0.f, 0.f, 0.f, 0.f};
        if (q < 36) {
#pragma unroll
            for (int ks = 0; ks < 4; ++ks) GT[j] = MFMA16(frag_nat(sBn, S_BP, 16 * psi[j], 32 * ks, lane), frag_nat(sC, S_BP, 16 * pli[j], 32 * ks, lane), GT[j]); } }
    float ss[4] = {0.f, 0.f, 0.f, 0.f};
    for (int hh = 0; hh < NHEADS; ++hh) {
        const int hg = g * 8 + hh;
        __syncthreads();
        if (hh == 0) { const int blk = tid >> 7, r = (tid >> 3) & 15, cc = tid & 7;
            *(LAS unsigned*)(sG + (32 * blk + r) * S_BP + 32 * blk + 16 + 2 * cc) = 0u; }
#pragma unroll
        for (int k = 0; k < 2; ++k) { const int piece = tid + 512 * k;
            *(LAS v4u*)(sX + (piece >> 3) * S_XP + (piece & 7) * 8) = px[k];
            *(LAS v4u*)(sS + (piece >> 4) * S_BP + (piece & 15) * 8) = ps[k]; }
        if (hh < NHEADS - 1) S3_LOADHEAD(hg + 1);
        v2u zw[4];
#pragma unroll
        for (int j = 0; j < 4; ++j) zw[j] = *(const v2u*)(ZS + (size_t)(tok0 + 16 * (par + 2 * j) + li_) * 2048 + hg * 64 + 16 * pt + 4 * g4);
#pragma unroll
        for (int j = 0; j < 5; ++j) {
            if (wave + 8 * j < 36) {
                const int l = 16 * pli[j] + li_, s0 = 16 * psi[j] + 4 * g4;
                const float al = sAc[hh * 128 + l];
                const f32x4 as = *(const LAS f32x4*)(sAc + hh * 128 + s0), ds = *(const LAS f32x4*)(sDt + hh * 128 + s0);
                float v[4];
#pragma unroll
                for (int r = 0; r < 4; ++r) v[r] = (s0 + r <= l) ? GT[j][r] * __expf(al - as[r]) * ds[r] : 0.f;
                v2u w; w.x = pk2(v[0], v[1]); w.y = pk2(v[2], v[3]);
                *(LAS v2u*)(sG + l * S_BP + s0) = w;
            }
        }
        __syncthreads();
        bf16x8 xa[4], sa[4];
#pragma unroll
        for (int ks = 0; ks < 4; ++ks) { xa[ks] = frag_tr(sX, S_XP, 32 * ks, 16 * pt, lane); sa[ks] = frag_nat(sS, S_BP, 16 * pt, 32 * ks, lane); }
        const float dsk = INF(I_DSKIP)[hg];
        v2u yw[4];
#pragma unroll
        for (int j = 0; j < 4; ++j) {
            const int lt = par + 2 * j, l = 16 * lt + li_;
            f32x4 yd = {0.f, 0.f, 0.f, 0.f}, yo = {0.f, 0.f, 0.f, 0.f};
#pragma unroll
            for (int ks = 0; ks < 4; ++ks) { if (ks <= (lt >> 1)) yd = MFMA16(xa[ks], frag_nat(sG, S_BP, 16 * lt, 32 * ks, lane), yd); }
#pragma unroll
            for (int ks = 0; ks < 4; ++ks) yo = MFMA16(sa[ks], frag_nat(sC, S_BP, 16 * lt, 32 * ks, lane), yo);
            const float el = __expf(sAc[hh * 128 + l]);
            const int p0 = 16 * pt + 4 * g4;
            const v2u xw = *(const LAS v2u*)(sX + l * S_XP + p0);
            const float xs[4] = {bflo(xw.x), bfhi(xw.x), bflo(xw.y), bfhi(xw.y)}, zs[4] = {bflo(zw[j].x), bfhi(zw[j].x), bflo(zw[j].y), bfhi(zw[j].y)};
            float y[4];
#pragma unroll
            for (int r = 0; r < 4; ++r) { y[r] = (yd[r] + el * yo[r] + dsk * xs[r]) * zs[r]; ss[j] += y[r] * y[r]; }
            yw[j].x = pk2(y[0], y[1]); yw[j].y = pk2(y[2], y[3]);
        }
#pragma unroll
        for (int q = 0; q < 2; ++q) {
            const auto r0 = __builtin_amdgcn_permlane16_swap(yw[2 * q].x, yw[2 * q + 1].x, false, false), r1 = __builtin_amdgcn_permlane16_swap(yw[2 * q].y, yw[2 * q + 1].y, false, false);
            const int l = 16 * (par + 2 * (2 * q + (g4 & 1))) + li_;
            *(v4u*)(YC + (size_t)(tok0 + l) * 3072 + 1024 + hg * 64 + 16 * pt + 4 * (g4 & ~1)) = (v4u){r0[0], r1[0], r0[1], r1[1]};
        }
    }
#undef S3_LOADHEAD
#pragma unroll
    for (int j = 0; j < 4; ++j) { float s = ss[j]; s += __shfl_xor(s, 16); s += __shfl_xor(s, 32); if (g4 == 0) sSS[(16 * (par + 2 * j) + li_) * 4 + pt] = s; }
    __syncthreads();
    if (tid < 128) { const f32x4 p4 = *(const LAS f32x4*)(sSS + tid * 4);
        ((float*)(a->ws + WS_RSTD))[(size_t)(tok0 + tid) * 4 + g] = 1.f / sqrtf(((p4[0] + p4[1]) + (p4[2] + p4[3])) * (1.f / 512.f) + EPS); }
    __syncthreads();
}
__device__ __forceinline__ void ssd_s3_unit(KA a, int unit, LAS unsigned char* lds, int tid, int wave, int lane) { ssd_s3_unit_t<8>(a, unit, lds, tid, wave, lane); }
__device__ __forceinline__ void attn_combine(KA a, float lam, int gw, int NGW, int lane) {
    const bf16* O = (const bf16*)(a->ws + WS_O); bf16* YC = (bf16*)(a->ws + WS_YA);
    const int h8 = lane >> 3, jj = lane & 7;
    float gn[16];
#pragma unroll
    for (int k = 0; k < 4; ++k) { const f32x4 t = *(const f32x4*)(INF(I_HNORM) + 16 * jj + 4 * k); gn[4 * k] = t[0]; gn[4 * k + 1] = t[1]; gn[4 * k + 2] = t[2]; gn[4 * k + 3] = t[3]; }
    for (int m0 = gw; m0 < M; m0 += 4 * NGW) {
        v4u ra[4][4];
#pragma unroll
        for (int u = 0; u < 4; ++u) { const int m = m0 + u * NGW; const bf16* o0 = O + (size_t)(m < M ? m : m0) * 2048 + (2 * h8) * 128 + 16 * jj;
            ra[u][0] = *(const v4u*)o0; ra[u][1] = *(const v4u*)(o0 + 8); ra[u][2] = *(const v4u*)(o0 + 128); ra[u][3] = *(const v4u*)(o0 + 136); }
#pragma unroll
        for (int u = 0; u < 4; ++u) { const int m = m0 + u * NGW; if (m >= M) continue;
            float a0[16], a1[16], d[16];
            unpack8(ra[u][0], a0); unpack8(ra[u][1], a0 + 8); unpack8(ra[u][2], a1); unpack8(ra[u][3], a1 + 8);
            float s = 0.f;
#pragma unroll
            for (int k = 0; k < 16; ++k) { d[k] = a0[k] - lam * a1[k]; s += d[k] * d[k]; }
            s += __shfl_xor(s, 1); s += __shfl_xor(s, 2); s += __shfl_xor(s, 4);
            const float rstd = (1.f - LAMBDA_INIT) / sqrtf(s * (1.f / 128.f) + EPS);
            v4u w0, w1;
            w0.x = pk2(d[0] * rstd * gn[0], d[1] * rstd * gn[1]); w0.y = pk2(d[2] * rstd * gn[2], d[3] * rstd * gn[3]); w0.z = pk2(d[4] * rstd * gn[4], d[5] * rstd * gn[5]); w0.w = pk2(d[6] * rstd * gn[6], d[7] * rstd * gn[7]);
            w1.x = pk2(d[8] * rstd * gn[8], d[9] * rstd * gn[9]); w1.y = pk2(d[10] * rstd * gn[10], d[11] * rstd * gn[11]); w1.z = pk2(d[12] * rstd * gn[12], d[13] * rstd * gn[13]); w1.w = pk2(d[14] * rstd * gn[14], d[15] * rstd * gn[15]);
            bf16* y = YC + (size_t)m * 1024 + h8 * 128 + 16 * jj;
            *(v4u*)y = w0; *(v4u*)(y + 8) = w1; }
    }
}
template <bool DRY> __device__ __forceinline__ void route_tokens_t(KA a, gu32* ctl, int gw, int NGW, int lane) {
    const float* LOG = (const float*)(a->ws + WS_LOGITS); int* LIST = (int*)(a->ws + WS_LIST); float* PAIRW = (float*)(a->ws + WS_PAIRW);
    const int sl = lane & 15, tk = lane >> 4, lbase = lane & 48;
    float bias[16];
#pragma unroll
    for (int q = 0; q < 4; ++q) { const f32x4 t = *(const f32x4*)(INF(I_RB) + 16 * sl + 4 * q); bias[4 * q] = t[0]; bias[4 * q + 1] = t[1]; bias[4 * q + 2] = t[2]; bias[4 * q + 3] = t[3]; }
    const float NEG = -INFINITY;
    f32x4 lgn[4]; bool have = false; unsigned ppos = 0u; int pe = 0, pm = 0; float pw = 0.f;
    if (gw < M / 4) {
#pragma unroll
        for (int q = 0; q < 4; ++q) lgn[q] = *(const f32x4*)(LOG + (size_t)(4 * gw + tk) * 256 + 16 * sl + 4 * q); }
    for (int task = gw; task < M / 4; task += NGW) {
        const int m = 4 * task + tk;
        float sc[16], cm[16];
        f32x4 lgc[4];
#pragma unroll
        for (int q = 0; q < 4; ++q) lgc[q] = lgn[q];
        if (task + NGW < M / 4) {
#pragma unroll
            for (int q = 0; q < 4; ++q) lgn[q] = *(const f32x4*)(LOG + (size_t)(4 * (task + NGW) + tk) * 256 + 16 * sl + 4 * q); }
#pragma unroll
        for (int q = 0; q < 4; ++q) { const f32x4 lg = lgc[q];
#pragma unroll
            for (int r = 0; r < 4; ++r) { sc[4 * q + r] = sigmoid_f(lg[r]); cm[4 * q + r] = sc[4 * q + r] + bias[4 * q + r]; } }
        float t1 = NEG, t2 = NEG;
#pragma unroll
        for (int j = 0; j < 16; ++j) { const float v = cm[j]; const float n2 = fmaxf(fminf(t1, v), t2); t1 = fmaxf(t1, v); t2 = n2; }
        { const float o1 = __shfl_xor(t1, 1), o2 = __shfl_xor(t2, 1); const float n1 = fmaxf(t1, o1), n2 = fmaxf(fminf(t1, o1), fmaxf(t2, o2)); t1 = n1; t2 = n2; }
        const float gs = t1 + t2; const int mygrp = sl >> 1;
        int rank = 0;
#pragma unroll
        for (int gg = 0; gg < 8; ++gg) { const float o = __shfl(gs, lbase + 2 * gg); rank += ((o > gs) || (o == gs && gg < mygrp)) ? 1 : 0; }
        if (rank >= 4) {
#pragma unroll
            for (int j = 0; j < 16; ++j) cm[j] = NEG; }
        float my_s = 0.f, sum = 0.f; int my_e = 0;
#pragma unroll
        for (int k = 0; k < 8; ++k) {
            float bv = cm[0], bs = sc[0]; int bi = 16 * sl;
#pragma unroll
            for (int j = 1; j < 16; ++j) { const bool g = cm[j] > bv; bv = g ? cm[j] : bv; bs = g ? sc[j] : bs; bi = g ? 16 * sl + j : bi; }
#pragma unroll
            for (int o = 1; o < 16; o <<= 1) { const float ov = __shfl_xor(bv, o), os = __shfl_xor(bs, o); const int oi = __shfl_xor(bi, o);
                const bool g = (ov > bv) || (ov == bv && oi < bi); bv = g ? ov : bv; bs = g ? os : bs; bi = g ? oi : bi; }
#pragma unroll
            for (int j = 0; j < 16; ++j) cm[j] = (bi == 16 * sl + j) ? NEG : cm[j];
            sum += bs;
            if (sl == k) { my_e = bi; my_s = bs; }
        }
        if (sl < 8) {
            const float w = my_s / (sum + 1e-20f) * 2.5f;
            if (DRY) { asm volatile("" :: "v"(w), "v"(my_e)); }
            else {
                if (have) { LIST[(size_t)pe * M + ppos] = pm * 8 + sl; PAIRW[pm * 8 + sl] = pw; }
                ppos = __hip_atomic_fetch_add(ctl + CW_CNT + my_e, 1u, RLX_AGENT); pe = my_e; pm = m; pw = w; }
        }
        have = true;
    }
    if (!DRY && have && sl < 8) { LIST[(size_t)pe * M + ppos] = pm * 8 + sl; PAIRW[pm * 8 + sl] = pw; }
}
__device__ __forceinline__ void route_tokens(KA a, gu32* ctl, int gw, int NGW, int lane) { route_tokens_t<false>(a, ctl, gw, NGW, lane); }
template <bool DRY> __device__ __forceinline__ void final_rows_t(KA a, int gw, int NGW, int lane) {
    float* outp = DRY ? (float*)(a->ws + WS_Q) : a->out;
    const bf16* SH = (const bf16*)(a->ws + WS_SHARED); const unsigned char* YP = a->ws + WS_YPAIR; const float* mod = (const float*)(a->ws + WS_MOD); const bf16* X1H = (const bf16*)(a->ws + WS_X1H);
    typedef float f2_ __attribute__((ext_vector_type(2)));
    for (int b = 0; b < BATCH; ++b) {
        f32x4 gm[4], nf[4];
#pragma unroll
        for (int q = 0; q < 4; ++q) { const int col = 8 * lane + 512 * (q >> 1) + 4 * (q & 1); gm[q] = *(const f32x4*)(mod + b * 6144 + 5120 + col); nf[q] = *(const f32x4*)(INF(I_NFIN) + col); }
        int m = gw; while (m < b * SEQ) m += NGW;
        for (; m < (b + 1) * SEQ; m += NGW) {
            float v[2][8]; float s = 0.f;
#pragma unroll
            for (int j = 0; j < 2; ++j) { const int col = 8 * lane + 512 * j;
                float xv[8]; unpack8(*(const v4u*)(X1H + (size_t)m * D + col), xv);
                float acc[8]; unpack8(*(const v4u*)(SH + (size_t)m * D + col), acc);
                float ry[8] = {0.f, 0.f, 0.f, 0.f, 0.f, 0.f, 0.f, 0.f};
#pragma unroll
                for (int k = 0; k < 8; ++k) { const v2u yw = *(const v2u*)(YP + ((size_t)m * 8 + k) * D + col);
                    const f2_ p0 = __builtin_amdgcn_cvt_pk_f32_fp8((int)yw.x, false), p1 = __builtin_amdgcn_cvt_pk_f32_fp8((int)yw.x, true);
                    const f2_ p2 = __builtin_amdgcn_cvt_pk_f32_fp8((int)yw.y, false), p3 = __builtin_amdgcn_cvt_pk_f32_fp8((int)yw.y, true);
                    ry[0] += p0.x; ry[1] += p0.y; ry[2] += p1.x; ry[3] += p1.y; ry[4] += p2.x; ry[5] += p2.y; ry[6] += p3.x; ry[7] += p3.y; }
#pragma unroll
                for (int e = 0; e < 4; ++e) { v[j][e] = xv[e] + gm[2 * j][e] * (acc[e] + ry[e] * 0.0625f); v[j][4 + e] = xv[4 + e] + gm[2 * j + 1][e] * (acc[4 + e] + ry[4 + e] * 0.0625f); }
#pragma unroll
                for (int e = 0; e < 8; ++e) s += v[j][e] * v[j][e]; }
            const float rstd = 1.f / sqrtf(wave_sum(s) * (1.f / D) + EPS);
#pragma unroll
            for (int j = 0; j < 2; ++j) { const int col = 8 * lane + 512 * j;
                *(f32x4*)(outp + (size_t)m * D + col) = (f32x4){v[j][0], v[j][1], v[j][2], v[j][3]} * rstd * nf[2 * j];
                *(f32x4*)(outp + (size_t)m * D + col + 4) = (f32x4){v[j][4], v[j][5], v[j][6], v[j][7]} * rstd * nf[2 * j + 1]; }
        }
    }
}
__device__ __forceinline__ void final_rows(KA a, int gw, int NGW, int lane) { final_rows_t<false>(a, gw, NGW, lane); }

constexpr int NPHASE = 14;
__global__ void __launch_bounds__(NWAVES * 64, 2) mega(Args a_byval) {
    extern __shared__ __attribute__((aligned(16))) unsigned char lds_raw[];
    LAS unsigned char* lds = (LAS unsigned char*)lds_raw;
    const int wave = __builtin_amdgcn_readfirstlane((int)threadIdx.x >> 6);
    const int bx = blockIdx.x;
    { const int tid = tid_fresh(wave); for (int u = tid; u < (LDS_BYTES - LDSCTL_OFF) / 4; u += NWAVES * 64) ((LAS unsigned*)(lds + LDSCTL_OFF))[u] = 0u; }
    __syncthreads();
    const int lo = a_byval.ph_lo, hi = a_byval.ph_hi;
    if (hi - lo > 1) { KA a = ka_fresh(); (void)xcd_barrier_post((unsigned*)(a->ws + WS_CTL) + CW_BAR, (volatile LAS unsigned*)(lds + MISC_OFF) + 8, wave == 0 && lane_id() == 0); }
#ifndef PHMASK
#define PHMASK 0x7fff
#endif
#define IN(k) (((PHMASK >> (k)) & 1) && lo <= (k) && (k) < hi)
#define SEAM(k) do { if (IN(k) && IN((k) + 1)) { KA a_ = ka_fresh(); XcdBarrier b_; b_.bar = (unsigned*)(a_->ws + WS_CTL) + CW_BAR; b_.x = xb_xcc_id(); b_.st = (volatile LAS unsigned*)(lds + MISC_OFF) + 8; xcd_barrier(b_, wave == 0 && lane_id() == 0); } } while (0)
#define PHASE_BEGIN KA a = ka_fresh(); const int tid = tid_fresh(wave), lane = tid & 63; (void)lane; unsigned char* ws = a->ws; const float* mod = (const float*)(ws + WS_MOD); (void)mod; gu32* ctl = (gu32*)(ws + WS_CTL); (void)ctl; \
    const int G = a->G; const int vcu = (G % 8 == 0) ? (bx % 8) * (G / 8) + bx / 8 : bx; (void)vcu; const int gw = bx * NWAVES + wave, NGW = G * NWAVES; (void)gw; (void)NGW;

    if (IN(0)) { PHASE_BEGIN ph0_mod(a, lds, tid); ph0_misc(a, ctl, bx * NWAVES * 64 + tid, G * NWAVES * 64); ph0_weights(a, lds, gw, NGW, wave, lane, 0, (G == 256) ? TR_SPLIT : TR_NITEMS); }
    SEAM(0);
    if (IN(1)) { PHASE_BEGIN norm_rows<false>(INF(I_X), INF(I_NMIX), mod, 0, 1024, (bf16*)(ws + WS_H), gw, NGW, lane); }
    SEAM(1);
    if (IN(2)) { PHASE_BEGIN
        if (G == 256 && bx >= 256 - HELPER_CUS) {
            convert_queue(a, lds, ctl + CW_QCONV, wave, lane, TR_SPLIT, TR_NITEMS);
        } else {
            pg8::GridOrder S; S.init(ws + WS_H, ws + WS_WIN, 1024, 1024, M, NIN, (G == 256) ? 256 - HELPER_CUS : G, bx);
            EpiInProj E{a};
            pg8::gemm_phase<EpiInProj, pg8::GridOrder, true>(lds, pg8::GemmDesc{1024, 1024, 1024}, S, E, wave);
            if (G == 256) convert_queue(a, lds, ctl + CW_QCONV, wave, lane, TR_SPLIT, TR_NITEMS);
        }
    }
    SEAM(2);
    if (IN(3)) { PHASE_BEGIN for (int u = bx; u < 512; u += G) ssd_s1_unit(a, u, lds, tid, wave, lane); }
    SEAM(3);
    if (IN(4)) { PHASE_BEGIN
        for (int it = bx; it < 256; it += G) ssd_s2_item(a, it, tid);
        const attn_body::bf16* Qp = (const attn_body::bf16*)(ws + WS_Q); const attn_body::bf16* Kp = (const attn_body::bf16*)(ws + WS_K); const attn_body::bf16* Vp = (const attn_body::bf16*)(ws + WS_V);
        attn_body::bf16* Op = (attn_body::bf16*)(ws + WS_O);
        { const float lam = __builtin_bit_cast(float, __builtin_amdgcn_readfirstlane((int)__hip_atomic_load(ctl + CW_LAM, RLX_AGENT)));
          const attn_body::AttnTensors AT{Qp, Kp, Vp, Op, lam, INF(I_HNORM), (attn_body::bf16*)(ws + WS_YA)}; const attn_body::StaticOrder S((int)G, (int)bx);
          attn_body::attn_phase<attn_body::StaticOrder>((char*)lds_raw, AT, S, wave); }
    }
    SEAM(4);
    if (IN(5)) { PHASE_BEGIN
        for (int u = bx; u < 512; u += G) ssd_s3_unit(a, u, lds, tid, wave, lane);
        const float lam = __builtin_bit_cast(float, __hip_atomic_load(ctl + CW_LAM, RLX_AGENT));
    }
    SEAM(5);
    if (IN(6)) { PHASE_BEGIN
        { pg8::GridOrder S; S.init(ws + WS_YA, ws + WS_WA, 1024, 1024, M, 1024, G, bx);
          EpiMixA E{a};
          pg8::gemm_phase<EpiMixA, pg8::GridOrder, true>(lds, pg8::GemmDesc{1024, 1024, 1024}, S, E, wave); }
        { pg8::GridOrder S; S.init(ws + WS_YCAT + 1024 * 2, ws + WS_WS, 3072, 2048, M, 1024, G, bx);
          LAS float* rs = (LAS float*)(lds + TAB_OFF);
          { pg8::Unit u0; if (S.next(0, u0)) { const float* RSTD = (const float*)(ws + WS_RSTD);
                for (int k = tid; k < 1024; k += NWAVES * 64) rs[k] = RSTD[(size_t)u0.pm * 1024 + k]; } }
          __syncthreads();
          EpiMixB E{a, rs}; HookGrp H{rs};
          pg8::gemm_phase<EpiMixB, pg8::GridOrder, true, HookGrp>(lds, pg8::GemmDesc{3072, 2048, 2048}, S, E, wave, H); }
    }
    SEAM(6);
    if (IN(7)) { PHASE_BEGIN
        pg8::GridOrder S; S.init(ws + WS_MIXED, ws + WS_WO, 1024, 1024, M, 1024, G, bx);
        EpiOut E{a};
        pg8::gemm_phase<EpiOut, pg8::GridOrder, true>(lds, pg8::GemmDesc{1024, 1024, 1024}, S, E, wave);
    }
    SEAM(7);
    if (IN(8)) { PHASE_BEGIN norm_rows<true>(ws + WS_X1H, INF(I_NFFN), mod, 3072, 4096, (bf16*)(ws + WS_H), gw, NGW, lane); }
    SEAM(8);
    if (IN(9)) { PHASE_BEGIN
        pg8::GridOrder S; S.init(ws + WS_H, ws + WS_WRS, 1024, 1024, M, 1024, G, bx);
        EpiRS E{a};
        pg8::gemm_phase<EpiRS, pg8::GridOrder, true>(lds, pg8::GemmDesc{1024, 1024, 1024}, S, E, wave);
    }
    SEAM(9);
    if (IN(10)) { PHASE_BEGIN
        route_tokens(a, ctl, gw, NGW, lane);
        pg8::GridOrder S; S.init(ws + WS_HS, ws + WS_WSHD, 256, 256, M, 1024, G, bx);
        EpiStore E{a, WS_SHARED, 1024};
        pg8::gemm_phase<EpiStore, pg8::GridOrder, true>(lds, pg8::GemmDesc{256, 256, 256}, S, E, wave);
    }
    SEAM(10);
    if (IN(11)) { PHASE_BEGIN
        LAS int* tile = (LAS int*)(lds + TAB_OFF); LAS unsigned* rowoff = (LAS unsigned*)(lds + TAB_OFF + 4096);
        const int ntiles = moe_build_tiles(ctl, lds, tile, tid);
        const int* LIST = (const int*)(ws + WS_LIST);
        { LAS const int* scnt = (LAS const int*)(lds + 2048); int lv[3]; bool ok[3];
#pragma unroll
          for (int i = 0; i < 3; ++i) { const int k = tid + 512 * i, ui = k >> 8, r = k & 255, idx = ui * G + vcu; ok[i] = idx < 2 * ntiles;
              const int t = tile[ok[i] ? (idx >> 1) : 0], e = t & 0xffff, slot = ((t >> 16) & 0xff) * 256 + r; ok[i] = ok[i] && slot < scnt[e];
              lv[i] = ok[i] ? LIST[(size_t)e * M + slot] : 0; }
#pragma unroll
          for (int i = 0; i < 3; ++i) rowoff[tid + 512 * i] = ok[i] ? (unsigned)(lv[i] >> 3) * 2048u : 0u; }
        __syncthreads();
        MoeOrder1 S{(const char*)(ws + WS_H), (const char*)(ws + WS_WEGU), tile, rowoff, ntiles, G, vcu};
        EpiMoe1 E{a};
        pg8::gemm_phase<EpiMoe1, MoeOrder1, true>(lds, pg8::GemmDesc{1024, 1024, 1024}, S, E, wave);
    }
    SEAM(11);
    if (IN(12)) { PHASE_BEGIN
        LAS int* tile = (LAS int*)(lds + 4096);
        LAS unsigned* utab = (LAS unsigned*)(lds + TAB_OFF);
        const int ntiles = moe_build_tiles(ctl, lds, tile, tid);
        { const int* LIST = (const int*)(ws + WS_LIST); const float* PAIRW = (const float*)(ws + WS_PAIRW);
          LAS const int* scnt = (LAS const int*)(lds + 2048);
          constexpr int NIT = (MOE2_MAXU * 257 + NWAVES * 64 - 1) / (NWAVES * 64);
          int pr[NIT]; float pwt[NIT]; unsigned ent0[NIT]; bool ok[NIT];
#pragma unroll
          for (int i = 0; i < NIT; ++i) { const int k = tid + NWAVES * 64 * i, ui = k / 257, r = k - ui * 257, idx = ui * G + vcu; const bool in = k < MOE2_MAXU * 257 && idx < 4 * ntiles;
              const int t = tile[in ? (idx >> 2) : 0], e = t & 0xffff, slot = ((t >> 16) & 0xff) * 256 + r;
              ent0[i] = (in && r == 256) ? (unsigned)t : 0xffffffffu; ok[i] = in && r < 256 && slot < scnt[e];
              pr[i] = ok[i] ? LIST[(size_t)e * M + slot] : 0; }
#pragma unroll
          for (int i = 0; i < NIT; ++i) pwt[i] = ok[i] ? PAIRW[pr[i]] : 0.f;
#pragma unroll
          for (int i = 0; i < NIT; ++i) { const int k = tid + NWAVES * 64 * i;
              if (k < MOE2_MAXU * 257) utab[k] = ok[i] ? (((unsigned)pr[i] << 15) | ((unsigned)__builtin_bit_cast(unsigned short, (_Float16)pwt[i]) & 0x7fffu)) : ent0[i]; } }
        __syncthreads();
        MoeOrder2 S{(const char*)(ws + WS_HE), (const char*)(ws + WS_WED), utab, ntiles, G, vcu};
        EpiMoe2 E{a, utab};
        pg8::gemm_phase<EpiMoe2, MoeOrder2, true>(lds, pg8::GemmDesc{256, 256, 256}, S, E, wave);
    }
    SEAM(12);
    if (IN(13)) { PHASE_BEGIN final_rows(a, gw, NGW, lane); }
#if MK_N_LAUNCHES == 0 && defined(MK_PROBE_S3)
    if (IN(14)) { PHASE_BEGIN for (int u = bx; u < 512; u += G) ssd_s3_unit_t<MK_PROBE_S3>(a, u, lds, tid, wave, lane); }
#endif
#if MK_N_LAUNCHES == 0 && defined(MK_PROBE_COMB)
    if (IN(14)) { PHASE_BEGIN attn_combine(a, 0.5f, gw, NGW, lane); }
#endif
#if MK_N_LAUNCHES == 0 && defined(MK_PROBE_ROUTE)
    if (IN(14)) { PHASE_BEGIN route_tokens_t<true>(a, ctl, gw, NGW, lane); }
#endif
#if MK_N_LAUNCHES == 0 && defined(MK_PROBE_FINAL)
    if (IN(14)) { PHASE_BEGIN final_rows_t<true>(a, gw, NGW, lane); }
#endif
#if MK_N_LAUNCHES == 0 && defined(MK_PROBE_GEMM)
    if (IN(14)) { PHASE_BEGIN
        pg8::GridOrder S; S.init(ws + WS_WEGU, ws + WS_WIN, 1024, 1024, M, NIN, G, bx);
        EpiStore E{a, WS_Q, NIN};
        pg8::gemm_phase<EpiStore, pg8::GridOrder, true>(lds, pg8::GemmDesc{1024, 1024, 1024}, S, E, wave);
    }
#endif
#undef IN
#undef SEAM
}

extern "C" void kernel_launch(void* const* d_in, const int* in_sizes, int n_in, void* d_out, int out_size, void* d_ws, size_t ws_size, hipStream_t stream) {
    static int grid = 0;
    if (grid == 0) {
        if (n_in != 32 || out_size != M * D || ws_size < WS_END) { fprintf(stderr, "kernel_launch: unexpected shapes (n_in %d out %d ws %zu)\n", n_in, out_size, ws_size); grid = -1; return; }
        int dev = 0, cus = 0, per_cu = 0;
        if (hipGetDevice(&dev) != hipSuccess || hipDeviceGetAttribute(&cus, hipDeviceAttributeMultiprocessorCount, dev) != hipSuccess) { grid = -1; return; }
        if (hipFuncSetAttribute((const void*)mega, hipFuncAttributeMaxDynamicSharedMemorySize, LDS_BYTES) != hipSuccess) { fprintf(stderr, "kernel_launch: hipFuncSetAttribute failed\n"); grid = -1; return; }
        if (hipOccupancyMaxActiveBlocksPerMultiprocessor(&per_cu, (const void*)mega, NWAVES * 64, LDS_BYTES) != hipSuccess || per_cu < 1) { fprintf(stderr, "kernel_launch: occupancy query says %d\n", per_cu); (void)hipGetLastError(); grid = -1; return; }
        grid = cus;
    }
    if (grid < 0) return;
    (void)hipMemsetAsync((char*)d_ws + WS_CTL, 0, CTL_ZERO_BYTES, stream);
    Args a{};
    for (int i = 0; i < 32; ++i) a.in[i] = d_in[i];
    a.out = (float*)d_out; a.ws = (unsigned char*)d_ws; a.G = grid;
#if MK_N_LAUNCHES == 1
    a.ph_lo = 0; a.ph_hi = NPHASE;
    hipLaunchKernelGGL(mega, dim3(grid), dim3(NWAVES * 64), LDS_BYTES, stream, a);
#else
    for (int p = 0; p < NPHASE; ++p) { a.ph_lo = p; a.ph_hi = p + 1; for (int r = 0; r < 1 + ((MK_DUPMASK >> p) & 1); ++r) hipLaunchKernelGGL(mega, dim3(grid), dim3(NWAVES * 64), LDS_BYTES, stream, a); }
#if defined(MK_PROBE_GEMM) || defined(MK_PROBE_S3) || defined(MK_PROBE_COMB) || defined(MK_PROBE_ROUTE) || defined(MK_PROBE_FINAL)
    a.ph_lo = 14; a.ph_hi = 15; hipLaunchKernelGGL(mega, dim3(grid), dim3(NWAVES * 64), LDS_BYTES, stream, a);
#endif
#endif
}
```

```cpp
#include <hip/hip_runtime.h>
#include <hip/hip_bf16.h>
#include <cstdio>
#include <cstdint>
#include <cmath>

#ifndef MK_N_LAUNCHES
#define MK_N_LAUNCHES 1
#endif

#ifndef MK_DUPMASK
#define MK_DUPMASK 0
#endif

#define LAS __attribute__((address_space(3)))
#define GAS __attribute__((address_space(1)))
typedef unsigned short bf16;
typedef unsigned v4u __attribute__((ext_vector_type(4)));
typedef unsigned v2u __attribute__((ext_vector_type(2)));
typedef float f32x4 __attribute__((ext_vector_type(4)));
typedef float f32x2 __attribute__((ext_vector_type(2)));
typedef short bf16x8 __attribute__((ext_vector_type(8)));
typedef short s16x4 __attribute__((ext_vector_type(4)));
typedef GAS unsigned gu32;
typedef GAS unsigned long long gu64;
#define RLX_AGENT __ATOMIC_RELAXED, __HIP_MEMORY_SCOPE_AGENT
#define LDS_WAIT() asm volatile("s_waitcnt lgkmcnt(0)" ::: "memory")
#define VM_WAIT() asm volatile("s_waitcnt vmcnt(0)" ::: "memory")

constexpr int BATCH = 2, SEQ = 8192, D = 1024, M = BATCH * SEQ;
constexpr int IN_COLS = 10272, NIN = 10496;
constexpr int NEXP = 256, TOPK = 8, EFF = 256;
constexpr int NPAIR = M * TOPK;
constexpr int MAXTILES = NPAIR / 256 + NEXP;
constexpr float EPS = 1e-6f;
constexpr float LAMBDA_INIT = 0.2f;
constexpr float QSCALE = 0.125f * 1.4426950408889634f;

constexpr size_t MiB = 1u << 20;
constexpr size_t WS_CTL = 0, CTL_ZERO_BYTES = 1 * MiB;
constexpr size_t WS_WIN = 2 * MiB;
constexpr size_t WS_WA = 23 * MiB;
constexpr size_t WS_WS = 25 * MiB;
constexpr size_t WS_WO = 29 * MiB;
constexpr size_t WS_WRS = 31 * MiB;
constexpr size_t WS_WSHD = 33 * MiB;
constexpr size_t WS_MOD = 34 * MiB;
constexpr size_t WS_CS = 35 * MiB;
constexpr size_t WS_WEGU = 36 * MiB;
constexpr size_t WS_WED = 292 * MiB;
constexpr size_t WS_H = 420 * MiB;
constexpr size_t WS_Q = 452 * MiB, WS_K = 484 * MiB, WS_V = 516 * MiB;
constexpr size_t WS_YCAT = 452 * MiB;
constexpr size_t WS_YA = 420 * MiB;
constexpr size_t WS_MIXED = 676 * MiB;
constexpr size_t WS_ZS = 548 * MiB;
constexpr size_t WS_TMP = 548 * MiB;
constexpr size_t WS_XBC = 612 * MiB;
constexpr size_t WS_O = 612 * MiB;
constexpr size_t WS_GATES = 708 * MiB;
constexpr size_t WS_DT = 772 * MiB;
constexpr size_t WS_ACUM = 774 * MiB;
constexpr size_t WS_XS = 776 * MiB;
constexpr size_t WS_BC = 840 * MiB;
constexpr size_t WS_CHST = 872 * MiB;
constexpr size_t WS_STIN = 936 * MiB;
constexpr size_t WS_LOGITS = 452 * MiB;
constexpr size_t WS_HS = 468 * MiB;
constexpr size_t WS_SHARED = 476 * MiB;
constexpr size_t WS_LIST = 508 * MiB;
constexpr size_t WS_PAIRW = 524 * MiB;
constexpr size_t WS_HE = 548 * MiB;
constexpr size_t WS_YPAIR = 644 * MiB;
constexpr size_t WS_X1H = 776 * MiB;
constexpr size_t WS_RSTD = 1000 * MiB;
constexpr size_t WS_END = 1001 * MiB;
constexpr int CW_TMO = 0, CW_CODE = 1;
constexpr int CW_BAR = 4096;
constexpr int CW_CNT = 16384;
constexpr int CW_LAM = 17000;
constexpr int CW_QCONV = 18432;

constexpr int RING_BYTES = 131072;
constexpr int TAB_OFF = RING_BYTES;
constexpr int TAB_BYTES = 12800;
constexpr int LDSCTL_OFF = TAB_OFF + TAB_BYTES, MISC_OFF = LDSCTL_OFF + 64;
constexpr int LDS_BYTES = 147456;
static_assert(MISC_OFF + 128 <= LDS_BYTES, "LDS map");
constexpr int NWAVES = 8;

__device__ __forceinline__ unsigned f2bf(float f) { unsigned u = __builtin_bit_cast(unsigned, f); return (u + 0x7fffu + ((u >> 16) & 1u)) >> 16; }
typedef float f32x2_t_ __attribute__((ext_vector_type(2))); typedef __bf16 bf16x2_t_ __attribute__((ext_vector_type(2)));
__device__ __forceinline__ unsigned pk2(float lo, float hi) { f32x2_t_ v = {lo, hi}; bf16x2_t_ b = __builtin_convertvector(v, bf16x2_t_); return __builtin_bit_cast(unsigned, b); }
__device__ __forceinline__ float bf2f(unsigned short h) { return __builtin_bit_cast(float, (unsigned)h << 16); }
__device__ __forceinline__ float bflo(unsigned w) { return __builtin_bit_cast(float, w << 16); }
__device__ __forceinline__ float bfhi(unsigned w) { return __builtin_bit_cast(float, w & 0xffff0000u); }
__device__ __forceinline__ float silu_f(float v) { return v * __builtin_amdgcn_rcpf(1.f + __expf(-v)); }
__device__ __forceinline__ float sigmoid_f(float v) { return __builtin_amdgcn_rcpf(1.f + __expf(-v)); }
__device__ __forceinline__ float softplus_f(float v) { return fmaxf(v, 0.f) + log1pf(__expf(-fabsf(v))); }
__device__ __forceinline__ int lane_id() { int l; asm volatile("v_mbcnt_lo_u32_b32 %0, -1, 0\n\tv_mbcnt_hi_u32_b32 %0, -1, %0" : "=v"(l)); return l; }
__device__ __forceinline__ float wave_sum(float v) {
#pragma unroll
    for (int o = 1; o < 64; o <<= 1) v += __shfl_xor(v, o);
    return v;
}
namespace pg8 {
#define PG8_LAS __attribute__((address_space(3)))
typedef unsigned short bf16_t;
typedef short bf16x8 __attribute__((ext_vector_type(8)));
typedef float f32x4 __attribute__((ext_vector_type(4)));
typedef unsigned u32x4 __attribute__((ext_vector_type(4)));
constexpr int BM = 256, BK = 64, HALF = 128, HTB = HALF * BK * 2  , STAGE_BYTES = 8 * HTB, NXCD = 8, WGM = 8;

__host__ __device__ __forceinline__ int lds_byte(int r, int c) { const int st = (r >> 4) * 2 + (c >> 5), rr = r & 15, cc = c & 31, ob = rr * 64 + cc * 2; return st * 1024 + (ob ^ (((ob >> 9) & 1) << 5)); }
__host__ __device__ __forceinline__ void stage_rc(int b, int& R, int& C) { const int st = b / 1024, sb = b % 1024, swz = sb ^ (((sb >> 9) & 1) << 5); R = (st >> 1) * 16 + swz / 64; C = (st & 1) * 32 + (swz % 64) / 2; }
__host__ __device__ __forceinline__ int perm32(int rho) { const int n = rho >> 4, i = rho & 15; return 8 * (i >> 2) + 4 * n + (i & 3); }

struct Unit { int pm, pn, aux, ui; };
struct GemmDesc { int lda, ldb, K; };

struct GridOrder {
    const char* A; const char* Bt; size_t tstepA, tstepB;
    int nM, nN, nwg, G, c;
    static constexpr bool GATHER = false;
    __device__ __forceinline__ void init(const void* A_, const void* Bt_, int lda, int ldb, int M, int N, int G_, int c_) {
        A = (const char*)A_; Bt = (const char*)Bt_; tstepA = (size_t)BM * lda * 2; tstepB = (size_t)BM * ldb * 2; nM = M / BM; nN = N / BM; nwg = nM * nN; G = G_; c = c_; }
    __device__ __forceinline__ bool next(int i, Unit& u) const {
        const long L = (long)i * G + c; if (L >= nwg) return false;
        int wgid = (int)L; { const int q = nwg / NXCD, r = nwg % NXCD, xcd = wgid % NXCD, off = wgid / NXCD; wgid = (xcd < r ? xcd * (q + 1) : r * (q + 1) + (xcd - r) * q) + off; }
        const int nig = WGM * nN, gid = wgid / nig, fm = gid * WGM, gsz = (nM - fm) < WGM ? (nM - fm) : WGM;
        u.pm = fm + ((wgid % nig) % gsz); u.pn = (wgid % nig) / gsz; u.aux = 0; u.ui = i; return true;
    }
    __device__ __forceinline__ const char* abase(const Unit& u) const { return A + (size_t)u.pm * tstepA; }
    __device__ __forceinline__ const char* bbase(const Unit& u) const { return Bt + (size_t)u.pn * tstepB; }
    __device__ __forceinline__ unsigned rowoff(int, int) const { return 0u; }
    __device__ __forceinline__ bool full(const Unit&) const { return true; }
};

__device__ __forceinline__ unsigned cvt_pk_bf16(float lo, float hi) { unsigned r; asm volatile("v_cvt_pk_bf16_f32 %0, %1, %2" : "=v"(r) : "v"(lo), "v"(hi)); return r; }

struct NoHook { static constexpr bool ON = false; __device__ __forceinline__ void operator()(f32x4 (&)[2][2][4][2], int, int) const {} };
template <class Epi, class Sched, bool ALIGN_EPI, class Hook = NoHook>
__device__ __forceinline__ void gemm_phase(PG8_LAS unsigned char* lds, const GemmDesc g, const Sched& S, const Epi& E, int wave_, const Hook H = Hook()) {
    const int lane = lane_id(), wid = wave_, tid = wid * 64 + lane,
              wr = wid >> 2, wc = wid & 3, fr = lane & 15, fq = lane >> 4;
    int K = g.K; asm volatile("" : "+s"(K)); const int nt = K / BK;
    constexpr bool GATHER = Sched::GATHER;
    unsigned voffA0[2], voffA1[2], voffB0[2], voffB1[2], nvA0[2], nvA1[2]; int Rr[2]; unsigned Cb[2];
#pragma unroll
    for (int i = 0; i < 2; ++i) { int R, C; stage_rc(tid * 16 + i * 8192, R, C); const int Rb = ((R & ~31) + perm32(R & 31));
        Rr[i] = R; Cb[i] = (unsigned)C * 2u;
        voffA0[i] = (unsigned)(R * g.lda + C) * 2u; voffA1[i] = voffA0[i] + (unsigned)(HALF * g.lda) * 2u;
        voffB0[i] = (unsigned)(Rb * g.ldb + C) * 2u; voffB1[i] = voffB0[i] + (unsigned)(HALF * g.ldb) * 2u;
        nvA0[i] = voffA0[i]; nvA1[i] = voffA1[i]; }
    const size_t kstep = (size_t)(BK * 2);
    const unsigned ldsw = (unsigned)wid * 1024u;
    const int aoff = lds_byte(wr * 64 + fr, fq * 8), boff = lds_byte(wc * 32 + fr, fq * 8);
#define PG8_SA(b, h) (((b) * 2 + (h)) * HTB)
#define PG8_SB(b, h) ((4 + (b) * 2 + (h)) * HTB)
#define PG8_STAGE(bufoff, gbase, voff) do { _Pragma("unroll") for (int _i = 0; _i < 2; ++_i) \
        __builtin_amdgcn_global_load_lds((const unsigned*)((const char*)(gbase) + (voff)[_i]), (PG8_LAS unsigned*)(lds + (bufoff) + ldsw + _i * 8192), 16, 0, 0); } while (0)
#define PG8_LDA(dst, b, h) do { _Pragma("unroll") for (int m = 0; m < 4; ++m) _Pragma("unroll") for (int k = 0; k < 2; ++k) dst[m][k] = *(const PG8_LAS bf16x8*)(lds + PG8_SA(b, h) + aoff + m * 2048 + k * 1024); } while (0)
#define PG8_LDB(dst, b, h) do { _Pragma("unroll") for (int n = 0; n < 2; ++n) _Pragma("unroll") for (int k = 0; k < 2; ++k) dst[n][k] = *(const PG8_LAS bf16x8*)(lds + PG8_SB(b, h) + boff + n * 2048 + k * 1024); } while (0)
#define PG8_MMA(ai, bj, At, Bt) do { __builtin_amdgcn_s_setprio(1); _Pragma("unroll") for (int m = 0; m < 4; ++m) _Pragma("unroll") for (int n = 0; n < 2; ++n) _Pragma("unroll") for (int k = 0; k < 2; ++k) \
        acc[ai][bj][m][n] = __builtin_amdgcn_mfma_f32_16x16x32_bf16(Bt[n][k], At[m][k], acc[ai][bj][m][n], 0, 0, 0); __builtin_amdgcn_s_setprio(0); } while (0)
#define PG8_WAIT_V(n) asm volatile("s_waitcnt vmcnt(" #n ")" ::: "memory")
#define PG8_WAIT_L(n) asm volatile("s_waitcnt lgkmcnt(" #n ")" ::: "memory")
#define PG8_BAR __builtin_amdgcn_s_barrier()
#define PG8_SCHED __builtin_amdgcn_sched_barrier(0)
    Unit cur, nxt; int ui = 0;
    if (!S.next(0, cur)) return;
    if constexpr (GATHER) {
#pragma unroll
        for (int i = 0; i < 2; ++i) { voffA0[i] = S.rowoff(0, Rr[i]) + Cb[i]; voffA1[i] = S.rowoff(0, HALF + Rr[i]) + Cb[i]; }
    }
    f32x4 acc[2][2][4][2];
#pragma unroll
    for (int a = 0; a < 2; ++a)
#pragma unroll
        for (int b = 0; b < 2; ++b)
#pragma unroll
            for (int m = 0; m < 4; ++m)
#pragma unroll
                for (int n = 0; n < 2; ++n) acc[a][b][m][n] = (f32x4){0.f, 0.f, 0.f, 0.f};
    bf16x8 At[4][2], B0[2][2], B1[2][2];
    const char* cA = S.abase(cur); const char* cB = S.bbase(cur);
    PG8_STAGE(PG8_SB(0, 0), cB, voffB0); PG8_STAGE(PG8_SB(0, 1), cB, voffB1); PG8_STAGE(PG8_SA(0, 0), cA, voffA0); PG8_STAGE(PG8_SA(0, 1), cA, voffA1);
    if (wr == 1) PG8_BAR;
    PG8_WAIT_V(2); PG8_BAR;
    PG8_STAGE(PG8_SB(1, 0), cB + kstep, voffB0); PG8_STAGE(PG8_SA(1, 0), cA + kstep, voffA0); PG8_STAGE(PG8_SB(1, 1), cB + kstep, voffB1);
    PG8_WAIT_V(6); PG8_BAR;
    for (;;) {
        const bool has_next = S.next(ui + 1, nxt);
        const char* nA = has_next ? S.abase(nxt) : cA; const char* nB = has_next ? S.bbase(nxt) : cB;
        if constexpr (GATHER) {
            if (has_next) {
#pragma unroll
                for (int i = 0; i < 2; ++i) { nvA0[i] = S.rowoff(ui + 1, Rr[i]) + Cb[i]; nvA1[i] = S.rowoff(ui + 1, HALF + Rr[i]) + Cb[i]; }
            } else {
#pragma unroll
                for (int i = 0; i < 2; ++i) { nvA0[i] = voffA0[i]; nvA1[i] = voffA1[i]; }
            }
        }
        for (int t = 0; t < nt; t += 2) {
            if constexpr (Hook::ON) H(acc, t, wr);
            const bool last = (t == nt - 2);
            const char* a1 = cA + (size_t)(t + 1) * kstep;
            const char* a2 = last ? nA : cA + (size_t)(t + 2) * kstep; const char* b2 = last ? nB : cB + (size_t)(t + 2) * kstep;
            const char* a3 = a2 + kstep; const char* b3 = b2 + kstep;
            unsigned sA0[2], sA1[2];
#pragma unroll
            for (int i = 0; i < 2; ++i) { sA0[i] = (GATHER && last) ? nvA0[i] : voffA0[i]; sA1[i] = (GATHER && last) ? nvA1[i] : voffA1[i]; }
            PG8_LDB(B0, 0, 0); PG8_LDB(B1, 0, 1); PG8_SCHED; PG8_LDA(At, 0, 0); PG8_STAGE(PG8_SA(1, 1), a1, voffA1);
            PG8_WAIT_V(8); PG8_WAIT_L(0); PG8_BAR; PG8_MMA(0, 0, At, B0); PG8_MMA(0, 1, At, B1); PG8_BAR; PG8_SCHED;
            PG8_LDA(At, 0, 1); PG8_STAGE(PG8_SB(0, 0), b2, voffB0); PG8_STAGE(PG8_SB(0, 1), b2, voffB1); PG8_STAGE(PG8_SA(0, 0), a2, sA0);
            PG8_WAIT_V(8); PG8_WAIT_L(0); PG8_BAR; PG8_MMA(1, 0, At, B0); PG8_MMA(1, 1, At, B1); PG8_BAR; PG8_SCHED;
            PG8_LDB(B0, 1, 0); PG8_LDB(B1, 1, 1); PG8_SCHED; PG8_LDA(At, 1, 0); PG8_STAGE(PG8_SA(0, 1), a2, sA1);
            PG8_WAIT_V(8); PG8_WAIT_L(0); PG8_BAR; PG8_MMA(0, 0, At, B0); PG8_MMA(0, 1, At, B1); PG8_BAR; PG8_SCHED;
            PG8_LDA(At, 1, 1); PG8_STAGE(PG8_SB(1, 0), b3, voffB0); PG8_STAGE(PG8_SB(1, 1), b3, voffB1); PG8_STAGE(PG8_SA(1, 0), a3, sA0);
            PG8_WAIT_V(8); PG8_WAIT_L(0); PG8_BAR; PG8_MMA(1, 0, At, B0); PG8_MMA(1, 1, At, B1); PG8_BAR; PG8_SCHED;
        }
        if constexpr (ALIGN_EPI) { if (wr == 0) PG8_BAR; }
        E(acc, cur, wr, wc, fr, fq);
        if (!has_next) break;
#pragma unroll
        for (int a = 0; a < 2; ++a)
#pragma unroll
            for (int b = 0; b < 2; ++b)
#pragma unroll
                for (int m = 0; m < 4; ++m)
#pragma unroll
                    for (int n = 0; n < 2; ++n) acc[a][b][m][n] = (f32x4){0.f, 0.f, 0.f, 0.f};
        cur = nxt; cA = nA; cB = nB; ++ui;
        if constexpr (GATHER) {
#pragma unroll
            for (int i = 0; i < 2; ++i) { voffA0[i] = nvA0[i]; voffA1[i] = nvA1[i]; }
        }
        if constexpr (ALIGN_EPI) { if (wr == 1) PG8_BAR; }
    }
    PG8_WAIT_V(0);
    if constexpr (!ALIGN_EPI) { if (wr == 0) PG8_BAR; }
    PG8_BAR;
#undef PG8_SA
#undef PG8_SB
#undef PG8_STAGE
#undef PG8_LDA
#undef PG8_LDB
#undef PG8_MMA
#undef PG8_WAIT_V
#undef PG8_WAIT_L
#undef PG8_BAR
#undef PG8_SCHED
}
}
namespace attn_body {
using bf16=__hip_bfloat16;
using bf16x8=__attribute__((ext_vector_type(8)))short;
using s16x4=__attribute__((ext_vector_type(4)))short;
using f32x16=__attribute__((ext_vector_type(16)))float;
using u32x4=__attribute__((ext_vector_type(4)))unsigned;
constexpr int BATCH=2,NHEAD=16,SEQ=8192,D=64,DM=NHEAD*D;
constexpr int NW=8,QBLK=32,QB=QBLK*NW,KVBLK=64,NQB=SEQ/QB;
constexpr int ATTN_PITCH=DM, ATTN_UNIT_ROWS=QB, OPITCH=2048;
__device__ __forceinline__ int crow(int r,int hi){return (r&3)+8*(r>>2)+4*hi;}
#define SBAR() __builtin_amdgcn_sched_barrier(0)
__device__ __forceinline__ void cmask(f32x16&p0,f32x16&p1,int jb,int qrel,int hi){
  const float NEG=-INFINITY; int dq=qrel-(64*jb+4*hi); asm volatile("":"+v"(dq));
  #pragma unroll
  for(int r=0;r<16;++r){const int cr=(r&3)+8*(r>>2); if(cr>dq)p0[r]=NEG; if(cr+32>dq)p1[r]=NEG;}
}

constexpr int NSLOT=3, SLOTB=8192;
constexpr int VSLOTB=2*SLOTB;
constexpr int LDS_K=0, LDS_V=NSLOT*SLOTB, LDS_WS=LDS_V+NSLOT*VSLOTB, LDS_OST=LDS_WS+NW*64*4, LDS_BYTES=LDS_OST+NW*4096;
constexpr float C2=0.125f*1.4426950408889634f;
__device__ __forceinline__ void glds16(const void*gsrc,unsigned lds_dst){unsigned keep;
  asm volatile("s_mov_b32 %0, m0\n\ts_mov_b32 m0, %2\n\ts_nop 0\n\tglobal_load_lds_dwordx4 %1, off\n\ts_mov_b32 m0, %0":"=&s"(keep):"v"(gsrc),"s"(lds_dst):"memory");}
__device__ __forceinline__ float max3f(float a,float b,float c){float r;asm("v_max3_f32 %0, %1, %2, %3":"=v"(r):"v"(a),"v"(b),"v"(c));return r;}
__device__ __forceinline__ float max2f(float a,float b){float r;asm("v_max_f32_e32 %0, %1, %2":"=v"(r):"v"(a),"v"(b));return r;}
__device__ __forceinline__ float fadd_s(float a,float b){float r;asm("v_add_f32_e32 %0, %1, %2":"=v"(r):"v"(a),"v"(b));return r;}
__device__ __forceinline__ float fsub_s(float a,float b){float r;asm("v_sub_f32_e32 %0, %1, %2":"=v"(r):"v"(a),"v"(b));return r;}
typedef float f32x2_t __attribute__((ext_vector_type(2))); typedef __bf16 bf16x2_t __attribute__((ext_vector_type(2)));
__device__ __forceinline__ unsigned cvtpk_s(float lo,float hi){f32x2_t v={lo,hi};bf16x2_t b=__builtin_convertvector(v,bf16x2_t);return __builtin_bit_cast(unsigned,b);}
#define WAIT_BAR(N) asm volatile("s_waitcnt vmcnt(" #N ") lgkmcnt(0)\n\ts_barrier":::"memory")

__device__ __forceinline__ void qkt(f32x16&p0,f32x16&p1,const char*Kslot,const bf16x8*qr,const f32x16&negm,int r32,int hi){
  const char*kb=Kslot+hi*1024+r32*16;
  #pragma unroll
  for(int d0=0;d0<4;++d0){
    const bf16x8 b0=*reinterpret_cast<const bf16x8*>(kb+d0*2048);
    const bf16x8 b1=*reinterpret_cast<const bf16x8*>(kb+d0*2048+512);
    if(d0==0){p0=__builtin_amdgcn_mfma_f32_32x32x16_bf16(b0,qr[0],negm,0,0,0);p1=__builtin_amdgcn_mfma_f32_32x32x16_bf16(b1,qr[0],negm,0,0,0);}
    else{p0=__builtin_amdgcn_mfma_f32_32x32x16_bf16(b0,qr[d0],p0,0,0,0);p1=__builtin_amdgcn_mfma_f32_32x32x16_bf16(b1,qr[d0],p1,0,0,0);}}
}
typedef __attribute__((address_space(3))) const char* lds_cptr;
typedef short v4i16_t __attribute__((ext_vector_type(4)));
__device__ __forceinline__ void kload8(bf16x8*kf,lds_cptr kp){
  kf[0]=*(const __attribute__((address_space(3))) bf16x8*)(kp);      kf[1]=*(const __attribute__((address_space(3))) bf16x8*)(kp+512);
  kf[2]=*(const __attribute__((address_space(3))) bf16x8*)(kp+2048); kf[3]=*(const __attribute__((address_space(3))) bf16x8*)(kp+2560);
  kf[4]=*(const __attribute__((address_space(3))) bf16x8*)(kp+4096); kf[5]=*(const __attribute__((address_space(3))) bf16x8*)(kp+4608);
  kf[6]=*(const __attribute__((address_space(3))) bf16x8*)(kp+6144); kf[7]=*(const __attribute__((address_space(3))) bf16x8*)(kp+6656);
}
__device__ __forceinline__ void kload2(bf16x8*kf,lds_cptr kp,int j){ kf[2*j]=*(const __attribute__((address_space(3))) bf16x8*)(kp+j*2048); kf[2*j+1]=*(const __attribute__((address_space(3))) bf16x8*)(kp+j*2048+512); }
__device__ __forceinline__ s16x4 vtr(lds_cptr p){ return __builtin_bit_cast(s16x4,__builtin_amdgcn_ds_read_tr16_b64_v4i16((__attribute__((address_space(3))) v4i16_t*)p)); }
__device__ __forceinline__ float rowmax(const f32x16&p0,const f32x16&p1){
  float a=max3f(p0[0],p0[1],p1[0]),b=max3f(p0[2],p0[3],p1[1]);a=max3f(a,p1[2],p1[3]);
  #pragma unroll
  for(int r=4;r<16;r+=4){a=max3f(a,p0[r],p0[r+1]);b=max3f(b,p0[r+2],p0[r+3]);a=max3f(a,p1[r],p1[r+1]);b=max3f(b,p1[r+2],p1[r+3]);}
  const float m=max2f(a,b);
  auto rr=__builtin_amdgcn_permlane32_swap(__float_as_uint(m),__float_as_uint(m),false,false);
  return max2f(__uint_as_float(rr[0]),__uint_as_float(rr[1]));
}
__device__ __forceinline__ void pv(f32x16*o,int vb,bf16x8 pa0,bf16x8 pa1,bf16x8 pa2,bf16x8 pa3){
  #pragma unroll
  for(int d0=0;d0<4;++d0){s16x4 lo[4],hi[4];
    #pragma unroll
    for(int ks=0;ks<4;++ks){
      asm volatile("ds_read_b64_tr_b16 %0,%1 offset:%c2":"=&v"(lo[ks]):"v"(vb),"i"(d0*4096+ks*1024):"memory");
      asm volatile("ds_read_b64_tr_b16 %0,%1 offset:%c2":"=&v"(hi[ks]):"v"(vb),"i"(d0*4096+ks*1024+512):"memory");}
    asm volatile("s_waitcnt lgkmcnt(0)":::"memory");SBAR();
    #define PK(k) (bf16x8){lo[k][0],lo[k][1],lo[k][2],lo[k][3],hi[k][0],hi[k][1],hi[k][2],hi[k][3]}
    o[d0]=__builtin_amdgcn_mfma_f32_32x32x16_bf16(pa0,PK(0),o[d0],0,0,0);
    o[d0]=__builtin_amdgcn_mfma_f32_32x32x16_bf16(pa1,PK(1),o[d0],0,0,0);
    o[d0]=__builtin_amdgcn_mfma_f32_32x32x16_bf16(pa2,PK(2),o[d0],0,0,0);
    o[d0]=__builtin_amdgcn_mfma_f32_32x32x16_bf16(pa3,PK(3),o[d0],0,0,0);
    #undef PK
  }
}

#ifndef ATTN_STORE16
#define ATTN_STORE16(p,v) (*(u32x4*)(p)=(v))
#endif
template<int THRL,bool COMB> __device__ __forceinline__ void attn_unit(int b,int cq,int cv,int co,int qb,const bf16*Q,const bf16*__restrict__ K,const bf16*__restrict__ V,bf16*O,char*shm,float lam,const float*gain,bf16*YC,int yc,int wave_){
  const int lane=lane_id(),r32=lane&31,hi=lane>>5; const int wid=wave_; const int tid=wid*64+lane; (void)tid;
  const long rowbase=(long)b*SEQ; const int q0=qb*QB;
  const bf16*Qw=Q+(rowbase+q0+wid*QBLK)*DM+cq;
  const bf16*Kh=K+rowbase*DM+cq,*Vh=V+rowbase*DM+cv;
  const unsigned lds0=(unsigned)(uintptr_t)shm;
  float*wsf=(float*)(shm+LDS_WS)+wid*64;
  const bf16*ksrc=Kh+(long)lane*DM+wid*8;
  const bf16*vsrc=Vh+(long)(16*(wid&3)+(lane>>2))*DM+(wid>>2)*32+(lane&3)*8;
  const unsigned kdst=lds0+LDS_K+wid*1024, vdst=lds0+LDS_V+wid*1024;
  #define DMA_K(t,slot) glds16(ksrc+(long)(t)*KVBLK*DM,(unsigned)__builtin_amdgcn_readfirstlane(kdst+(slot)))
  #define DMA_V(t,slot) do{ glds16(vsrc+(long)(t)*KVBLK*DM,(unsigned)__builtin_amdgcn_readfirstlane(vdst+2*(slot))); glds16(vsrc+64+(long)(t)*KVBLK*DM,(unsigned)__builtin_amdgcn_readfirstlane(vdst+2*(slot)+8192)); }while(0)
  const char*Kbase=shm+LDS_K; bf16x8 kf[8];
  const lds_cptr shm3=(lds_cptr)shm; const lds_cptr kp0=shm3+LDS_K+hi*1024+r32*16; const lds_cptr vp0=shm3+LDS_V+((lane>>4)&1)*32+(lane&3)*8+(4*hi+((lane&15)>>2))*64;
  const int NT=(q0+QB)/KVBLK;
  DMA_K(0,0);DMA_V(0,0);DMA_K(1,SLOTB);
  bf16x8 qr[4];
  #pragma unroll
  for(int d0=0;d0<4;++d0)qr[d0]=*reinterpret_cast<const bf16x8*>(&Qw[(long)r32*DM+d0*16+hi*8]);
  float mhat=0.f,l_reg=0.f;f32x16 o[4];o[0]=f32x16{};o[1]=f32x16{};o[2]=f32x16{};o[3]=f32x16{};f32x16 negm=f32x16{};asm volatile("":"+v"(negm));
  const int qrel=wid*QBLK+r32;
  #define CMASK(P0,P1,t) do{int jb_=(t)-(NT-4); if(jb_>=0)cmask(P0,P1,jb_,qrel,hi);}while(0)
  bool resc=false;
  #define START(P0,P1) do{ const float rm=rowmax(P0,P1); resc=false; \
    { const float dl=rm; mhat=fadd_s(mhat,dl); \
      _Pragma("unroll") for(int r=0;r<16;++r){P0[r]=fsub_s(P0[r],dl);P1[r]=fsub_s(P1[r],dl);} \
      _Pragma("unroll") for(int r=0;r<16;++r)negm[r]=-mhat; asm volatile("":"+v"(negm)); } \
    _Pragma("unroll") for(int r=0;r<16;++r){P0[r]=__builtin_amdgcn_exp2f(P0[r]);P1[r]=__builtin_amdgcn_exp2f(P1[r]);} }while(0)
  #define RESC() do{ if(resc){ asm volatile("s_waitcnt lgkmcnt(0)":::"memory"); \
      _Pragma("unroll") for(int d_=0;d_<4;++d_) _Pragma("unroll") for(int r=0;r<16;++r)o[d_][r]*=wsf[crow(r,hi)]; } }while(0)
  f32x16 pA0,pA1,pB0,pB1;
  int sl_prev=0,sl_cur=0,sl_next=SLOTB;
  #define ROT() do{sl_prev=sl_cur;sl_cur=sl_next;sl_next=(sl_next==(NSLOT-1)*SLOTB)?0:sl_next+SLOTB;}while(0)
  DMA_K(2,2*SLOTB);
  WAIT_BAR(4);
  qkt(pA0,pA1,Kbase,qr,negm,r32,hi);asm volatile("s_nop 15\n\ts_nop 7":"+v"(pA0),"+v"(pA1));CMASK(pA0,pA1,0);
  START(pA0,pA1);
  WAIT_BAR(0);
  DMA_K(3,0);DMA_V(1,SLOTB);
  ROT();
  kload8(kf,kp0+sl_cur);
  WAIT_BAR(3);
  s16x4 vlo[4],vhi[4]; u32x4 pw0,pw1,pw2,pw3;
  #define PKW(P,B) cvtpk_s(P[B],P[B+1])
  #define PAF(k) __builtin_bit_cast(bf16x8,pw##k)
  #define VFR(i) (bf16x8){vlo[i][0],vlo[i][1],vlo[i][2],vlo[i][3],vhi[i][0],vhi[i][1],vhi[i][2],vhi[i][3]}
  #define PIN(x) asm volatile("":"+v"(x))
  #define MX3(a,b,c) __builtin_fmaxf(__builtin_fmaxf((a),(b)),(c))
  #define GAPA(MF,A0,A1,A2,A3,W0,W1,PW) do{ MF; sacc+=A0; sacc+=A1; sacc+=A2; sacc+=A3; PIN(sacc); W0; W1; PIN(PW); SBAR(); }while(0)
  #define EX(v) __builtin_amdgcn_exp2f(v)
  #define GAPB(MF,X,B) do{ MF; X[B]=EX(X[B]); X[B+1]=EX(X[B+1]); PIN(X); SBAR(); }while(0)
  #define VRD(sl,m) do{ vlo[sl]=vtr(vp_+((((m)&3))*4096+((m)>>2)*1024)); vhi[sl]=vtr(vp_+((((m)&3))*4096+((m)>>2)*1024+512)); }while(0)
  #define KRD(G,j) do{ if(G){ kload2(kf,kp0+sl_next,j); SBAR(); } }while(0)
  #define ZC (f32x16{})
  #define STEP(C0,C1,P0,P1,t,GK,GV,GL) do{ SBAR(); \
    const lds_cptr vp_=vp0+2*sl_prev; \
    float sacc=(P0[0]+P0[1]); \
    GAPA(C0=__builtin_amdgcn_mfma_f32_32x32x16_bf16(kf[0],qr[0],negm,0,0,0), P0[2],P0[3],P0[4],P0[5],     pw0[0]=PKW(P0,0), pw0[1]=PKW(P0,2), pw0); \
    GAPA(C1=__builtin_amdgcn_mfma_f32_32x32x16_bf16(kf[1],qr[0],negm,0,0,0), P0[6],P0[7],P0[8],P0[9],     pw0[2]=PKW(P0,4), pw0[3]=PKW(P0,6), pw0); \
    GAPA(C0=__builtin_amdgcn_mfma_f32_32x32x16_bf16(kf[2],qr[1],C0,0,0,0),   P0[10],P0[11],P0[12],P0[13], pw1[0]=PKW(P0,8), pw1[1]=PKW(P0,10), pw1); \
    GAPA(C1=__builtin_amdgcn_mfma_f32_32x32x16_bf16(kf[3],qr[1],C1,0,0,0),   P0[14],P0[15],P1[0],P1[1],   pw1[2]=PKW(P0,12),pw1[3]=PKW(P0,14), pw1); \
    GAPA(C0=__builtin_amdgcn_mfma_f32_32x32x16_bf16(kf[4],qr[2],C0,0,0,0),   P1[2],P1[3],P1[4],P1[5],     pw2[0]=PKW(P1,0), pw2[1]=PKW(P1,2), pw2); \
    GAPA(C1=__builtin_amdgcn_mfma_f32_32x32x16_bf16(kf[5],qr[2],C1,0,0,0),   P1[6],P1[7],P1[8],P1[9],     pw2[2]=PKW(P1,4), pw2[3]=PKW(P1,6), pw2); \
    GAPA(C0=__builtin_amdgcn_mfma_f32_32x32x16_bf16(kf[6],qr[3],C0,0,0,0),   P1[10],P1[11],P1[12],P1[13], pw3[0]=PKW(P1,8), pw3[1]=PKW(P1,10), pw3); \
    GAPA(C1=__builtin_amdgcn_mfma_f32_32x32x16_bf16(kf[7],qr[3],C1,0,0,0),   P1[14],P1[15],0.f,0.f,       pw3[2]=PKW(P1,12),pw3[3]=PKW(P1,14), pw3); \
    l_reg+=sacc; \
    VRD(0,0); VRD(1,1); VRD(2,2); VRD(3,3); SBAR(); \
    if(GK){DMA_K((t)+3,sl_cur);} if(GV){DMA_V((t)+1,sl_next);} \
    CMASK(C0,C1,t); \
    { float a=MX3(C0[0],C0[1],C1[0]),b=MX3(C0[2],C0[3],C1[1]); a=MX3(a,C1[2],C1[3]); \
      _Pragma("unroll") for(int r=4;r<16;r+=4){a=MX3(a,C0[r],C0[r+1]);b=MX3(b,C0[r+2],C0[r+3]);a=MX3(a,C1[r],C1[r+1]);b=MX3(b,C1[r+2],C1[r+3]);} \
      float rm=__builtin_fmaxf(a,b); { auto rr=__builtin_amdgcn_permlane32_swap(__float_as_uint(rm),__float_as_uint(rm),false,false); rm=__builtin_fmaxf(__uint_as_float(rr[0]),__uint_as_float(rr[1])); } \
      resc=false; \
      if(__builtin_expect(__any(rm>(float)THRL),0)){ const float dl=__builtin_fmaxf(rm,0.f); mhat+=dl; \
        _Pragma("unroll") for(int r=0;r<16;++r){C0[r]-=dl;C1[r]-=dl;} \
        _Pragma("unroll") for(int r=0;r<16;++r)negm[r]=-mhat; asm volatile("":"+v"(negm)); \
        const float f=__builtin_amdgcn_exp2f(-dl); l_reg*=f; if(hi==0)wsf[r32]=f; resc=true; } } \
    SBAR(); \
    GAPB(o[0]=__builtin_amdgcn_mfma_f32_32x32x16_bf16(PAF(0),VFR(0),o[0],0,0,0), C0,0);  VRD(0,4);  SBAR(); \
    GAPB(o[1]=__builtin_amdgcn_mfma_f32_32x32x16_bf16(PAF(0),VFR(1),o[1],0,0,0), C0,2);  VRD(1,5);  SBAR(); \
    GAPB(o[2]=__builtin_amdgcn_mfma_f32_32x32x16_bf16(PAF(0),VFR(2),o[2],0,0,0), C0,4);  VRD(2,6);  SBAR(); \
    GAPB(o[3]=__builtin_amdgcn_mfma_f32_32x32x16_bf16(PAF(0),VFR(3),o[3],0,0,0), C0,6);  VRD(3,7);  SBAR(); \
    GAPB(o[0]=__builtin_amdgcn_mfma_f32_32x32x16_bf16(PAF(1),VFR(0),o[0],0,0,0), C0,8);  VRD(0,8);  SBAR(); \
    GAPB(o[1]=__builtin_amdgcn_mfma_f32_32x32x16_bf16(PAF(1),VFR(1),o[1],0,0,0), C0,10);  VRD(1,9);  SBAR(); \
    KRD(GL,0); GAPB(o[2]=__builtin_amdgcn_mfma_f32_32x32x16_bf16(PAF(1),VFR(2),o[2],0,0,0), C0,12);  VRD(2,10);  SBAR(); \
    KRD(GL,1); GAPB(o[3]=__builtin_amdgcn_mfma_f32_32x32x16_bf16(PAF(1),VFR(3),o[3],0,0,0), C0,14);  VRD(3,11);  SBAR(); \
    KRD(GL,2); GAPB(o[0]=__builtin_amdgcn_mfma_f32_32x32x16_bf16(PAF(2),VFR(0),o[0],0,0,0), C1,0);  VRD(0,12);  SBAR(); \
    KRD(GL,3); GAPB(o[1]=__builtin_amdgcn_mfma_f32_32x32x16_bf16(PAF(2),VFR(1),o[1],0,0,0), C1,2);  VRD(1,13);  SBAR(); \
    GAPB(o[2]=__builtin_amdgcn_mfma_f32_32x32x16_bf16(PAF(2),VFR(2),o[2],0,0,0), C1,4);  VRD(2,14);  SBAR(); \
    GAPB(o[3]=__builtin_amdgcn_mfma_f32_32x32x16_bf16(PAF(2),VFR(3),o[3],0,0,0), C1,6);  VRD(3,15);  SBAR(); \
    GAPB(o[0]=__builtin_amdgcn_mfma_f32_32x32x16_bf16(PAF(3),VFR(0),o[0],0,0,0), C1,8); \
    GAPB(o[1]=__builtin_amdgcn_mfma_f32_32x32x16_bf16(PAF(3),VFR(1),o[1],0,0,0), C1,10); \
    GAPB(o[2]=__builtin_amdgcn_mfma_f32_32x32x16_bf16(PAF(3),VFR(2),o[2],0,0,0), C1,12); \
    GAPB(o[3]=__builtin_amdgcn_mfma_f32_32x32x16_bf16(PAF(3),VFR(3),o[3],0,0,0), C1,14); \
    }while(0)
  int t=1;
  #undef CMASK
  #define CMASK(P0,P1,t) do{}while(0)
  for(;t+5<NT;t+=2){
    STEP(pB0,pB1,pA0,pA1,t,true,true,true);     WAIT_BAR(3); RESC(); ROT();
    STEP(pA0,pA1,pB0,pB1,t+1,true,true,true);   WAIT_BAR(3); RESC(); ROT();
  }
  #undef CMASK
  #define CMASK(P0,P1,t) do{int jb_=(t)-(NT-4); if(jb_>=0)cmask(P0,P1,jb_,qrel,hi);}while(0)
  #define ENDW(tt) do{ if((tt)+3<NT){WAIT_BAR(3);} else if((tt)+2<NT){WAIT_BAR(2);} else {WAIT_BAR(0);} }while(0)
  for(;t+1<NT;t+=2){
    STEP(pB0,pB1,pA0,pA1,t,(t+3<NT),(t+1<NT),(t+1<NT));       ENDW(t);   RESC(); ROT();
    STEP(pA0,pA1,pB0,pB1,t+1,(t+4<NT),(t+2<NT),(t+2<NT));     ENDW(t+1); RESC(); ROT();
  }
  STEP(pB0,pB1,pA0,pA1,NT-1,false,false,false); RESC();
  { float sacc=pB0[0]+pB0[1]; _Pragma("unroll") for(int r=2;r<16;++r)sacc+=pB0[r]; _Pragma("unroll") for(int r=0;r<16;++r)sacc+=pB1[r]; l_reg+=sacc;
    pw0=(u32x4){PKW(pB0,0),PKW(pB0,2),PKW(pB0,4),PKW(pB0,6)};pw1=(u32x4){PKW(pB0,8),PKW(pB0,10),PKW(pB0,12),PKW(pB0,14)};pw2=(u32x4){PKW(pB1,0),PKW(pB1,2),PKW(pB1,4),PKW(pB1,6)};pw3=(u32x4){PKW(pB1,8),PKW(pB1,10),PKW(pB1,12),PKW(pB1,14)};
    const int le_=lane_id();
    const int vb0=(int)(lds0+LDS_V)+((le_>>4)&1)*32+(le_&3)*8+(4*(le_>>5)+((le_&15)>>2))*64;
    SBAR(); pv(o,vb0+2*sl_cur,PAF(0),PAF(1),PAF(2),PAF(3)); }
  #undef PKW
  #undef PAF
  #undef VFR
  #undef PIN
  #undef MX3
  #undef GAPA
  #undef GAPB
  #undef EX
  #undef VRD
  #undef KRD
  #undef ZC
  #undef STEP
  #undef ENDW
  {auto rr=__builtin_amdgcn_permlane32_swap(__float_as_uint(l_reg),__float_as_uint(l_reg),false,false);l_reg=__uint_as_float(rr[0])+__uint_as_float(rr[1]);}
  const int le=lane_id(); const int r32e=le&31,hie=le>>5;
  if(hie==0)wsf[32+r32e]=l_reg;asm volatile("s_waitcnt lgkmcnt(0)":::"memory");
  float rli[16];
  #pragma unroll
  for(int r=0;r<16;++r)rli[r]=__builtin_amdgcn_rcpf(wsf[32+crow(r,hie)]);
  bf16*Ow=O+(rowbase+q0+wid*QBLK)*OPITCH+co;
  { bf16*stg=(bf16*)(shm+LDS_OST)+wid*2048;
    float dd[2][4][8]; float ssq[4]={0.f,0.f,0.f,0.f};
    #pragma unroll
    for(int h2=0;h2<2;++h2){
      #pragma unroll
      for(int r=0;r<16;++r){const int orow=crow(r,hie);
        #pragma unroll
        for(int d0=0;d0<2;++d0)stg[orow*64+d0*32+r32e]=__float2bfloat16(o[2*h2+d0][r]*rli[r]);}
      asm volatile("s_waitcnt lgkmcnt(0)":::"memory");
      #pragma unroll
      for(int i=0;i<4;++i){const int row=i*8+(le>>3),ch=le&7; const u32x4 v=*(const u32x4*)(stg+row*64+ch*8);
        if(!COMB){ ATTN_STORE16(Ow+(long)row*OPITCH+h2*64+ch*8,v); }
        else{ const u32x4 w=*(const u32x4*)(Ow-128+(long)row*OPITCH+h2*64+ch*8);
          #pragma unroll
          for(int k=0;k<4;++k){ const float a0=__uint_as_float(w[k]<<16),a1=__uint_as_float(w[k]&0xffff0000u),b0=__uint_as_float(v[k]<<16),b1=__uint_as_float(v[k]&0xffff0000u);
            const float e0=a0-lam*b0,e1=a1-lam*b1; dd[h2][i][2*k]=e0; dd[h2][i][2*k+1]=e1; ssq[i]+=e0*e0+e1*e1; } } }
      asm volatile("s_waitcnt lgkmcnt(0)":::"memory"); }
    if(COMB){
      #pragma unroll
      for(int i=0;i<4;++i){ float sq=ssq[i]; sq+=__shfl_xor(sq,1); sq+=__shfl_xor(sq,2); sq+=__shfl_xor(sq,4);
        const float rs=0.8f/sqrtf(sq*(1.f/128.f)+1e-6f); const int row=i*8+(le>>3),ch=le&7;
        #pragma unroll
        for(int h2=0;h2<2;++h2){ const float*gp=gain+h2*64+ch*8; u32x4 y;
          #pragma unroll
          for(int k=0;k<4;++k) y[k]=cvtpk_s(dd[h2][i][2*k]*rs*gp[2*k],dd[h2][i][2*k+1]*rs*gp[2*k+1]);
          *(u32x4*)(YC+(rowbase+q0+wid*QBLK+row)*1024+yc+h2*64+ch*8)=y; } } } }
  asm volatile("s_waitcnt lgkmcnt(0)\n\ts_barrier":::"memory");
  #undef DMA_K
  #undef DMA_V
  #undef CMASK
  #undef START
  #undef RESC
  #undef ROT
}
constexpr int ATTN_LDS_BYTES=LDS_BYTES;
struct AttnTensors { const bf16* Q; const bf16* K; const bf16* V; bf16* O; float lam; const float* gain; bf16* YC; };
struct AttnUnit { int grp; int qb; };
struct StaticOrder {
  int vcu, G, bx;
  __device__ __forceinline__ explicit StaticOrder(int grid,int block):vcu((grid%8==0)?(block%8)*(grid/8)+block/8:block),G(grid),bx(block){}
  __device__ __forceinline__ bool next(int i,AttnUnit&u)const{
    if(G==256){ if(i>=2)return false; const int s=vcu&15; u.grp=vcu>>4; u.qb=(i==0)?s:31-s; return true; }
    const int idx=bx+i*G; if(idx>=512)return false; u.grp=idx>>5; u.qb=idx&31; return true; }
};
template<class Sched,int THRL=8> __device__ __forceinline__ void attn_phase(char*lds,const AttnTensors&T,const Sched&S,int wave_){
  AttnUnit u;
  for(int i=0;S.next(i,u);++i){ const int b=u.grp>>3,vh=(u.grp&7)*2;
    attn_unit<THRL,false>(b,vh*64,(vh>>1)*128,vh*128,u.qb,T.Q,T.K,T.V,T.O,lds,0.f,nullptr,nullptr,0,wave_);
    attn_unit<THRL,true>(b,(vh+1)*64,(vh>>1)*128,(vh+1)*128,u.qb,T.Q,T.K,T.V,T.O,lds,T.lam,T.gain,T.YC,(vh>>1)*128,wave_); }
}
#undef SBAR
#undef WAIT_BAR
}
#define XB_TMO      128
#define XB_XCNT(j)  (256  + 64 * (j))
#define XB_XSUB(j)  (1280 + 64 * (j))
#define XB_XGEN(j)  (2304 + 64 * (j))
#define XB_TOP      3328
#define XB_TOPGEN   3392
#define XCD_BAR_WORDS 3456
#define XB_SPIN_CAP (1u << 18)

__device__ __forceinline__ unsigned xb_ld(unsigned* p)              { return __hip_atomic_load(p, __ATOMIC_RELAXED, __HIP_MEMORY_SCOPE_AGENT); }
__device__ __forceinline__ unsigned xb_add(unsigned* p, unsigned v) { return __hip_atomic_fetch_add(p, v, __ATOMIC_RELAXED, __HIP_MEMORY_SCOPE_AGENT); }
__device__ __forceinline__ unsigned xb_xcc_id() { return (unsigned)__builtin_amdgcn_s_getreg((3 << 11) | 20) & 0xFu; }
#define XB_SPIN(cond, bar) do { unsigned _sp = 0; while (cond) { __builtin_amdgcn_s_sleep(1); \
    if ((++_sp & 255u) == 0u) { if (xb_ld(&(bar)[XB_TMO])) break; if (_sp > XB_SPIN_CAP) { atomicAdd(&(bar)[XB_TMO], 1u); break; } } } } while (0)

struct XcdBarrier {
    unsigned* bar; unsigned x;
    volatile LAS unsigned* st;
};

__device__ __forceinline__ XcdBarrier xcd_barrier_post(unsigned* bar, volatile LAS unsigned* st, bool leader) {
    XcdBarrier b; b.bar = bar; b.x = xb_xcc_id(); b.st = st;
    if (leader) (void)xb_add(&bar[XB_XCNT(b.x)], 1u);
    return b;
}
__device__ __forceinline__ void xcd_barrier_complete(unsigned* bar, unsigned x, unsigned& nloc, unsigned& nx) {
    const unsigned G = gridDim.x * gridDim.y * gridDim.z;
    unsigned sum, cnt, mine, sp = 0u;
    for (;;) {
        sum = 0u; cnt = 0u; mine = 0u;
#pragma unroll
        for (unsigned j = 0; j < 16; ++j) { const unsigned c = xb_ld(&bar[XB_XCNT(j)]); sum += c; cnt += (c > 0u) ? 1u : 0u; mine = (j == x) ? c : mine; }
        if (sum == G) break;
        __builtin_amdgcn_s_sleep(1);
        if ((++sp & 255u) == 0u) { if (xb_ld(&bar[XB_TMO])) break; if (sp > XB_SPIN_CAP) { atomicAdd(&bar[XB_TMO], 1u); break; } }
    }
    nloc = mine > 0u ? mine : 1u; nx = cnt > 0u ? cnt : 1u;
}

__device__ __forceinline__ void xcd_barrier(const XcdBarrier& b, bool leader) {
    asm volatile("s_waitcnt vmcnt(0)" ::: "memory");
    __syncthreads();
    if (leader) {
        unsigned* bar = b.bar;
        __builtin_amdgcn_s_waitcnt(0);
        unsigned nloc = b.st[0], nx = b.st[1];
        if (nloc == 0u) { xcd_barrier_complete(bar, b.x, nloc, nx); b.st[0] = nloc; b.st[1] = nx; }
        const unsigned old = xb_add(&bar[XB_XSUB(b.x)], 1u);
        const unsigned gen = old / nloc;
        if (old + 1u == (gen + 1u) * nloc) {
            __builtin_amdgcn_fence(__ATOMIC_RELEASE, "agent");
            asm volatile("s_waitcnt vmcnt(0)" ::: "memory");
            const unsigned og = xb_add(&bar[XB_TOP], 1u);
            const unsigned tg = og / nx;
            if (og + 1u == (tg + 1u) * nx) xb_add(&bar[XB_TOPGEN], 1u);
            else XB_SPIN(xb_ld(&bar[XB_TOPGEN]) == tg, bar);
            __builtin_amdgcn_fence(__ATOMIC_ACQUIRE, "agent");
            xb_add(&bar[XB_XGEN(b.x)], 1u);
            asm volatile("s_waitcnt vmcnt(0)" ::: "memory");
        } else {
            XB_SPIN(xb_ld(&bar[XB_XGEN(b.x)]) == gen, bar);
            __builtin_amdgcn_fence(__ATOMIC_ACQUIRE, "agent");
            asm volatile("s_waitcnt vmcnt(0)" ::: "memory");
        }
    }
    __syncthreads();
}
struct Args { const void* in[32]; float* out; unsigned char* ws; int ph_lo, ph_hi, G, pad; };
typedef const __attribute__((address_space(4))) Args* KA;
__device__ __forceinline__ KA ka_fresh() { KA p = (KA)__builtin_amdgcn_kernarg_segment_ptr(); asm volatile("" : "+s"(p)); return p; }
__device__ __forceinline__ int tid_fresh(int wave) { return wave * 64 + lane_id(); }
#define INF(k) ((const float*)a->in[k])
enum { I_X = 0, I_C, I_POS, I_WADA, I_BADA, I_NMIX, I_WIN, I_BGATE, I_LQ1, I_LK1, I_LQ2, I_LK2, I_HNORM, I_CONVW, I_CONVB, I_DTB, I_ALOG, I_DSKIP, I_SSDN,
       I_WBA, I_WBS, I_WOUT, I_NFFN, I_WR, I_RB, I_WEG, I_WEU, I_WED, I_WSG, I_WSU, I_WSD, I_NFIN };

__device__ __forceinline__ void ph0_mod(KA a, LAS unsigned char* lds, int tid) {
    const float* c = INF(I_C); const float* w_ada = INF(I_WADA); const float* b_ada = INF(I_BADA); float* mod = (float*)(a->ws + WS_MOD);
    LAS float* scr = (LAS float*)lds;
    for (int wg = blockIdx.x; wg < 192; wg += gridDim.x) {
        const int kg = tid >> 3, cq = tid & 7;
        f32x4 a0 = {0.f, 0.f, 0.f, 0.f}, a1 = {0.f, 0.f, 0.f, 0.f};
#pragma unroll 4
        for (int it = 0; it < 16; ++it) { const int k = kg + 64 * it; const f32x4 w = *(const f32x4*)(w_ada + (size_t)k * 6144 + 32 * wg + 4 * cq);
            const float s0 = silu_f(c[k]), s1 = silu_f(c[1024 + k]); a0 += s0 * w; a1 += s1 * w; }
        *(LAS f32x4*)(scr + (kg * 8 + cq) * 8) = a0; *(LAS f32x4*)(scr + (kg * 8 + cq) * 8 + 4) = a1;
        __syncthreads();
        if (tid < 64) { const int b = tid >> 5, col = tid & 31; float s = 0.f;
            for (int g = 0; g < 64; ++g) s += scr[(g * 8 + (col >> 2)) * 8 + b * 4 + (col & 3)];
            mod[b * 6144 + 32 * wg + col] = s + b_ada[32 * wg + col]; }
        __syncthreads();
    }
}
__device__ __forceinline__ void ph0_misc(KA a, gu32* ctl, int gtid, int gthreads) {
    const int* pos = (const int*)a->in[I_POS]; float* cs = (float*)(a->ws + WS_CS);
    const float invf[8] = {1.0f, 0.193922758102417f, 0.03760603070259094f, 0.00729266507551074f, 0.001414213445968926f, 0.00027424818836152554f, 5.318296462064609e-05f, 1.0313385246263351e-05f};
    for (int it = gtid; it < M * 8; it += gthreads) {
        const int tok = it >> 3, i = it & 7;
        float f = invf[0];
#pragma unroll
        for (int j = 1; j < 8; ++j) f = (i == j) ? invf[j] : f;
        const float ang = (float)pos[tok] * f;
        const double ad = (double)ang; const double kk = rint(ad * 0.15915494309189535); const float r = (float)(ad - kk * 6.283185307179586);
        cs[tok * 16 + i] = __cosf(r); cs[tok * 16 + 8 + i] = __sinf(r);
    }
    if (gtid == 0) {
        float s1 = 0.f, s2 = 0.f;
        for (int i = 0; i < 64; ++i) { s1 += INF(I_LQ1)[i] * INF(I_LK1)[i]; s2 += INF(I_LQ2)[i] * INF(I_LK2)[i]; }
        const float lam = expf(s1) - expf(s2) + LAMBDA_INIT;
        ctl[CW_LAM] = __builtin_bit_cast(unsigned, lam);
    }
}
struct TrDesc { const float* src; bf16* dst; const float* ksc; int ldw, ldo; };
__device__ __forceinline__ int gu_row(int n0, int is_up) { return (n0 < 128 ? n0 : 256 + (n0 - 128)) + (is_up ? 128 : 0); }
constexpr int TR_I1 = 16 * 321, TR_I2 = 16 * 32, TR_I3 = 32 * 32, TR_I4 = 16 * 32, TR_I5 = 16 * 8, TR_I6 = 2 * 16 * 8, TR_I7 = 4 * 32, TR_I8 = 256 * 2 * 16 * 8, TR_I9 = 256 * 4 * 32;
constexpr int TR_NSMALL = TR_I1 + TR_I2 + TR_I3 + TR_I4 + TR_I5 + TR_I6 + TR_I7;
constexpr int TR_NITEMS = TR_NSMALL + TR_I8 + TR_I9;
__device__ __forceinline__ TrDesc tr_decode(KA a, int it) {
    unsigned char* ws = a->ws; TrDesc d; int r = it;
#define TRD(W_, ldw_, k0_, n0_, WT_, ldo_, orow_) do { d.src = (W_) + (size_t)(k0_) * (ldw_) + (n0_); d.ldw = (ldw_); d.dst = (WT_) + (size_t)(orow_) * (ldo_) + (k0_); d.ldo = (ldo_); d.ksc = nullptr; return d; } while (0)
    if (r < TR_I1) { const int kb = r / 321, nb = r % 321, n0 = 32 * nb; const int orow = n0 < 8192 ? n0 : (n0 < 8224 ? 10240 : n0 - 32);
        TRD(INF(I_WIN), IN_COLS, 64 * kb, n0, (bf16*)(ws + WS_WIN), 1024, orow); } r -= TR_I1;
    if (r < TR_I2) TRD(INF(I_WBA), 1024, 64 * (r / 32), 32 * (r % 32), (bf16*)(ws + WS_WA), 1024, 32 * (r % 32)); r -= TR_I2;
    if (r < TR_I3) { const int k0 = 64 * (r / 32), n0 = 32 * (r % 32);
        d.src = INF(I_WBS) + (size_t)k0 * 1024 + n0; d.ldw = 1024; d.dst = (bf16*)(ws + WS_WS) + (size_t)n0 * 2048 + k0; d.ldo = 2048; d.ksc = INF(I_SSDN) + k0; return d; } r -= TR_I3;
    if (r < TR_I4) TRD(INF(I_WOUT), 1024, 64 * (r / 32), 32 * (r % 32), (bf16*)(ws + WS_WO), 1024, 32 * (r % 32)); r -= TR_I4;
    if (r < TR_I5) TRD(INF(I_WR), 256, 64 * (r / 8), 32 * (r % 8), (bf16*)(ws + WS_WRS), 1024, 32 * (r % 8)); r -= TR_I5;
    if (r < TR_I6) { const int up = r / 128, q = r % 128, n0 = 32 * (q % 8); TRD(up ? INF(I_WSU) : INF(I_WSG), 256, 64 * (q / 8), n0, (bf16*)(ws + WS_WRS), 1024, 256 + gu_row(n0, up)); } r -= TR_I6;
    if (r < TR_I7) TRD(INF(I_WSD), 1024, 64 * (r / 32), 32 * (r % 32), (bf16*)(ws + WS_WSHD), 256, 32 * (r % 32)); r -= TR_I7;
    if (r < TR_I8) { const int e = r / 256, q = r % 256, up = q / 128, q2 = q % 128, n0 = 32 * (q2 % 8);
        TRD((up ? INF(I_WEU) : INF(I_WEG)) + (size_t)e * 1024 * 256, 256, 64 * (q2 / 8), n0, (bf16*)(ws + WS_WEGU) + (size_t)e * 512 * 1024, 1024, gu_row(n0, up)); } r -= TR_I8;
    { const int e = r / 128, q = r % 128; TRD(INF(I_WED) + (size_t)e * 256 * 1024, 1024, 64 * (q / 32), 32 * (q % 32), (bf16*)(ws + WS_WED) + (size_t)e * 1024 * 256, 256, 32 * (q % 32)); }
#undef TRD
}
__device__ __forceinline__ void tr_load(const TrDesc& d, float (&v)[32], int lane) {
#pragma unroll
    for (int i = 0; i < 32; ++i) { const int kk = 2 * i + (lane >> 5); v[i] = __builtin_nontemporal_load(d.src + (size_t)kk * d.ldw + (lane & 31)); }
    if (d.ksc) {
#pragma unroll
        for (int i = 0; i < 32; ++i) v[i] *= d.ksc[2 * i + (lane >> 5)]; }
}
__device__ __forceinline__ void tr_store(const TrDesc& d, const float (&v)[32], LAS float* scr, int lane) {
#pragma unroll
    for (int i = 0; i < 32; ++i) { const int kk = 2 * i + (lane >> 5); scr[kk * 33 + (lane & 31)] = v[i]; }
    LDS_WAIT(); asm volatile("" ::: "memory");
    const int c = lane & 7;
#pragma unroll
    for (int j = 0; j < 4; ++j) { const int n = (lane >> 3) + 8 * j; const LAS float* s = scr + (8 * c) * 33 + n;
        v4u o; o.x = pk2(s[0 * 33], s[1 * 33]); o.y = pk2(s[2 * 33], s[3 * 33]); o.z = pk2(s[4 * 33], s[5 * 33]); o.w = pk2(s[6 * 33], s[7 * 33]);
        __builtin_nontemporal_store(o, (GAS v4u*)(d.dst + (size_t)n * d.ldo + 8 * c)); }
    LDS_WAIT(); asm volatile("" ::: "memory");
}
constexpr int HELPER_CUS = 64;
constexpr int TR_SPLIT = TR_I1;
__device__ __forceinline__ void ph0_weights(KA a, LAS unsigned char* lds, int gw, int NGW, int wave, int lane, int it_lo, int it_hi) {
    LAS float* scr = (LAS float*)(lds + wave * 16384);
    for (int it = it_lo + gw; it < it_hi; it += 4 * NGW) {
        const int i1 = it + NGW, i2 = it + 2 * NGW, i3 = it + 3 * NGW;
        const bool h1 = i1 < it_hi, h2 = i2 < it_hi, h3 = i3 < it_hi;
        const TrDesc d0 = tr_decode(a, it), d1 = tr_decode(a, h1 ? i1 : it), d2 = tr_decode(a, h2 ? i2 : it), d3 = tr_decode(a, h3 ? i3 : it);
        float v0[32], v1[32], v2[32], v3[32];
        tr_load(d0, v0, lane); tr_load(d1, v1, lane); tr_load(d2, v2, lane); tr_load(d3, v3, lane);
        tr_store(d0, v0, scr, lane);
        if (h1) tr_store(d1, v1, scr, lane);
        if (h2) tr_store(d2, v2, scr, lane);
        if (h3) tr_store(d3, v3, scr, lane);
    }
}
__device__ __forceinline__ void convert_queue(KA a, LAS unsigned char* lds, gu32* qhead, int wave, int lane, int it_lo, int it_hi) {
    LAS float* scr = (LAS float*)(lds + wave * 16384);
    for (;;) {
        unsigned got = 0u; if (lane == 0) got = __hip_atomic_fetch_add(qhead, 16u, RLX_AGENT);
        const int base = it_lo + (int)__builtin_amdgcn_readfirstlane((int)got);
        if (base >= it_hi) break;
        for (int it = base; it < base + 16 && it < it_hi; it += 4) {
            const int i1 = it + 1, i2 = it + 2, i3 = it + 3;
            const bool h1 = i1 < it_hi, h2 = i2 < it_hi, h3 = i3 < it_hi;
            const TrDesc d0 = tr_decode(a, it), d1 = tr_decode(a, h1 ? i1 : it), d2 = tr_decode(a, h2 ? i2 : it), d3 = tr_decode(a, h3 ? i3 : it);
            float v0[32], v1[32], v2[32], v3[32];
            tr_load(d0, v0, lane); tr_load(d1, v1, lane); tr_load(d2, v2, lane); tr_load(d3, v3, lane);
            tr_store(d0, v0, scr, lane);
            if (h1) tr_store(d1, v1, scr, lane);
            if (h2) tr_store(d2, v2, scr, lane);
            if (h3) tr_store(d3, v3, scr, lane);
        }
    }
}
__device__ __forceinline__ v4u pack8(const f32x4 v0, const f32x4 v1) { v4u w; w.x = pk2(v0[0], v0[1]); w.y = pk2(v0[2], v0[3]); w.z = pk2(v1[0], v1[1]); w.w = pk2(v1[2], v1[3]); return w; }
__device__ __forceinline__ void unpack8(const v4u w, float* f) { f[0] = bflo(w.x); f[1] = bfhi(w.x); f[2] = bflo(w.y); f[3] = bfhi(w.y); f[4] = bflo(w.z); f[5] = bfhi(w.z); f[6] = bflo(w.w); f[7] = bfhi(w.w); }
template <bool BF16IN> __device__ __forceinline__ void norm_rows(const void* xin_, const float* gain, const float* mod, int shift_off, int scale_off, bf16* out, int gw, int NGW, int lane) {
    for (int b = 0; b < BATCH; ++b) {
        f32x4 ga[4], sh[4];
#pragma unroll
        for (int q = 0; q < 4; ++q) { const int col = 8 * lane + 512 * (q >> 1) + 4 * (q & 1);
            const f32x4 g = *(const f32x4*)(gain + col), sc = *(const f32x4*)(mod + b * 6144 + scale_off + col); sh[q] = *(const f32x4*)(mod + b * 6144 + shift_off + col); ga[q] = g * (1.f + sc); }
        int m = gw; while (m < b * SEQ) m += NGW;
        const int mend = (b + 1) * SEQ;
        f32x4 v[4], nx[4];
#define NR_LOAD(m_) do { if (BF16IN) { _Pragma("unroll") for (int jj = 0; jj < 2; ++jj) { float t_[8]; unpack8(*(const GAS v4u*)((const bf16*)xin_ + (size_t)(m_) * D + 8 * lane + 512 * jj), t_); \
                nx[2 * jj] = (f32x4){t_[0], t_[1], t_[2], t_[3]}; nx[2 * jj + 1] = (f32x4){t_[4], t_[5], t_[6], t_[7]}; } } \
            else { _Pragma("unroll") for (int q = 0; q < 4; ++q) nx[q] = *(const GAS f32x4*)((const float*)xin_ + (size_t)(m_) * D + 8 * lane + 512 * (q >> 1) + 4 * (q & 1)); } } while (0)
        if (m < mend) NR_LOAD(m);
        for (; m < mend; m += NGW) {
            float s = 0.f;
#pragma unroll
            for (int q = 0; q < 4; ++q) { v[q] = nx[q]; s += (v[q].x * v[q].x + v[q].y * v[q].y) + (v[q].z * v[q].z + v[q].w * v[q].w); }
            if (m + NGW < mend) NR_LOAD(m + NGW);
            const float rstd = 1.f / sqrtf(wave_sum(s) * (1.f / D) + EPS);
#pragma unroll
            for (int jj = 0; jj < 2; ++jj) { const f32x4 y0 = v[2 * jj] * rstd * ga[2 * jj] + sh[2 * jj], y1 = v[2 * jj + 1] * rstd * ga[2 * jj + 1] + sh[2 * jj + 1];
                v4u o; o.x = pk2(y0.x, y0.y); o.y = pk2(y0.z, y0.w); o.z = pk2(y1.x, y1.y); o.w = pk2(y1.z, y1.w);
                *(GAS v4u*)(out + (size_t)m * D + 8 * lane + 512 * jj) = o; }
        }
#undef NR_LOAD
    }
}
using pg8::Unit;

struct EpiInProj {
    KA a0;
    __device__ __forceinline__ void operator()(const f32x4 (&acc)[2][2][4][2], const Unit& u, int wr, int wc, int fr, int fq) const {
        KA a = a0; asm volatile("" : "+s"(a));
        unsigned char* ws = a->ws;
        const int pn = u.pn; const int row0 = u.pm * 256 + wr * 64 + fr, tc0 = 32 * wc + 8 * fq;
        if (pn < 8) {
            bf16* dst = (bf16*)(ws + (pn < 4 ? WS_Q : WS_K)) + (pn & 3) * 256; const float sc = pn < 4 ? QSCALE : 1.f;
            if ((wc & 1) == 0) {
                const float* cs = (const float*)(ws + WS_CS);
                constexpr int KD = 2; f32x4 c0[KD + 1], c1[KD + 1], s0[KD + 1], s1[KD + 1]; const float sg = (fq == 0) ? -1.f : 1.f; const bool rot = fq < 2;
#define EPI_LD(ir) do { const float* p_ = cs + (size_t)(row0 + ((ir) >> 2) * 128 + ((ir) & 3) * 16) * 16; c0[(ir) % (KD + 1)] = *(const f32x4*)(p_); c1[(ir) % (KD + 1)] = *(const f32x4*)(p_ + 4); \
                    s0[(ir) % (KD + 1)] = *(const f32x4*)(p_ + 8); s1[(ir) % (KD + 1)] = *(const f32x4*)(p_ + 12); } while (0)
#pragma unroll
                for (int ir = 0; ir < KD; ++ir) EPI_LD(ir);
#pragma unroll
                for (int ir = 0; ir < 8; ++ir) {
                    if (ir + KD < 8) EPI_LD(ir + KD);
                    const int ai = ir >> 2, m = ir & 3; const int row = row0 + ai * 128 + m * 16;
                    f32x4 cc0 = c0[ir % (KD + 1)], cc1 = c1[ir % (KD + 1)], ss0 = s0[ir % (KD + 1)], ss1 = s1[ir % (KD + 1)];
#pragma unroll
                    for (int jj = 0; jj < 4; ++jj) { cc0[jj] = rot ? cc0[jj] : 1.f; cc1[jj] = rot ? cc1[jj] : 1.f; ss0[jj] = rot ? ss0[jj] * sg : 0.f; ss1[jj] = rot ? ss1[jj] * sg : 0.f; }
#pragma unroll
                    for (int bj = 0; bj < 2; ++bj) {
                        f32x4 v0 = acc[ai][bj][m][0], v1 = acc[ai][bj][m][1], o0, o1;
#pragma unroll
                        for (int jj = 0; jj < 4; ++jj) { o0[jj] = __shfl_xor(v0[jj], 16); o1[jj] = __shfl_xor(v1[jj], 16); }
                        v0 = (v0 * cc0 + o0 * ss0) * sc; v1 = (v1 * cc1 + o1 * ss1) * sc;
                        *(v4u*)(dst + (size_t)row * 1024 + 128 * bj + tc0) = pack8(v0, v1);
                    }
                }
#undef EPI_LD
            } else {
#pragma unroll
                for (int it = 0; it < 16; ++it) { const int ai = it >> 3, m = (it >> 1) & 3, bj = it & 1; const int row = row0 + ai * 128 + m * 16;
                    *(v4u*)(dst + (size_t)row * 1024 + 128 * bj + tc0) = pack8(acc[ai][bj][m][0] * sc, acc[ai][bj][m][1] * sc); }
            }
        } else if (pn < 12) {
            bf16* V = (bf16*)(ws + WS_V) + (pn - 8) * 256;
#pragma unroll
            for (int it = 0; it < 16; ++it) { const int ai = it >> 3, m = (it >> 1) & 3, bj = it & 1; const int row = row0 + ai * 128 + m * 16;
                *(v4u*)(V + (size_t)row * 1024 + 128 * bj + tc0) = pack8(acc[ai][bj][m][0], acc[ai][bj][m][1]); }
        } else if (pn < 20) {
            bf16* ZS = (bf16*)(ws + WS_ZS) + (pn - 12) * 256;
#pragma unroll
            for (int it = 0; it < 16; ++it) { const int ai = it >> 3, m = (it >> 1) & 3, bj = it & 1; const int row = row0 + ai * 128 + m * 16;
                f32x4 v0 = acc[ai][bj][m][0], v1 = acc[ai][bj][m][1];
#pragma unroll
                for (int jj = 0; jj < 4; ++jj) { v0[jj] = silu_f(v0[jj]); v1[jj] = silu_f(v1[jj]); }
                *(v4u*)(ZS + (size_t)row * 2048 + 128 * bj + tc0) = pack8(v0, v1); }
        } else if (pn < 32) {
            bf16* XBC = (bf16*)(ws + WS_XBC) + (pn - 20) * 256;
#pragma unroll
            for (int it = 0; it < 16; ++it) { const int ai = it >> 3, m = (it >> 1) & 3, bj = it & 1; const int row = row0 + ai * 128 + m * 16;
                *(v4u*)(XBC + (size_t)row * 3072 + 128 * bj + tc0) = pack8(acc[ai][bj][m][0], acc[ai][bj][m][1]); }
        } else if (pn < 40) {
            bf16* GATES = (bf16*)(ws + WS_GATES) + (pn - 32) * 256; const float* b_gate = INF(I_BGATE) + (pn - 32) * 256 + tc0;
            f32x4 bg[2][2];
#pragma unroll
            for (int bj = 0; bj < 2; ++bj) { bg[bj][0] = *(const f32x4*)(b_gate + 128 * bj); bg[bj][1] = *(const f32x4*)(b_gate + 128 * bj + 4); }
#pragma unroll
            for (int it = 0; it < 16; ++it) { const int ai = it >> 3, m = (it >> 1) & 3, bj = it & 1; const int row = row0 + ai * 128 + m * 16;
                f32x4 v0 = acc[ai][bj][m][0], v1 = acc[ai][bj][m][1];
#pragma unroll
                for (int jj = 0; jj < 4; ++jj) { v0[jj] = sigmoid_f(v0[jj] + bg[bj][0][jj]); v1[jj] = sigmoid_f(v1[jj] + bg[bj][1][jj]); }
                *(v4u*)(GATES + (size_t)row * 2048 + 128 * bj + tc0) = pack8(v0, v1); }
        } else {
            if (wc == 0) {
                float* DT = (float*)(ws + WS_DT); const float* dt_bias = INF(I_DTB);
                const f32x4 b0 = *(const f32x4*)(dt_bias + tc0), b1 = *(const f32x4*)(dt_bias + tc0 + 4);
#pragma unroll
                for (int ir = 0; ir < 8; ++ir) { const int ai = ir >> 2, m = ir & 3; const int row = row0 + ai * 128 + m * 16;
                    f32x4 v0 = acc[ai][0][m][0], v1 = acc[ai][0][m][1];
#pragma unroll
                    for (int jj = 0; jj < 4; ++jj) { v0[jj] = softplus_f(v0[jj] + b0[jj]); v1[jj] = softplus_f(v1[jj] + b1[jj]); }
                    *(f32x4*)(DT + (size_t)row * 32 + tc0) = v0; *(f32x4*)(DT + (size_t)row * 32 + tc0 + 4) = v1; }
            }
        }
    }
};
struct EpiMixA {
    KA a0;
    __device__ __forceinline__ void operator()(const f32x4 (&acc)[2][2][4][2], const Unit& u, int wr, int wc, int fr, int fq) const {
        KA a = a0; asm volatile("" : "+s"(a));
        unsigned char* ws = a->ws; bf16* TMP = (bf16*)(ws + WS_TMP); const bf16* GATES = (const bf16*)(ws + WS_GATES);
        const int row0 = u.pm * 256 + wr * 64 + fr;
#pragma unroll
        for (int ai = 0; ai < 2; ++ai)
#pragma unroll
            for (int m = 0; m < 4; ++m) { const int row = row0 + ai * 128 + m * 16;
#pragma unroll
                for (int bj = 0; bj < 2; ++bj) { const int col = u.pn * 256 + 128 * bj + 32 * wc + 8 * fq;
                    float g[8]; unpack8(*(const v4u*)(GATES + (size_t)row * 2048 + col), g);
                    f32x4 v0 = acc[ai][bj][m][0], v1 = acc[ai][bj][m][1];
#pragma unroll
                    for (int j = 0; j < 4; ++j) { v0[j] *= g[j]; v1[j] *= g[4 + j]; }
                    *(v4u*)(TMP + (size_t)row * 1024 + col) = pack8(v0, v1); } }
    }
};
struct HookGrp {
    static constexpr bool ON = true; LAS const float* rs;
    __device__ __forceinline__ void operator()(f32x4 (&acc)[2][2][4][2], int t, int wr) const {
        if (t == 8 || t == 16 || t == 24) {
            const int gi = (t >> 3) - 1; const int fr = lane_id() & 15;
#pragma unroll
            for (int ai = 0; ai < 2; ++ai)
#pragma unroll
                for (int m = 0; m < 4; ++m) { const int rl = ai * 128 + wr * 64 + m * 16 + fr; const float f = rs[rl * 4 + gi] * __builtin_amdgcn_rcpf(rs[rl * 4 + gi + 1]);
#pragma unroll
                    for (int bj = 0; bj < 2; ++bj) { acc[ai][bj][m][0] = acc[ai][bj][m][0] * f; acc[ai][bj][m][1] = acc[ai][bj][m][1] * f; } }
        }
    }
};
struct EpiMixB {
    KA a0; LAS const float* rs;
    __device__ __forceinline__ void operator()(const f32x4 (&acc)[2][2][4][2], const Unit& u, int wr, int wc, int fr, int fq) const {
        KA a = a0; asm volatile("" : "+s"(a));
        unsigned char* ws = a->ws; const bf16* TMP = (const bf16*)(ws + WS_TMP); const bf16* GATES = (const bf16*)(ws + WS_GATES); bf16* MIXED = (bf16*)(ws + WS_MIXED);
        const int row0 = u.pm * 256 + wr * 64 + fr;
#pragma unroll
        for (int ai = 0; ai < 2; ++ai)
#pragma unroll
            for (int m = 0; m < 4; ++m) { const int row = row0 + ai * 128 + m * 16; const float r3 = rs[(ai * 128 + wr * 64 + m * 16 + fr) * 4 + 3];
#pragma unroll
                for (int bj = 0; bj < 2; ++bj) { const int col = u.pn * 256 + 128 * bj + 32 * wc + 8 * fq;
                    float g[8]; unpack8(*(const v4u*)(GATES + (size_t)row * 2048 + 1024 + col), g);
                    float tt[8]; unpack8(*(const v4u*)(TMP + (size_t)row * 1024 + col), tt);
                    f32x4 v0 = acc[ai][bj][m][0], v1 = acc[ai][bj][m][1];
#pragma unroll
                    for (int j = 0; j < 4; ++j) { v0[j] = tt[j] + v0[j] * g[j] * r3; v1[j] = tt[4 + j] + v1[j] * g[4 + j] * r3; }
                    *(v4u*)(MIXED + (size_t)row * 1024 + col) = pack8(v0, v1); } }
    }
};
struct EpiOut {
    KA a0;
    __device__ __forceinline__ void operator()(const f32x4 (&acc)[2][2][4][2], const Unit& u, int wr, int wc, int fr, int fq) const {
        KA a = a0; asm volatile("" : "+s"(a));
        const float* X = INF(I_X); const float* mod = (const float*)(a->ws + WS_MOD); bf16* X1 = (bf16*)(a->ws + WS_X1H);
        const int row0 = u.pm * 256 + wr * 64 + fr; const int b = (u.pm * 256) >> 13;
#pragma unroll
        for (int bj = 0; bj < 2; ++bj) { const int col = u.pn * 256 + 128 * bj + 32 * wc + 8 * fq;
            const f32x4 g0 = *(const f32x4*)(mod + b * 6144 + 2048 + col), g1 = *(const f32x4*)(mod + b * 6144 + 2048 + col + 4);
#pragma unroll
            for (int ai = 0; ai < 2; ++ai)
#pragma unroll
                for (int m = 0; m < 4; ++m) { const int row = row0 + ai * 128 + m * 16;
                    const f32x4 x0 = *(const f32x4*)(X + (size_t)row * 1024 + col), x1 = *(const f32x4*)(X + (size_t)row * 1024 + col + 4);
                    *(v4u*)(X1 + (size_t)row * 1024 + col) = pack8(x0 + g0 * acc[ai][bj][m][0], x1 + g1 * acc[ai][bj][m][1]); } }
    }
};
struct EpiRS {
    KA a0;
    __device__ __forceinline__ void operator()(const f32x4 (&acc)[2][2][4][2], const Unit& u, int wr, int wc, int fr, int fq) const {
        KA a = a0; asm volatile("" : "+s"(a));
        unsigned char* ws = a->ws; float* LOGITS = (float*)(ws + WS_LOGITS); bf16* HS = (bf16*)(ws + WS_HS);
        const int row0 = u.pm * 256 + wr * 64 + fr;
#pragma unroll
        for (int ai = 0; ai < 2; ++ai)
#pragma unroll
            for (int m = 0; m < 4; ++m) { const int row = row0 + ai * 128 + m * 16;
                if (u.pn == 0) {
#pragma unroll
                    for (int bj = 0; bj < 2; ++bj) { const int col = 128 * bj + 32 * wc + 8 * fq;
                        *(f32x4*)(LOGITS + (size_t)row * 256 + col) = acc[ai][bj][m][0]; *(f32x4*)(LOGITS + (size_t)row * 256 + col + 4) = acc[ai][bj][m][1]; }
                } else {
                    f32x4 v0, v1;
#pragma unroll
                    for (int j = 0; j < 4; ++j) { v0[j] = silu_f(acc[ai][0][m][0][j]) * acc[ai][1][m][0][j]; v1[j] = silu_f(acc[ai][0][m][1][j]) * acc[ai][1][m][1][j]; }
                    *(v4u*)(HS + (size_t)row * 256 + (u.pn - 1) * 128 + 32 * wc + 8 * fq) = pack8(v0, v1);
                }
            }
    }
};
struct EpiStore {
    KA a0; size_t off; int ldc;
    __device__ __forceinline__ void operator()(const f32x4 (&acc)[2][2][4][2], const Unit& u, int wr, int wc, int fr, int fq) const {
        KA a = a0; asm volatile("" : "+s"(a));
        bf16* O = (bf16*)(a->ws + off);
        const int row0 = u.pm * 256 + wr * 64 + fr;
#pragma unroll
        for (int ai = 0; ai < 2; ++ai)
#pragma unroll
            for (int m = 0; m < 4; ++m) { const int row = row0 + ai * 128 + m * 16;
#pragma unroll
                for (int bj = 0; bj < 2; ++bj) *(v4u*)(O + (size_t)row * ldc + u.pn * 256 + 128 * bj + 32 * wc + 8 * fq) = pack8(acc[ai][bj][m][0], acc[ai][bj][m][1]); }
    }
};
struct MoeTab { LAS int* tile; LAS unsigned* rowoff; int ntiles; };
__device__ __forceinline__ int moe_build_tiles(gu32* ctl, LAS unsigned char* lds, LAS int* tile, int tid) {
    LAS int* sc = (LAS int*)lds;
    int nt = 0;
    if (tid < 256) { const int c = (int)__hip_atomic_load(ctl + CW_CNT + tid, RLX_AGENT); nt = (c + 255) >> 8; sc[tid] = nt; ((LAS int*)(lds + 2048))[tid] = c; }
    __syncthreads();
    int cur = 0;
    for (int o = 1; o < 256; o <<= 1) {
        int v = 0;
        if (tid < 256) { v = sc[cur * 256 + tid]; if (tid >= o) v += sc[cur * 256 + tid - o]; sc[(cur ^ 1) * 256 + tid] = v; }
        __syncthreads(); cur ^= 1;
    }
    const int total = sc[cur * 256 + 255];
    if (tid < 256) { const int end = sc[cur * 256 + tid], start = end - nt; for (int t = 0; t < nt; ++t) tile[start + t] = tid | (t << 16); }
    __syncthreads();
    return total;
}
struct MoeOrder1 {
    const char* H2; const char* W; LAS const int* tile; LAS const unsigned* rtab; int ntiles, G, c;
    static constexpr bool GATHER = true;
    __device__ __forceinline__ bool next(int i, Unit& u) const { const int idx = i * G + c; if (idx >= 2 * ntiles) return false; const int t = tile[idx >> 1]; u.pm = idx >> 1; u.pn = idx & 1; u.aux = t; u.ui = i; return true; }
    __device__ __forceinline__ const char* abase(const Unit&) const { return H2; }
    __device__ __forceinline__ const char* bbase(const Unit& u) const { return W + ((size_t)(u.aux & 0xffff) * 512 + (size_t)u.pn * 256) * 1024 * 2; }
    __device__ __forceinline__ unsigned rowoff(int ui, int r) const { return rtab[ui * 256 + r]; }
    __device__ __forceinline__ bool full(const Unit& u) const { return ((u.aux >> 30) & 1) == 0; }
};
struct EpiMoe1 {
    KA a0;
    __device__ __forceinline__ void operator()(const f32x4 (&acc)[2][2][4][2], const Unit& u, int wr, int wc, int fr, int fq) const {
        KA a = a0; asm volatile("" : "+s"(a));
        bf16* HE = (bf16*)(a->ws + WS_HE);
        const int row0 = u.pm * 256 + wr * 64 + fr; const bool half = (u.aux >> 30) & 1;
#pragma unroll
        for (int ai = 0; ai < 2; ++ai)
#pragma unroll
            for (int m = 0; m < 4; ++m) { const int row = row0 + ai * 128 + m * 16;
                f32x4 v0, v1;
#pragma unroll
                for (int j = 0; j < 4; ++j) { v0[j] = silu_f(acc[ai][0][m][0][j]) * acc[ai][1][m][0][j]; v1[j] = silu_f(acc[ai][0][m][1][j]) * acc[ai][1][m][1][j]; }
                *(v4u*)(HE + (size_t)row * 256 + u.pn * 128 + 32 * wc + 8 * fq) = pack8(v0, v1); }
    }
};
constexpr int MOE2_MAXU = 12;
struct MoeOrder2 {
    const char* HE; const char* W; LAS const unsigned* utab; int ntiles, G, c;
    static constexpr bool GATHER = false;
    __device__ __forceinline__ bool next(int i, Unit& u) const { const int idx = i * G + c; if (i >= MOE2_MAXU || idx >= 4 * ntiles) return false; u.pm = idx >> 2; u.pn = idx & 3; u.aux = (int)utab[i * 257 + 256]; u.ui = i; return true; }
    __device__ __forceinline__ const char* abase(const Unit& u) const { return HE + (size_t)u.pm * 256 * 256 * 2; }
    __device__ __forceinline__ const char* bbase(const Unit& u) const { return W + ((size_t)(u.aux & 0xffff) * 1024 + (size_t)u.pn * 256) * 256 * 2; }
    __device__ __forceinline__ unsigned rowoff(int, int) const { return 0u; }
    __device__ __forceinline__ bool full(const Unit& u) const { return ((u.aux >> 30) & 1) == 0; }
};
struct EpiMoe2 {
    KA a0; LAS const unsigned* utab;
    __device__ __forceinline__ void operator()(const f32x4 (&acc)[2][2][4][2], const Unit& u, int wr, int wc, int fr, int fq) const {
        KA a = a0; asm volatile("" : "+s"(a));
        unsigned char* YPAIR = a->ws + WS_YPAIR + u.pn * 256 + 32 * wc + 8 * (fq & ~1);
        const bool odd = (fq & 1) != 0;
#pragma unroll
        for (int ai = 0; ai < 2; ++ai)
#pragma unroll
            for (int k = 0; k < 2; ++k) {
                const unsigned entA = utab[u.ui * 257 + ai * 128 + wr * 64 + (2 * k) * 16 + fr], entB = utab[u.ui * 257 + ai * 128 + wr * 64 + (2 * k + 1) * 16 + fr];
                const float wA = 16.f * (float)__builtin_bit_cast(_Float16, (unsigned short)(entA & 0x7fffu)), wB = 16.f * (float)__builtin_bit_cast(_Float16, (unsigned short)(entB & 0x7fffu));
                const unsigned ent = odd ? entB : entA;
#pragma unroll
                for (int bj = 0; bj < 2; ++bj) {
                    const f32x4 a0v = acc[ai][bj][2 * k][0] * wA, a1v = acc[ai][bj][2 * k][1] * wA, b0v = acc[ai][bj][2 * k + 1][0] * wB, b1v = acc[ai][bj][2 * k + 1][1] * wB;
                    int A0 = __builtin_amdgcn_cvt_pk_fp8_f32(a0v[0], a0v[1], 0, false); A0 = __builtin_amdgcn_cvt_pk_fp8_f32(a0v[2], a0v[3], A0, true);
                    int A1 = __builtin_amdgcn_cvt_pk_fp8_f32(a1v[0], a1v[1], 0, false); A1 = __builtin_amdgcn_cvt_pk_fp8_f32(a1v[2], a1v[3], A1, true);
                    int B0 = __builtin_amdgcn_cvt_pk_fp8_f32(b0v[0], b0v[1], 0, false); B0 = __builtin_amdgcn_cvt_pk_fp8_f32(b0v[2], b0v[3], B0, true);
                    int B1 = __builtin_amdgcn_cvt_pk_fp8_f32(b1v[0], b1v[1], 0, false); B1 = __builtin_amdgcn_cvt_pk_fp8_f32(b1v[2], b1v[3], B1, true);
                    const auto r0 = __builtin_amdgcn_permlane16_swap((unsigned)A0, (unsigned)B0, false, false), r1 = __builtin_amdgcn_permlane16_swap((unsigned)A1, (unsigned)B1, false, false);
                    if (ent != 0xffffffffu) *(v4u*)(YPAIR + (size_t)(ent >> 15) * 1024 + 128 * bj) = (v4u){r0[0], r1[0], r0[1], r1[1]};
                }
            }
    }
};
typedef short v4i16_t __attribute__((ext_vector_type(4)));
__device__ __forceinline__ s16x4 trd(const LAS bf16* p) { return __builtin_bit_cast(s16x4, __builtin_amdgcn_ds_read_tr16_b64_v4i16((LAS v4i16_t*)p)); }
__device__ __forceinline__ bf16x8 frag_tr(const LAS bf16* T, int pitch, int l0, int c0, int lane) {
    const int g4 = lane >> 4, i = lane & 15, q = i >> 2, pp = i & 3;
    const LAS bf16* p = T + (l0 + 8 * g4 + q) * pitch + c0 + 4 * pp;
    const s16x4 lo = trd(p), hi = trd(p + 4 * pitch);
    return (bf16x8){lo[0], lo[1], lo[2], lo[3], hi[0], hi[1], hi[2], hi[3]};
}
__device__ __forceinline__ bf16x8 frag_nat(const LAS bf16* T, int pitch, int r0, int k0, int lane) {
    return *(const LAS bf16x8*)(T + (r0 + (lane & 15)) * pitch + k0 + 8 * (lane >> 4));
}
#define MFMA16(a, b, c) __builtin_amdgcn_mfma_f32_16x16x32_bf16((a), (b), (c), 0, 0, 0)

constexpr int S_BP = 136;
constexpr int S_XP4 = 264;
constexpr int S_XP = 72;

__device__ __forceinline__ void conv_part(KA a, int tok0, int c, int g, int cg_lo, int ncg, LAS unsigned char* lds, int tid) {
    const bf16* XBC = (const bf16*)(a->ws + WS_XBC); bf16* XS = (bf16*)(a->ws + WS_XS); bf16* BC = (bf16*)(a->ws + WS_BC);
    LAS bf16* sB = (LAS bf16*)lds; LAS bf16* sX = (LAS bf16*)(lds + 34816); const LAS float* sW = (const LAS float*)(lds + 106496);
    const int cg = cg_lo + tid % ncg, tg = tid / ncg, ntok = 128 / (512 / ncg);
    int gch; if (cg < 64) gch = g * 512 + cg * 8; else if (cg < 80) gch = 2048 + g * 128 + (cg - 64) * 8; else gch = 2560 + g * 128 + (cg - 80) * 8;
    float w[4][8], bias[8];
    asm volatile("" ::: "memory");
#pragma unroll
    for (int j = 0; j < 4; ++j) { const f32x4 w0 = *(const f32x4*)(INF(I_CONVW) + j * 3072 + gch), w1 = *(const f32x4*)(INF(I_CONVW) + j * 3072 + gch + 4);
#pragma unroll
        for (int i = 0; i < 4; ++i) { w[j][i] = w0[i]; w[j][4 + i] = w1[i]; } }
    { const f32x4 b0 = *(const f32x4*)(INF(I_CONVB) + gch), b1 = *(const f32x4*)(INF(I_CONVB) + gch + 4);
#pragma unroll
        for (int i = 0; i < 4; ++i) { bias[i] = b0[i]; bias[4 + i] = b1[i]; } }
    const int l_lo = tg * ntok;
    v4u r0, r1, r2;
    const bf16* src = XBC + (size_t)(tok0 + l_lo) * 3072 + gch;
    { const int sp = c * 128 + l_lo;
      const v4u z = {0u, 0u, 0u, 0u};
      r0 = sp >= 3 ? *(const v4u*)(src - 3 * 3072) : z;
      r1 = sp >= 2 ? *(const v4u*)(src - 2 * 3072) : z;
      r2 = sp >= 1 ? *(const v4u*)(src - 1 * 3072) : z; }
    v4u rn[4];
#pragma unroll
    for (int k = 0; k < 4; ++k) rn[k] = *(const v4u*)(src + (size_t)k * 3072);
    for (int tb = 0; tb < ntok; tb += 4) {
        v4u rr[4];
#pragma unroll
        for (int k = 0; k < 4; ++k) rr[k] = rn[k];
        if (tb + 4 < ntok) {
#pragma unroll
            for (int k = 0; k < 4; ++k) rn[k] = *(const v4u*)(src + (size_t)(tb + 4 + k) * 3072);
        }
#pragma unroll
        for (int k = 0; k < 4; ++k) {
            const int l = l_lo + tb + k; const v4u r3 = rr[k];
            float x0[8], x1[8], x2[8], x3[8], o[8];
            unpack8(r0, x0); unpack8(r1, x1); unpack8(r2, x2); unpack8(r3, x3);
#pragma unroll
            for (int i = 0; i < 8; ++i) { const float v = bias[i] + w[0][i] * x0[i] + w[1][i] * x1[i] + w[2][i] * x2[i] + w[3][i] * x3[i]; o[i] = silu_f(v); }
            v4u pk; pk.x = pk2(o[0], o[1]); pk.y = pk2(o[2], o[3]); pk.z = pk2(o[4], o[5]); pk.w = pk2(o[6], o[7]);
            if (cg < 64) {
                *(v4u*)(XS + (size_t)(tok0 + l) * 2048 + g * 512 + cg * 8) = pk;
                const float sc = sW[(cg >> 3) * 128 + l];
                v4u ps; ps.x = pk2(o[0] * sc, o[1] * sc); ps.y = pk2(o[2] * sc, o[3] * sc); ps.z = pk2(o[4] * sc, o[5] * sc); ps.w = pk2(o[6] * sc, o[7] * sc);
                *(LAS v4u*)(sX + l * S_XP4 + (cg & 31) * 8) = ps;
            } else if (cg < 80) {
                *(v4u*)(BC + (size_t)(tok0 + l) * 1024 + g * 128 + (cg - 64) * 8) = pk;
                *(LAS v4u*)(sB + l * S_BP + (cg - 64) * 8) = pk;
            } else {
                *(v4u*)(BC + (size_t)(tok0 + l) * 1024 + 512 + g * 128 + (cg - 80) * 8) = pk;
            }
            r0 = r1; r1 = r2; r2 = r3;
        }
    }
}
__device__ __forceinline__ void ssd_s1_unit(KA a, int unit, LAS unsigned char* lds, int tid, int wave, int lane) {
    const int g = unit & 3, c = (unit >> 2) & 63, b = unit >> 8; const int tok0 = b * SEQ + c * 128;
    const float* DT = (const float*)(a->ws + WS_DT); float* ACUM = (float*)(a->ws + WS_ACUM); bf16* CHST = (bf16*)(a->ws + WS_CHST);
    LAS bf16* sB = (LAS bf16*)lds; LAS bf16* sX = (LAS bf16*)(lds + 34816); LAS float* sAc = (LAS float*)(lds + 102400); LAS float* sW = (LAS float*)(lds + 106496);
    { const int hh = g * 8 + wave; const float a_neg = -expf(INF(I_ALOG)[hh]);
      const float d0 = DT[(size_t)(tok0 + lane) * 32 + hh], d1 = DT[(size_t)(tok0 + 64 + lane) * 32 + hh];
      float v0 = d0 * a_neg, v1 = d1 * a_neg;
#pragma unroll
      for (int o = 1; o < 64; o <<= 1) { const float t0 = __shfl_up(v0, o), t1 = __shfl_up(v1, o); if (lane >= o) { v0 += t0; v1 += t1; } }
      v1 += __shfl(v0, 63);
      const float alast = __shfl(v1, 63);
      ACUM[(size_t)(tok0 + lane) * 32 + hh] = v0; ACUM[(size_t)(tok0 + 64 + lane) * 32 + hh] = v1;
      sAc[wave * 128 + lane] = v0; sAc[wave * 128 + 64 + lane] = v1;
      sW[wave * 128 + lane] = d0 * __expf(alast - v0); sW[wave * 128 + 64 + lane] = d1 * __expf(alast - v1); }
    __syncthreads();
    for (int pass = 0; pass < 2; ++pass) {
        if (pass == 0) conv_part(a, tok0, c, g, 0, 32, lds, tid);
        else           conv_part(a, tok0, c, g, 32, 32, lds, tid);
        if (pass == 0) conv_part(a, tok0, c, g, 64, 32, lds, tid);
        __syncthreads();
        const int hl = wave >> 1, pt0 = 2 * (wave & 1);
        f32x4 acc[2][8];
#pragma unroll
        for (int i = 0; i < 2; ++i)
#pragma unroll
            for (int j = 0; j < 8; ++j) acc[i][j] = (f32x4){0.f, 0.f, 0.f, 0.f};
#pragma unroll
        for (int ks = 0; ks < 4; ++ks) {
            bf16x8 bx[2];
#pragma unroll
            for (int i = 0; i < 2; ++i) bx[i] = frag_tr(sX, S_XP4, 32 * ks, hl * 64 + 16 * (pt0 + i), lane);
#pragma unroll
            for (int nt = 0; nt < 8; ++nt) { const bf16x8 an = frag_tr(sB, S_BP, 32 * ks, 16 * nt, lane);
#pragma unroll
                for (int i = 0; i < 2; ++i) acc[i][nt] = MFMA16(an, bx[i], acc[i][nt]); }
        }
        { const int hh = g * 8 + pass * 4 + hl; bf16* dst = CHST + ((size_t)((b * 64 + c) * 32 + hh) * 64) * 128;
          const int g4 = lane >> 4; bf16* drow = dst + (size_t)(16 * (pt0 + (g4 & 1)) + (lane & 15)) * 128 + 4 * (g4 & ~1);
#pragma unroll
          for (int nt = 0; nt < 8; ++nt) {
              const unsigned ax = pk2(acc[0][nt][0], acc[0][nt][1]), ay = pk2(acc[0][nt][2], acc[0][nt][3]), bx_ = pk2(acc[1][nt][0], acc[1][nt][1]), by = pk2(acc[1][nt][2], acc[1][nt][3]);
              const auto r0 = __builtin_amdgcn_permlane16_swap(ax, bx_, false, false), r1 = __builtin_amdgcn_permlane16_swap(ay, by, false, false);
              *(v4u*)(drow + 16 * nt) = (v4u){r0[0], r1[0], r0[1], r1[1]}; } }
        __syncthreads();
    }
}
__device__ __forceinline__ void ssd_s2_item(KA a, int item, int tid) {
    const int pq = item & 3, hh = (item >> 2) & 31, b = item >> 7;
    const bf16* CHST = (const bf16*)(a->ws + WS_CHST); bf16* STIN = (bf16*)(a->ws + WS_STIN); const float* ACUM = (const float*)(a->ws + WS_ACUM);
    const size_t off = (size_t)(pq * 16) * 128 + (size_t)tid * 4;
    float s[4] = {0.f, 0.f, 0.f, 0.f};
    v2u wn[8]; float decn[8];
#define S2_LOAD(c0_) do { _Pragma("unroll") for (int j = 0; j < 8; ++j) { const size_t base = ((size_t)((b * 64 + (c0_) + j) * 32 + hh) * 64) * 128 + off; \
        wn[j] = *(const v2u*)(CHST + base); decn[j] = ACUM[(size_t)(b * SEQ + ((c0_) + j) * 128 + 127) * 32 + hh]; } } while (0)
    S2_LOAD(0);
    for (int c0 = 0; c0 < 64; c0 += 8) {
        v2u w[8]; float dec[8];
#pragma unroll
        for (int j = 0; j < 8; ++j) { w[j] = wn[j]; dec[j] = decn[j]; }
        if (c0 + 8 < 64) S2_LOAD(c0 + 8);
#pragma unroll
        for (int j = 0; j < 8; ++j) { const size_t base = ((size_t)((b * 64 + c0 + j) * 32 + hh) * 64) * 128 + off;
            v2u o; o.x = pk2(s[0], s[1]); o.y = pk2(s[2], s[3]); *(v2u*)(STIN + base) = o;
            const float d = __expf(dec[j]);
            s[0] = s[0] * d + bflo(w[j].x); s[1] = s[1] * d + bfhi(w[j].x); s[2] = s[2] * d + bflo(w[j].y); s[3] = s[3] * d + bfhi(w[j].y); }
    }
#undef S2_LOAD
}
template <int NHEADS> __device__ __forceinline__ void ssd_s3_unit_t(KA a, int unit, LAS unsigned char* lds, int tid, int wave, int lane) {
    const int g = unit & 3, c = (unit >> 2) & 63, b = unit >> 8; const int tok0 = b * SEQ + c * 128;
    const bf16* XS = (const bf16*)(a->ws + WS_XS); const bf16* BC = (const bf16*)(a->ws + WS_BC); const bf16* ZS = (const bf16*)(a->ws + WS_ZS);
    const bf16* STIN = (const bf16*)(a->ws + WS_STIN); const float* DT = (const float*)(a->ws + WS_DT); const float* ACUM = (const float*)(a->ws + WS_ACUM);
    bf16* YC = (bf16*)(a->ws + WS_YCAT);
    LAS bf16* sBn = (LAS bf16*)lds; LAS bf16* sG = (LAS bf16*)lds; LAS bf16* sC = (LAS bf16*)(lds + 34816); LAS bf16* sX = (LAS bf16*)(lds + 69632); LAS bf16* sS = (LAS bf16*)(lds + 88064);
    LAS float* sAc = (LAS float*)(lds + 105472); LAS float* sDt = (LAS float*)(lds + 109568); LAS float* sSS = (LAS float*)(lds + 113664);
    const int g4 = lane >> 4, li_ = lane & 15;
    const int pt = wave & 3, par = wave >> 2;
    v4u px[2], ps[2];
#define S3_LOADHEAD(hg_) do { _Pragma("unroll") for (int k = 0; k < 2; ++k) { const int piece = tid + 512 * k; \
        px[k] = *(const v4u*)(XS + (size_t)(tok0 + (piece >> 3)) * 2048 + (hg_) * 64 + (piece & 7) * 8); \
        ps[k] = *(const v4u*)(STIN + ((size_t)((b * 64 + c) * 32 + (hg_)) * 64 + (piece >> 4)) * 128 + (piece & 15) * 8); } } while (0)
    S3_LOADHEAD(g * 8);
#pragma unroll
    for (int k = 0; k < 4; ++k) { const int piece = tid + 512 * k, row = piece >> 4, ch = piece & 15;
        *(LAS v4u*)(sBn + row * S_BP + ch * 8) = *(const v4u*)(BC + (size_t)(tok0 + row) * 1024 + g * 128 + ch * 8);
        *(LAS v4u*)(sC + row * S_BP + ch * 8) = *(const v4u*)(BC + (size_t)(tok0 + row) * 1024 + 512 + g * 128 + ch * 8); }
#pragma unroll
    for (int k = 0; k < 2; ++k) { const int idx = tid + 512 * k, hh = idx >> 7, l = idx & 127;
        sAc[idx] = ACUM[(size_t)(tok0 + l) * 32 + g * 8 + hh]; sDt[idx] = DT[(size_t)(tok0 + l) * 32 + g * 8 + hh]; }
    __syncthreads();
    f32x4 GT[5]; int pli[5], psi[5];
#pragma unroll
    for (int j = 0; j < 5; ++j) { const int q = wave + 8 * j; int L = 0; while ((L + 1) * (L + 2) / 2 <= q) ++L; pli[j] = L; psi[j] = q - L * (L + 1) / 2;
        GT[j] = (f32x4){0.f, 0.f, 0.f, 0.f};
        if (q < 36) {
#pragma unroll
            for (int ks = 0; ks < 4; ++ks) GT[j] = MFMA16(frag_nat(sBn, S_BP, 16 * psi[j], 32 * ks, lane), frag_nat(sC, S_BP, 16 * pli[j], 32 * ks, lane), GT[j]); } }
    float ss[4] = {0.f, 0.f, 0.f, 0.f};
    for (int hh = 0; hh < NHEADS; ++hh) {
        const int hg = g * 8 + hh;
        __syncthreads();
        if (hh == 0) { const int blk = tid >> 7, r = (tid >> 3) & 15, cc = tid & 7;
            *(LAS unsigned*)(sG + (32 * blk + r) * S_BP + 32 * blk + 16 + 2 * cc) = 0u; }
#pragma unroll
        for (int k = 0; k < 2; ++k) { const int piece = tid + 512 * k;
            *(LAS v4u*)(sX + (piece >> 3) * S_XP + (piece & 7) * 8) = px[k];
            *(LAS v4u*)(sS + (piece >> 4) * S_BP + (piece & 15) * 8) = ps[k]; }
        if (hh < NHEADS - 1) S3_LOADHEAD(hg + 1);
        v2u zw[4];
#pragma unroll
        for (int j = 0; j < 4; ++j) zw[j] = *(const v2u*)(ZS + (size_t)(tok0 + 16 * (par + 2 * j) + li_) * 2048 + hg * 64 + 16 * pt + 4 * g4);
#pragma unroll
        for (int j = 0; j < 5; ++j) {
            if (wave + 8 * j < 36) {
                const int l = 16 * pli[j] + li_, s0 = 16 * psi[j] + 4 * g4;
                const float al = sAc[hh * 128 + l];
                const f32x4 as = *(const LAS f32x4*)(sAc + hh * 128 + s0), ds = *(const LAS f32x4*)(sDt + hh * 128 + s0);
                float v[4];
#pragma unroll
                for (int r = 0; r < 4; ++r) v[r] = (s0 + r <= l) ? GT[j][r] * __expf(al - as[r]) * ds[r] : 0.f;
                v2u w; w.x = pk2(v[0], v[1]); w.y = pk2(v[2], v[3]);
                *(LAS v2u*)(sG + l * S_BP + s0) = w;
            }
        }
        __syncthreads();
        bf16x8 xa[4], sa[4];
#pragma unroll
        for (int ks = 0; ks < 4; ++ks) { xa[ks] = frag_tr(sX, S_XP, 32 * ks, 16 * pt, lane); sa[ks] = frag_nat(sS, S_BP, 16 * pt, 32 * ks, lane); }
        const float dsk = INF(I_DSKIP)[hg];
        v2u yw[4];
#pragma unroll
        for (int j = 0; j < 4; ++j) {
            const int lt = par + 2 * j, l = 16 * lt + li_;
            f32x4 yd = {0.f, 0.f, 0.f, 0.f}, yo = {0.f, 0.f, 0.f, 0.f};
#pragma unroll
            for (int ks = 0; ks < 4; ++ks) { if (ks <= (lt >> 1)) yd = MFMA16(xa[ks], frag_nat(sG, S_BP, 16 * lt, 32 * ks, lane), yd); }
#pragma unroll
            for (int ks = 0; ks < 4; ++ks) yo = MFMA16(sa[ks], frag_nat(sC, S_BP, 16 * lt, 32 * ks, lane), yo);
            const float el = __expf(sAc[hh * 128 + l]);
            const int p0 = 16 * pt + 4 * g4;
            const v2u xw = *(const LAS v2u*)(sX + l * S_XP + p0);
            const float xs[4] = {bflo(xw.x), bfhi(xw.x), bflo(xw.y), bfhi(xw.y)}, zs[4] = {bflo(zw[j].x), bfhi(zw[j].x), bflo(zw[j].y), bfhi(zw[j].y)};
            float y[4];
#pragma unroll
            for (int r = 0; r < 4; ++r) { y[r] = (yd[r] + el * yo[r] + dsk * xs[r]) * zs[r]; ss[j] += y[r] * y[r]; }
            yw[j].x = pk2(y[0], y[1]); yw[j].y = pk2(y[2], y[3]);
        }
#pragma unroll
        for (int q = 0; q < 2; ++q) {
            const auto r0 = __builtin_amdgcn_permlane16_swap(yw[2 * q].x, yw[2 * q + 1].x, false, false), r1 = __builtin_amdgcn_permlane16_swap(yw[2 * q].y, yw[2 * q + 1].y, false, false);
            const int l = 16 * (par + 2 * (2 * q + (g4 & 1))) + li_;
            *(v4u*)(YC + (size_t)(tok0 + l) * 3072 + 1024 + hg * 64 + 16 * pt + 4 * (g4 & ~1)) = (v4u){r0[0], r1[0], r0[1], r1[1]};
        }
    }
#undef S3_LOADHEAD
#pragma unroll
    for (int j = 0; j < 4; ++j) { float s = ss[j]; s += __shfl_xor(s, 16); s += __shfl_xor(s, 32); if (g4 == 0) sSS[(16 * (par + 2 * j) + li_) * 4 + pt] = s; }
    __syncthreads();
    if (tid < 128) { const f32x4 p4 = *(const LAS f32x4*)(sSS + tid * 4);
        ((float*)(a->ws + WS_RSTD))[(size_t)(tok0 + tid) * 4 + g] = 1.f / sqrtf(((p4[0] + p4[1]) + (p4[2] + p4[3])) * (1.f / 512.f) + EPS); }
    __syncthreads();
}
__device__ __forceinline__ void ssd_s3_unit(KA a, int unit, LAS unsigned char* lds, int tid, int wave, int lane) { ssd_s3_unit_t<8>(a, unit, lds, tid, wave, lane); }
__device__ __forceinline__ void attn_combine(KA a, float lam, int gw, int NGW, int lane) {
    const bf16* O = (const bf16*)(a->ws + WS_O); bf16* YC = (bf16*)(a->ws + WS_YA);
    const int h8 = lane >> 3, jj = lane & 7;
    float gn[16];
#pragma unroll
    for (int k = 0; k < 4; ++k) { const f32x4 t = *(const f32x4*)(INF(I_HNORM) + 16 * jj + 4 * k); gn[4 * k] = t[0]; gn[4 * k + 1] = t[1]; gn[4 * k + 2] = t[2]; gn[4 * k + 3] = t[3]; }
    for (int m0 = gw; m0 < M; m0 += 4 * NGW) {
        v4u ra[4][4];
#pragma unroll
        for (int u = 0; u < 4; ++u) { const int m = m0 + u * NGW; const bf16* o0 = O + (size_t)(m < M ? m : m0) * 2048 + (2 * h8) * 128 + 16 * jj;
            ra[u][0] = *(const v4u*)o0; ra[u][1] = *(const v4u*)(o0 + 8); ra[u][2] = *(const v4u*)(o0 + 128); ra[u][3] = *(const v4u*)(o0 + 136); }
#pragma unroll
        for (int u = 0; u < 4; ++u) { const int m = m0 + u * NGW; if (m >= M) continue;
            float a0[16], a1[16], d[16];
            unpack8(ra[u][0], a0); unpack8(ra[u][1], a0 + 8); unpack8(ra[u][2], a1); unpack8(ra[u][3], a1 + 8);
            float s = 0.f;
#pragma unroll
            for (int k = 0; k < 16; ++k) { d[k] = a0[k] - lam * a1[k]; s += d[k] * d[k]; }
            s += __shfl_xor(s, 1); s += __shfl_xor(s, 2); s += __shfl_xor(s, 4);
            const float rstd = (1.f - LAMBDA_INIT) / sqrtf(s * (1.f / 128.f) + EPS);
            v4u w0, w1;
            w0.x = pk2(d[0] * rstd * gn[0], d[1] * rstd * gn[1]); w0.y = pk2(d[2] * rstd * gn[2], d[3] * rstd * gn[3]); w0.z = pk2(d[4] * rstd * gn[4], d[5] * rstd * gn[5]); w0.w = pk2(d[6] * rstd * gn[6], d[7] * rstd * gn[7]);
            w1.x = pk2(d[8] * rstd * gn[8], d[9] * rstd * gn[9]); w1.y = pk2(d[10] * rstd * gn[10], d[11] * rstd * gn[11]); w1.z = pk2(d[12] * rstd * gn[12], d[13] * rstd * gn[13]); w1.w = pk2(d[14] * rstd * gn[14], d[15] * rstd * gn[15]);
            bf16* y = YC + (size_t)m * 1024 + h8 * 128 + 16 * jj;
            *(v4u*)y = w0; *(v4u*)(y + 8) = w1; }
    }
}
template <bool DRY> __device__ __forceinline__ void route_tokens_t(KA a, gu32* ctl, int gw, int NGW, int lane) {
    const float* LOG = (const float*)(a->ws + WS_LOGITS); int* LIST = (int*)(a->ws + WS_LIST); float* PAIRW = (float*)(a->ws + WS_PAIRW);
    const int sl = lane & 15, tk = lane >> 4, lbase = lane & 48;
    float bias[16];
#pragma unroll
    for (int q = 0; q < 4; ++q) { const f32x4 t = *(const f32x4*)(INF(I_RB) + 16 * sl + 4 * q); bias[4 * q] = t[0]; bias[4 * q + 1] = t[1]; bias[4 * q + 2] = t[2]; bias[4 * q + 3] = t[3]; }
    const float NEG = -INFINITY;
    f32x4 lgn[4]; bool have = false; unsigned ppos = 0u; int pe = 0, pm = 0; float pw = 0.f;
    if (gw < M / 4) {
#pragma unroll
        for (int q = 0; q < 4; ++q) lgn[q] = *(const f32x4*)(LOG + (size_t)(4 * gw + tk) * 256 + 16 * sl + 4 * q); }
    for (int task = gw; task < M / 4; task += NGW) {
        const int m = 4 * task + tk;
        float sc[16], cm[16];
        f32x4 lgc[4];
#pragma unroll
        for (int q = 0; q < 4; ++q) lgc[q] = lgn[q];
        if (task + NGW < M / 4) {
#pragma unroll
            for (int q = 0; q < 4; ++q) lgn[q] = *(const f32x4*)(LOG + (size_t)(4 * (task + NGW) + tk) * 256 + 16 * sl + 4 * q); }
#pragma unroll
        for (int q = 0; q < 4; ++q) { const f32x4 lg = lgc[q];
#pragma unroll
            for (int r = 0; r < 4; ++r) { sc[4 * q + r] = sigmoid_f(lg[r]); cm[4 * q + r] = sc[4 * q + r] + bias[4 * q + r]; } }
        float t1 = NEG, t2 = NEG;
#pragma unroll
        for (int j = 0; j < 16; ++j) { const float v = cm[j]; const float n2 = fmaxf(fminf(t1, v), t2); t1 = fmaxf(t1, v); t2 = n2; }
        { const float o1 = __shfl_xor(t1, 1), o2 = __shfl_xor(t2, 1); const float n1 = fmaxf(t1, o1), n2 = fmaxf(fminf(t1, o1), fmaxf(t2, o2)); t1 = n1; t2 = n2; }
        const float gs = t1 + t2; const int mygrp = sl >> 1;
        int rank = 0;
#pragma unroll
        for (int gg = 0; gg < 8; ++gg) { const float o = __shfl(gs, lbase + 2 * gg); rank += ((o > gs) || (o == gs && gg < mygrp)) ? 1 : 0; }
        if (rank >= 4) {
#pragma unroll
            for (int j = 0; j < 16; ++j) cm[j] = NEG; }
        float my_s = 0.f, sum = 0.f; int my_e = 0;
#pragma unroll
        for (int k = 0; k < 8; ++k) {
            float bv = cm[0], bs = sc[0]; int bi = 16 * sl;
#pragma unroll
            for (int j = 1; j < 16; ++j) { const bool g = cm[j] > bv; bv = g ? cm[j] : bv; bs = g ? sc[j] : bs; bi = g ? 16 * sl + j : bi; }
#pragma unroll
            for (int o = 1; o < 16; o <<= 1) { const float ov = __shfl_xor(bv, o), os = __shfl_xor(bs, o); const int oi = __shfl_xor(bi, o);
                const bool g = (ov > bv) || (ov == bv && oi < bi); bv = g ? ov : bv; bs = g ? os : bs; bi = g ? oi : bi; }
#pragma unroll
            for (int j = 0; j < 16; ++j) cm[j] = (bi == 16 * sl + j) ? NEG : cm[j];
            sum += bs;
            if (sl == k) { my_e = bi; my_s = bs; }
        }
        if (sl < 8) {
            const float w = my_s / (sum + 1e-20f) * 2.5f;
            if (DRY) { asm volatile("" :: "v"(w), "v"(my_e)); }
            else {
                if (have) { LIST[(size_t)pe * M + ppos] = pm * 8 + sl; PAIRW[pm * 8 + sl] = pw; }
                ppos = __hip_atomic_fetch_add(ctl + CW_CNT + my_e, 1u, RLX_AGENT); pe = my_e; pm = m; pw = w; }
        }
        have = true;
    }
    if (!DRY && have && sl < 8) { LIST[(size_t)pe * M + ppos] = pm * 8 + sl; PAIRW[pm * 8 + sl] = pw; }
}
__device__ __forceinline__ void route_tokens(KA a, gu32* ctl, int gw, int NGW, int lane) { route_tokens_t<false>(a, ctl, gw, NGW, lane); }
template <bool DRY> __device__ __forceinline__ void final_rows_t(KA a, int gw, int NGW, int lane) {
    float* outp = DRY ? (float*)(a->ws + WS_Q) : a->out;
    const bf16* SH = (const bf16*)(a->ws + WS_SHARED); const unsigned char* YP = a->ws + WS_YPAIR; const float* mod = (const float*)(a->ws + WS_MOD); const bf16* X1H = (const bf16*)(a->ws + WS_X1H);
    typedef float f2_ __attribute__((ext_vector_type(2)));
    for (int b = 0; b < BATCH; ++b) {
        f32x4 gm[4], nf[4];
#pragma unroll
        for (int q = 0; q < 4; ++q) { const int col = 8 * lane + 512 * (q >> 1) + 4 * (q & 1); gm[q] = *(const f32x4*)(mod + b * 6144 + 5120 + col); nf[q] = *(const f32x4*)(INF(I_NFIN) + col); }
        int m = gw; while (m < b * SEQ) m += NGW;
        for (; m < (b + 1) * SEQ; m += NGW) {
            float v[2][8]; float s = 0.f;
#pragma unroll
            for (int j = 0; j < 2; ++j) { const int col = 8 * lane + 512 * j;
                float xv[8]; unpack8(*(const v4u*)(X1H + (size_t)m * D + col), xv);
                float acc[8]; unpack8(*(const v4u*)(SH + (size_t)m * D + col), acc);
                float ry[8] = {0.f, 0.f, 0.f, 0.f, 0.f, 0.f, 0.f, 0.f};
#pragma unroll
                for (int k = 0; k < 8; ++k) { const v2u yw = *(const v2u*)(YP + ((size_t)m * 8 + k) * D + col);
                    const f2_ p0 = __builtin_amdgcn_cvt_pk_f32_fp8((int)yw.x, false), p1 = __builtin_amdgcn_cvt_pk_f32_fp8((int)yw.x, true);
                    const f2_ p2 = __builtin_amdgcn_cvt_pk_f32_fp8((int)yw.y, false), p3 = __builtin_amdgcn_cvt_pk_f32_fp8((int)yw.y, true);
                    ry[0] += p0.x; ry[1] += p0.y; ry[2] += p1.x; ry[3] += p1.y; ry[4] += p2.x; ry[5] += p2.y; ry[6] += p3.x; ry[7] += p3.y; }
#pragma unroll
                for (int e = 0; e < 4; ++e) { v[j][e] = xv[e] + gm[2 * j][e] * (acc[e] + ry[e] * 0.0625f); v[j][4 + e] = xv[4 + e] + gm[2 * j + 1][e] * (acc[4 + e] + ry[4 + e] * 0.0625f); }
#pragma unroll
                for (int e = 0; e < 8; ++e) s += v[j][e] * v[j][e]; }
            const float rstd = 1.f / sqrtf(wave_sum(s) * (1.f / D) + EPS);
#pragma unroll
            for (int j = 0; j < 2; ++j) { const int col = 8 * lane + 512 * j;
                *(f32x4*)(outp + (size_t)m * D + col) = (f32x4){v[j][0], v[j][1], v[j][2], v[j][3]} * rstd * nf[2 * j];
                *(f32x4*)(outp + (size_t)m * D + col + 4) = (f32x4){v[j][4], v[j][5], v[j][6], v[j][7]} * rstd * nf[2 * j + 1]; }
        }
    }
}
__device__ __forceinline__ void final_rows(KA a, int gw, int NGW, int lane) { final_rows_t<false>(a, gw, NGW, lane); }

constexpr int NPHASE = 14;
__global__ void __launch_bounds__(NWAVES * 64, 2) mega(Args a_byval) {
    extern __shared__ __attribute__((aligned(16))) unsigned char lds_raw[];
    LAS unsigned char* lds = (LAS unsigned char*)lds_raw;
    const int wave = __builtin_amdgcn_readfirstlane((int)threadIdx.x >> 6);
    const int bx = blockIdx.x;
    { const int tid = tid_fresh(wave); for (int u = tid; u < (LDS_BYTES - LDSCTL_OFF) / 4; u += NWAVES * 64) ((LAS unsigned*)(lds + LDSCTL_OFF))[u] = 0u; }
    __syncthreads();
    const int lo = a_byval.ph_lo, hi = a_byval.ph_hi;
    if (hi - lo > 1) { KA a = ka_fresh(); (void)xcd_barrier_post((unsigned*)(a->ws + WS_CTL) + CW_BAR, (volatile LAS unsigned*)(lds + MISC_OFF) + 8, wave == 0 && lane_id() == 0); }
#ifndef PHMASK
#define PHMASK 0x7fff
#endif
#define IN(k) (((PHMASK >> (k)) & 1) && lo <= (k) && (k) < hi)
#define SEAM(k) do { if (IN(k) && IN((k) + 1)) { KA a_ = ka_fresh(); XcdBarrier b_; b_.bar = (unsigned*)(a_->ws + WS_CTL) + CW_BAR; b_.x = xb_xcc_id(); b_.st = (volatile LAS unsigned*)(lds + MISC_OFF) + 8; xcd_barrier(b_, wave == 0 && lane_id() == 0); } } while (0)
#define PHASE_BEGIN KA a = ka_fresh(); const int tid = tid_fresh(wave), lane = tid & 63; (void)lane; unsigned char* ws = a->ws; const float* mod = (const float*)(ws + WS_MOD); (void)mod; gu32* ctl = (gu32*)(ws + WS_CTL); (void)ctl; \
    const int G = a->G; const int vcu = (G % 8 == 0) ? (bx % 8) * (G / 8) + bx / 8 : bx; (void)vcu; const int gw = bx * NWAVES + wave, NGW = G * NWAVES; (void)gw; (void)NGW;

    if (IN(0)) { PHASE_BEGIN ph0_mod(a, lds, tid); ph0_misc(a, ctl, bx * NWAVES * 64 + tid, G * NWAVES * 64); ph0_weights(a, lds, gw, NGW, wave, lane, 0, (G == 256) ? TR_SPLIT : TR_NITEMS); }
    SEAM(0);
    if (IN(1)) { PHASE_BEGIN norm_rows<false>(INF(I_X), INF(I_NMIX), mod, 0, 1024, (bf16*)(ws + WS_H), gw, NGW, lane); }
    SEAM(1);
    if (IN(2)) { PHASE_BEGIN
        if (G == 256 && bx >= 256 - HELPER_CUS) {
            convert_queue(a, lds, ctl + CW_QCONV, wave, lane, TR_SPLIT, TR_NITEMS);
        } else {
            pg8::GridOrder S; S.init(ws + WS_H, ws + WS_WIN, 1024, 1024, M, NIN, (G == 256) ? 256 - HELPER_CUS : G, bx);
            EpiInProj E{a};
            pg8::gemm_phase<EpiInProj, pg8::GridOrder, true>(lds, pg8::GemmDesc{1024, 1024, 1024}, S, E, wave);
            if (G == 256) convert_queue(a, lds, ctl + CW_QCONV, wave, lane, TR_SPLIT, TR_NITEMS);
        }
    }
    SEAM(2);
    if (IN(3)) { PHASE_BEGIN for (int u = bx; u < 512; u += G) ssd_s1_unit(a, u, lds, tid, wave, lane); }
    SEAM(3);
    if (IN(4)) { PHASE_BEGIN
        for (int it = bx; it < 256; it += G) ssd_s2_item(a, it, tid);
        const attn_body::bf16* Qp = (const attn_body::bf16*)(ws + WS_Q); const attn_body::bf16* Kp = (const attn_body::bf16*)(ws + WS_K); const attn_body::bf16* Vp = (const attn_body::bf16*)(ws + WS_V);
        attn_body::bf16* Op = (attn_body::bf16*)(ws + WS_O);
        { const float lam = __builtin_bit_cast(float, __builtin_amdgcn_readfirstlane((int)__hip_atomic_load(ctl + CW_LAM, RLX_AGENT)));
          const attn_body::AttnTensors AT{Qp, Kp, Vp, Op, lam, INF(I_HNORM), (attn_body::bf16*)(ws + WS_YA)}; const attn_body::StaticOrder S((int)G, (int)bx);
          attn_body::attn_phase<attn_body::StaticOrder>((char*)lds_raw, AT, S, wave); }
    }
    SEAM(4);
    if (IN(5)) { PHASE_BEGIN
        for (int u = bx; u < 512; u += G) ssd_s3_unit(a, u, lds, tid, wave, lane);
        const float lam = __builtin_bit_cast(float, __hip_atomic_load(ctl + CW_LAM, RLX_AGENT));
    }
    SEAM(5);
    if (IN(6)) { PHASE_BEGIN
        { pg8::GridOrder S; S.init(ws + WS_YA, ws + WS_WA, 1024, 1024, M, 1024, G, bx);
          EpiMixA E{a};
          pg8::gemm_phase<EpiMixA, pg8::GridOrder, true>(lds, pg8::GemmDesc{1024, 1024, 1024}, S, E, wave); }
        { pg8::GridOrder S; S.init(ws + WS_YCAT + 1024 * 2, ws + WS_WS, 3072, 2048, M, 1024, G, bx);
          LAS float* rs = (LAS float*)(lds + TAB_OFF);
          { pg8::Unit u0; if (S.next(0, u0)) { const float* RSTD = (const float*)(ws + WS_RSTD);
                for (int k = tid; k < 1024; k += NWAVES * 64) rs[k] = RSTD[(size_t)u0.pm * 1024 + k]; } }
          __syncthreads();
          EpiMixB E{a, rs}; HookGrp H{rs};
          pg8::gemm_phase<EpiMixB, pg8::GridOrder, true, HookGrp>(lds, pg8::GemmDesc{3072, 2048, 2048}, S, E, wave, H); }
    }
    SEAM(6);
    if (IN(7)) { PHASE_BEGIN
        pg8::GridOrder S; S.init(ws + WS_MIXED, ws + WS_WO, 1024, 1024, M, 1024, G, bx);
        EpiOut E{a};
        pg8::gemm_phase<EpiOut, pg8::GridOrder, true>(lds, pg8::GemmDesc{1024, 1024, 1024}, S, E, wave);
    }
    SEAM(7);
    if (IN(8)) { PHASE_BEGIN norm_rows<true>(ws + WS_X1H, INF(I_NFFN), mod, 3072, 4096, (bf16*)(ws + WS_H), gw, NGW, lane); }
    SEAM(8);
    if (IN(9)) { PHASE_BEGIN
        pg8::GridOrder S; S.init(ws + WS_H, ws + WS_WRS, 1024, 1024, M, 768, G, bx);
        EpiRS E{a};
        pg8::gemm_phase<EpiRS, pg8::GridOrder, true>(lds, pg8::GemmDesc{1024, 1024, 1024}, S, E, wave);
    }
    SEAM(9);
    if (IN(10)) { PHASE_BEGIN
        route_tokens(a, ctl, gw, NGW, lane);
        pg8::GridOrder S; S.init(ws + WS_HS, ws + WS_WSHD, 256, 256, M, 1024, G, bx);
        EpiStore E{a, WS_SHARED, 1024};
        pg8::gemm_phase<EpiStore, pg8::GridOrder, true>(lds, pg8::GemmDesc{256, 256, 256}, S, E, wave);
    }
    SEAM(10);
    if (IN(11)) { PHASE_BEGIN
        LAS int* tile = (LAS int*)(lds + TAB_OFF); LAS unsigned* rowoff = (LAS unsigned*)(lds + TAB_OFF + 4096);
        const int ntiles = moe_build_tiles(ctl, lds, tile, tid);
        const int* LIST = (const int*)(ws + WS_LIST);
        { LAS const int* scnt = (LAS const int*)(lds + 2048); int lv[3]; bool ok[3];
#pragma unroll
          for (int i = 0; i < 3; ++i) { const int k = tid + 512 * i, ui = k >> 8, r = k & 255, idx = ui * G + vcu; ok[i] = idx < 2 * ntiles;
              const int t = tile[ok[i] ? (idx >> 1) : 0], e = t & 0xffff, slot = ((t >> 16) & 0xff) * 256 + r; ok[i] = ok[i] && slot < scnt[e];
              lv[i] = ok[i] ? LIST[(size_t)e * M + slot] : 0; }
#pragma unroll
          for (int i = 0; i < 3; ++i) rowoff[tid + 512 * i] = ok[i] ? (unsigned)(lv[i] >> 3) * 2048u : 0u; }
        __syncthreads();
        MoeOrder1 S{(const char*)(ws + WS_H), (const char*)(ws + WS_WEGU), tile, rowoff, ntiles, G, vcu};
        EpiMoe1 E{a};
        pg8::gemm_phase<EpiMoe1, MoeOrder1, true>(lds, pg8::GemmDesc{1024, 1024, 1024}, S, E, wave);
    }
    SEAM(11);
    if (IN(12)) { PHASE_BEGIN
        LAS int* tile = (LAS int*)(lds + 4096);
        LAS unsigned* utab = (LAS unsigned*)(lds + TAB_OFF);
        const int ntiles = moe_build_tiles(ctl, lds, tile, tid);
        { const int* LIST = (const int*)(ws + WS_LIST); const float* PAIRW = (const float*)(ws + WS_PAIRW);
          LAS const int* scnt = (LAS const int*)(lds + 2048);
          constexpr int NIT = (MOE2_MAXU * 257 + NWAVES * 64 - 1) / (NWAVES * 64);
          int pr[NIT]; float pwt[NIT]; unsigned ent0[NIT]; bool ok[NIT];
#pragma unroll
          for (int i = 0; i < NIT; ++i) { const int k = tid + NWAVES * 64 * i, ui = k / 257, r = k - ui * 257, idx = ui * G + vcu; const bool in = k < MOE2_MAXU * 257 && idx < 4 * ntiles;
              const int t = tile[in ? (idx >> 2) : 0], e = t & 0xffff, slot = ((t >> 16) & 0xff) * 256 + r;
              ent0[i] = (in && r == 256) ? (unsigned)t : 0xffffffffu; ok[i] = in && r < 256 && slot < scnt[e];
              pr[i] = ok[i] ? LIST[(size_t)e * M + slot] : 0; }
#pragma unroll
          for (int i = 0; i < NIT; ++i) pwt[i] = ok[i] ? PAIRW[pr[i]] : 0.f;
#pragma unroll
          for (int i = 0; i < NIT; ++i) { const int k = tid + NWAVES * 64 * i;
              if (k < MOE2_MAXU * 257) utab[k] = ok[i] ? (((unsigned)pr[i] << 15) | ((unsigned)__builtin_bit_cast(unsigned short, (_Float16)pwt[i]) & 0x7fffu)) : ent0[i]; } }
        __syncthreads();
        MoeOrder2 S{(const char*)(ws + WS_HE), (const char*)(ws + WS_WED), utab, ntiles, G, vcu};
        EpiMoe2 E{a, utab};
        pg8::gemm_phase<EpiMoe2, MoeOrder2, true>(lds, pg8::GemmDesc{256, 256, 256}, S, E, wave);
    }
    SEAM(12);
    if (IN(13)) { PHASE_BEGIN final_rows(a, gw, NGW, lane); }
#if MK_N_LAUNCHES == 0 && defined(MK_PROBE_S3)
    if (IN(14)) { PHASE_BEGIN for (int u = bx; u < 512; u += G) ssd_s3_unit_t<MK_PROBE_S3>(a, u, lds, tid, wave, lane); }
#endif
#if MK_N_LAUNCHES == 0 && defined(MK_PROBE_COMB)
    if (IN(14)) { PHASE_BEGIN attn_combine(a, 0.5f, gw, NGW, lane); }
#endif
#if MK_N_LAUNCHES == 0 && defined(MK_PROBE_ROUTE)
    if (IN(14)) { PHASE_BEGIN route_tokens_t<true>(a, ctl, gw, NGW, lane); }
#endif
#if MK_N_LAUNCHES == 0 && defined(MK_PROBE_FINAL)
    if (IN(14)) { PHASE_BEGIN final_rows_t<true>(a, gw, NGW, lane); }
#endif
#if MK_N_LAUNCHES == 0 && defined(MK_PROBE_GEMM)
    if (IN(14)) { PHASE_BEGIN
        pg8::GridOrder S; S.init(ws + WS_WEGU, ws + WS_WIN, 1024, 1024, M, NIN, G, bx);
        EpiStore E{a, WS_Q, NIN};
        pg8::gemm_phase<EpiStore, pg8::GridOrder, true>(lds, pg8::GemmDesc{1024, 1024, 1024}, S, E, wave);
    }
#endif
#undef IN
#undef SEAM
}

extern "C" void kernel_launch(void* const* d_in, const int* in_sizes, int n_in, void* d_out, int out_size, void* d_ws, size_t ws_size, hipStream_t stream) {
    static int grid = 0;
    if (grid == 0) {
        if (n_in != 32 || out_size != M * D || ws_size < WS_END) { fprintf(stderr, "kernel_launch: unexpected shapes (n_in %d out %d ws %zu)\n", n_in, out_size, ws_size); grid = -1; return; }
        int dev = 0, cus = 0, per_cu = 0;
        if (hipGetDevice(&dev) != hipSuccess || hipDeviceGetAttribute(&cus, hipDeviceAttributeMultiprocessorCount, dev) != hipSuccess) { grid = -1; return; }
        if (hipFuncSetAttribute((const void*)mega, hipFuncAttributeMaxDynamicSharedMemorySize, LDS_BYTES) != hipSuccess) { fprintf(stderr, "kernel_launch: hipFuncSetAttribute failed\n"); grid = -1; return; }
        if (hipOccupancyMaxActiveBlocksPerMultiprocessor(&per_cu, (const void*)mega, NWAVES * 64, LDS_BYTES) != hipSuccess || per_cu < 1) { fprintf(stderr, "kernel_launch: occupancy query says %d\n", per_cu); (void)hipGetLastError(); grid = -1; return; }
        grid = cus;
    }
    if (grid < 0) return;
    (void)hipMemsetAsync((char*)d_ws + WS_CTL, 0, CTL_ZERO_BYTES, stream);
    Args a{};
    for (int i = 0; i < 32; ++i) a.in[i] = d_in[i];
    a.out = (float*)d_out; a.ws = (unsigned char*)d_ws; a.G = grid;
#if MK_N_LAUNCHES == 1
    a.ph_lo = 0; a.ph_hi = NPHASE;
    hipLaunchKernelGGL(mega, dim3(grid), dim3(NWAVES * 64), LDS_BYTES, stream, a);
#else
    for (int p = 0; p < NPHASE; ++p) { a.ph_lo = p; a.ph_hi = p + 1; for (int r = 0; r < 1 + ((MK_DUPMASK >> p) & 1); ++r) hipLaunchKernelGGL(mega, dim3(grid), dim3(NWAVES * 64), LDS_BYTES, stream, a); }
#if defined(MK_PROBE_GEMM) || defined(MK_PROBE_S3) || defined(MK_PROBE_COMB) || defined(MK_PROBE_ROUTE) || defined(MK_PROBE_FINAL)
    a.ph_lo = 14; a.ph_hi = 15; hipLaunchKernelGGL(mega, dim3(grid), dim3(NWAVES * 64), LDS_BYTES, stream, a);
#endif
#endif
}
```

```cpp
#include <hip/hip_runtime.h>
#include <hip/hip_bf16.h>
#include <cstdio>
#include <cstdint>
#include <cmath>

#ifndef MK_N_LAUNCHES
#define MK_N_LAUNCHES 1
#endif

#ifndef MK_DUPMASK
#define MK_DUPMASK 0
#endif

#define LAS __attribute__((address_space(3)))
#define GAS __attribute__((address_space(1)))
typedef unsigned short bf16;
typedef unsigned v4u __attribute__((ext_vector_type(4)));
typedef unsigned v2u __attribute__((ext_vector_type(2)));
typedef float f32x4 __attribute__((ext_vector_type(4)));
typedef float f32x2 __attribute__((ext_vector_type(2)));
typedef short bf16x8 __attribute__((ext_vector_type(8)));
typedef short s16x4 __attribute__((ext_vector_type(4)));
typedef GAS unsigned gu32;
typedef GAS unsigned long long gu64;
#define RLX_AGENT __ATOMIC_RELAXED, __HIP_MEMORY_SCOPE_AGENT
#define LDS_WAIT() asm volatile("s_waitcnt lgkmcnt(0)" ::: "memory")
#define VM_WAIT() asm volatile("s_waitcnt vmcnt(0)" ::: "memory")

constexpr int BATCH = 2, SEQ = 8192, D = 1024, M = BATCH * SEQ;
constexpr int IN_COLS = 10272, NIN = 10496;
constexpr int NEXP = 256, TOPK = 8, EFF = 256;
constexpr int NPAIR = M * TOPK;
constexpr int MAXTILES = NPAIR / 256 + NEXP;
constexpr float EPS = 1e-6f;
constexpr float LAMBDA_INIT = 0.2f;
constexpr float QSCALE = 0.125f * 1.4426950408889634f;

constexpr size_t MiB = 1u << 20;
constexpr size_t WS_CTL = 0, CTL_ZERO_BYTES = 1 * MiB;
constexpr size_t WS_WIN = 2 * MiB;
constexpr size_t WS_WA = 23 * MiB;
constexpr size_t WS_WS = 25 * MiB;
constexpr size_t WS_WO = 29 * MiB;
constexpr size_t WS_WRS = 31 * MiB;
constexpr size_t WS_WSHD = 33 * MiB;
constexpr size_t WS_MOD = 34 * MiB;
constexpr size_t WS_CS = 35 * MiB;
constexpr size_t WS_WEGU = 36 * MiB;
constexpr size_t WS_WED = 292 * MiB;
constexpr size_t WS_H = 420 * MiB;
constexpr size_t WS_Q = 452 * MiB, WS_K = 484 * MiB, WS_V = 516 * MiB;
constexpr size_t WS_YCAT = 452 * MiB;
constexpr size_t WS_YA = 420 * MiB;
constexpr size_t WS_MIXED = 676 * MiB;
constexpr size_t WS_ZS = 548 * MiB;
constexpr size_t WS_TMP = 548 * MiB;
constexpr size_t WS_XBC = 612 * MiB;
constexpr size_t WS_O = 612 * MiB;
constexpr size_t WS_GATES = 708 * MiB;
constexpr size_t WS_DT = 772 * MiB;
constexpr size_t WS_ACUM = 774 * MiB;
constexpr size_t WS_XS = 776 * MiB;
constexpr size_t WS_BC = 840 * MiB;
constexpr size_t WS_CHST = 872 * MiB;
constexpr size_t WS_STIN = 936 * MiB;
constexpr size_t WS_LOGITS = 452 * MiB;
constexpr size_t WS_HS = 468 * MiB;
constexpr size_t WS_SHARED = 476 * MiB;
constexpr size_t WS_LIST = 508 * MiB;
constexpr size_t WS_PAIRW = 524 * MiB;
constexpr size_t WS_HE = 548 * MiB;
constexpr size_t WS_YPAIR = 644 * MiB;
constexpr size_t WS_X1H = 776 * MiB;
constexpr size_t WS_RSTD = 1000 * MiB;
constexpr size_t WS_END = 1001 * MiB;
constexpr int CW_TMO = 0, CW_CODE = 1;
constexpr int CW_BAR = 4096;
constexpr int CW_CNT = 16384;
constexpr int CW_LAM = 17000;
constexpr int CW_QCONV = 18432;

constexpr int RING_BYTES = 131072;
constexpr int TAB_OFF = RING_BYTES;
constexpr int TAB_BYTES = 12800;
constexpr int LDSCTL_OFF = TAB_OFF + TAB_BYTES, MISC_OFF = LDSCTL_OFF + 64;
constexpr int LDS_BYTES = 147456;
static_assert(MISC_OFF + 128 <= LDS_BYTES, "LDS map");
constexpr int NWAVES = 8;

__device__ __forceinline__ unsigned f2bf(float f) { unsigned u = __builtin_bit_cast(unsigned, f); return (u + 0x7fffu + ((u >> 16) & 1u)) >> 16; }
typedef float f32x2_t_ __attribute__((ext_vector_type(2))); typedef __bf16 bf16x2_t_ __attribute__((ext_vector_type(2)));
__device__ __forceinline__ unsigned pk2(float lo, float hi) { f32x2_t_ v = {lo, hi}; bf16x2_t_ b = __builtin_convertvector(v, bf16x2_t_); return __builtin_bit_cast(unsigned, b); }
__device__ __forceinline__ float bf2f(unsigned short h) { return __builtin_bit_cast(float, (unsigned)h << 16); }
__device__ __forceinline__ float bflo(unsigned w) { return __builtin_bit_cast(float, w << 16); }
__device__ __forceinline__ float bfhi(unsigned w) { return __builtin_bit_cast(float, w & 0xffff0000u); }
__device__ __forceinline__ float silu_f(float v) { return v * __builtin_amdgcn_rcpf(1.f + __expf(-v)); }
__device__ __forceinline__ float sigmoid_f(float v) { return __builtin_amdgcn_rcpf(1.f + __expf(-v)); }
__device__ __forceinline__ float softplus_f(float v) { return fmaxf(v, 0.f) + log1pf(__expf(-fabsf(v))); }
__device__ __forceinline__ int lane_id() { int l; asm volatile("v_mbcnt_lo_u32_b32 %0, -1, 0\n\tv_mbcnt_hi_u32_b32 %0, -1, %0" : "=v"(l)); return l; }
__device__ __forceinline__ float wave_sum(float v) {
#pragma unroll
    for (int o = 1; o < 64; o <<= 1) v += __shfl_xor(v, o);
    return v;
}
namespace pg8 {
#define PG8_LAS __attribute__((address_space(3)))
typedef unsigned short bf16_t;
typedef short bf16x8 __attribute__((ext_vector_type(8)));
typedef float f32x4 __attribute__((ext_vector_type(4)));
typedef unsigned u32x4 __attribute__((ext_vector_type(4)));
constexpr int BM = 256, BK = 64, HALF = 128, HTB = HALF * BK * 2  , STAGE_BYTES = 8 * HTB, NXCD = 8, WGM = 8;

__host__ __device__ __forceinline__ int lds_byte(int r, int c) { const int st = (r >> 4) * 2 + (c >> 5), rr = r & 15, cc = c & 31, ob = rr * 64 + cc * 2; return st * 1024 + (ob ^ (((ob >> 9) & 1) << 5)); }
__host__ __device__ __forceinline__ void stage_rc(int b, int& R, int& C) { const int st = b / 1024, sb = b % 1024, swz = sb ^ (((sb >> 9) & 1) << 5); R = (st >> 1) * 16 + swz / 64; C = (st & 1) * 32 + (swz % 64) / 2; }
__host__ __device__ __forceinline__ int perm32(int rho) { const int n = rho >> 4, i = rho & 15; return 8 * (i >> 2) + 4 * n + (i & 3); }

struct Unit { int pm, pn, aux, ui; };
struct GemmDesc { int lda, ldb, K; };

struct GridOrder {
    const char* A; const char* Bt; size_t tstepA, tstepB;
    int nM, nN, nwg, G, c;
    static constexpr bool GATHER = false;
    __device__ __forceinline__ void init(const void* A_, const void* Bt_, int lda, int ldb, int M, int N, int G_, int c_) {
        A = (const char*)A_; Bt = (const char*)Bt_; tstepA = (size_t)BM * lda * 2; tstepB = (size_t)BM * ldb * 2; nM = M / BM; nN = N / BM; nwg = nM * nN; G = G_; c = c_; }
    __device__ __forceinline__ bool next(int i, Unit& u) const {
        const long L = (long)i * G + c; if (L >= nwg) return false;
        int wgid = (int)L; { const int q = nwg / NXCD, r = nwg % NXCD, xcd = wgid % NXCD, off = wgid / NXCD; wgid = (xcd < r ? xcd * (q + 1) : r * (q + 1) + (xcd - r) * q) + off; }
        const int nig = WGM * nN, gid = wgid / nig, fm = gid * WGM, gsz = (nM - fm) < WGM ? (nM - fm) : WGM;
        u.pm = fm + ((wgid % nig) % gsz); u.pn = (wgid % nig) / gsz; u.aux = 0; u.ui = i; return true;
    }
    __device__ __forceinline__ const char* abase(const Unit& u) const { return A + (size_t)u.pm * tstepA; }
    __device__ __forceinline__ const char* bbase(const Unit& u) const { return Bt + (size_t)u.pn * tstepB; }
    __device__ __forceinline__ unsigned rowoff(int, int) const { return 0u; }
    __device__ __forceinline__ bool full(const Unit&) const { return true; }
};

__device__ __forceinline__ unsigned cvt_pk_bf16(float lo, float hi) { unsigned r; asm volatile("v_cvt_pk_bf16_f32 %0, %1, %2" : "=v"(r) : "v"(lo), "v"(hi)); return r; }

struct AccBox { f32x4 v[2][2][4][2]; };
struct NoHook { static constexpr bool ON = false; __device__ __forceinline__ void operator()(f32x4 (&)[2][2][4][2], int, int) const {} };
template <class Epi, class Sched, bool ALIGN_EPI, class Hook = NoHook, int ACCMODE = 0>
__device__ __forceinline__ void gemm_phase(PG8_LAS unsigned char* lds, const GemmDesc g, const Sched& S, const Epi& E, int wave_, const Hook H = Hook(), AccBox* xb = nullptr) {
    const int lane = lane_id(), wid = wave_, tid = wid * 64 + lane,
              wr = wid >> 2, wc = wid & 3, fr = lane & 15, fq = lane >> 4;
    int K = g.K; asm volatile("" : "+s"(K)); const int nt = K / BK;
    constexpr bool GATHER = Sched::GATHER;
    unsigned voffA0[2], voffA1[2], voffB0[2], voffB1[2], nvA0[2], nvA1[2]; int Rr[2]; unsigned Cb[2];
#pragma unroll
    for (int i = 0; i < 2; ++i) { int R, C; stage_rc(tid * 16 + i * 8192, R, C); const int Rb = ((R & ~31) + perm32(R & 31));
        Rr[i] = R; Cb[i] = (unsigned)C * 2u;
        voffA0[i] = (unsigned)(R * g.lda + C) * 2u; voffA1[i] = voffA0[i] + (unsigned)(HALF * g.lda) * 2u;
        voffB0[i] = (unsigned)(Rb * g.ldb + C) * 2u; voffB1[i] = voffB0[i] + (unsigned)(HALF * g.ldb) * 2u;
        nvA0[i] = voffA0[i]; nvA1[i] = voffA1[i]; }
    const size_t kstep = (size_t)(BK * 2);
    const unsigned ldsw = (unsigned)wid * 1024u;
    const int aoff = lds_byte(wr * 64 + fr, fq * 8), boff = lds_byte(wc * 32 + fr, fq * 8);
#define PG8_SA(b, h) (((b) * 2 + (h)) * HTB)
#define PG8_SB(b, h) ((4 + (b) * 2 + (h)) * HTB)
#define PG8_STAGE(bufoff, gbase, voff) do { _Pragma("unroll") for (int _i = 0; _i < 2; ++_i) \
        __builtin_amdgcn_global_load_lds((const unsigned*)((const char*)(gbase) + (voff)[_i]), (PG8_LAS unsigned*)(lds + (bufoff) + ldsw + _i * 8192), 16, 0, 0); } while (0)
#define PG8_LDA(dst, b, h) do { _Pragma("unroll") for (int m = 0; m < 4; ++m) _Pragma("unroll") for (int k = 0; k < 2; ++k) dst[m][k] = *(const PG8_LAS bf16x8*)(lds + PG8_SA(b, h) + aoff + m * 2048 + k * 1024); } while (0)
#define PG8_LDB(dst, b, h) do { _Pragma("unroll") for (int n = 0; n < 2; ++n) _Pragma("unroll") for (int k = 0; k < 2; ++k) dst[n][k] = *(const PG8_LAS bf16x8*)(lds + PG8_SB(b, h) + boff + n * 2048 + k * 1024); } while (0)
#define PG8_MMA(ai, bj, At, Bt) do { __builtin_amdgcn_s_setprio(1); _Pragma("unroll") for (int m = 0; m < 4; ++m) _Pragma("unroll") for (int n = 0; n < 2; ++n) _Pragma("unroll") for (int k = 0; k < 2; ++k) \
        acc[ai][bj][m][n] = __builtin_amdgcn_mfma_f32_16x16x32_bf16(Bt[n][k], At[m][k], acc[ai][bj][m][n], 0, 0, 0); __builtin_amdgcn_s_setprio(0); } while (0)
#define PG8_WAIT_V(n) asm volatile("s_waitcnt vmcnt(" #n ")" ::: "memory")
#define PG8_WAIT_L(n) asm volatile("s_waitcnt lgkmcnt(" #n ")" ::: "memory")
#define PG8_BAR __builtin_amdgcn_s_barrier()
#define PG8_SCHED __builtin_amdgcn_sched_barrier(0)
    Unit cur, nxt; int ui = 0;
    if (!S.next(0, cur)) return;
    if constexpr (GATHER) {
#pragma unroll
        for (int i = 0; i < 2; ++i) { voffA0[i] = S.rowoff(0, Rr[i]) + Cb[i]; voffA1[i] = S.rowoff(0, HALF + Rr[i]) + Cb[i]; }
    }
    f32x4 acc_local[2][2][4][2];
    f32x4 (&acc)[2][2][4][2] = (ACCMODE != 0) ? xb->v : acc_local;
    if constexpr (ACCMODE != 2) {
#pragma unroll
        for (int a = 0; a < 2; ++a)
#pragma unroll
            for (int b = 0; b < 2; ++b)
#pragma unroll
                for (int m = 0; m < 4; ++m)
#pragma unroll
                    for (int n = 0; n < 2; ++n) acc[a][b][m][n] = (f32x4){0.f, 0.f, 0.f, 0.f};
    }
    bf16x8 At[4][2], B0[2][2], B1[2][2];
    const char* cA = S.abase(cur); const char* cB = S.bbase(cur);
    PG8_STAGE(PG8_SB(0, 0), cB, voffB0); PG8_STAGE(PG8_SB(0, 1), cB, voffB1); PG8_STAGE(PG8_SA(0, 0), cA, voffA0); PG8_STAGE(PG8_SA(0, 1), cA, voffA1);
    if (wr == 1) PG8_BAR;
    PG8_WAIT_V(2); PG8_BAR;
    PG8_STAGE(PG8_SB(1, 0), cB + kstep, voffB0); PG8_STAGE(PG8_SA(1, 0), cA + kstep, voffA0); PG8_STAGE(PG8_SB(1, 1), cB + kstep, voffB1);
    PG8_WAIT_V(6); PG8_BAR;
    for (;;) {
        const bool has_next = S.next(ui + 1, nxt);
        const char* nA = has_next ? S.abase(nxt) : cA; const char* nB = has_next ? S.bbase(nxt) : cB;
        if constexpr (GATHER) {
            if (has_next) {
#pragma unroll
                for (int i = 0; i < 2; ++i) { nvA0[i] = S.rowoff(ui + 1, Rr[i]) + Cb[i]; nvA1[i] = S.rowoff(ui + 1, HALF + Rr[i]) + Cb[i]; }
            } else {
#pragma unroll
                for (int i = 0; i < 2; ++i) { nvA0[i] = voffA0[i]; nvA1[i] = voffA1[i]; }
            }
        }
        for (int t = 0; t < nt; t += 2) {
            if constexpr (Hook::ON) H(acc, t, wr);
            const bool last = (t == nt - 2);
            const char* a1 = cA + (size_t)(t + 1) * kstep;
            const char* a2 = last ? nA : cA + (size_t)(t + 2) * kstep; const char* b2 = last ? nB : cB + (size_t)(t + 2) * kstep;
            const char* a3 = a2 + kstep; const char* b3 = b2 + kstep;
            unsigned sA0[2], sA1[2];
#pragma unroll
            for (int i = 0; i < 2; ++i) { sA0[i] = (GATHER && last) ? nvA0[i] : voffA0[i]; sA1[i] = (GATHER && last) ? nvA1[i] : voffA1[i]; }
            PG8_LDB(B0, 0, 0); PG8_LDB(B1, 0, 1); PG8_SCHED; PG8_LDA(At, 0, 0); PG8_STAGE(PG8_SA(1, 1), a1, voffA1);
            PG8_WAIT_V(8); PG8_WAIT_L(0); PG8_BAR; PG8_MMA(0, 0, At, B0); PG8_MMA(0, 1, At, B1); PG8_BAR; PG8_SCHED;
            PG8_LDA(At, 0, 1); PG8_STAGE(PG8_SB(0, 0), b2, voffB0); PG8_STAGE(PG8_SB(0, 1), b2, voffB1); PG8_STAGE(PG8_SA(0, 0), a2, sA0);
            PG8_WAIT_V(8); PG8_WAIT_L(0); PG8_BAR; PG8_MMA(1, 0, At, B0); PG8_MMA(1, 1, At, B1); PG8_BAR; PG8_SCHED;
            PG8_LDB(B0, 1, 0); PG8_LDB(B1, 1, 1); PG8_SCHED; PG8_LDA(At, 1, 0); PG8_STAGE(PG8_SA(0, 1), a2, sA1);
            PG8_WAIT_V(8); PG8_WAIT_L(0); PG8_BAR; PG8_MMA(0, 0, At, B0); PG8_MMA(0, 1, At, B1); PG8_BAR; PG8_SCHED;
            PG8_LDA(At, 1, 1); PG8_STAGE(PG8_SB(1, 0), b3, voffB0); PG8_STAGE(PG8_SB(1, 1), b3, voffB1); PG8_STAGE(PG8_SA(1, 0), a3, sA0);
            PG8_WAIT_V(8); PG8_WAIT_L(0); PG8_BAR; PG8_MMA(1, 0, At, B0); PG8_MMA(1, 1, At, B1); PG8_BAR; PG8_SCHED;
        }
        if constexpr (ALIGN_EPI) { if (wr == 0) PG8_BAR; }
        E(acc, cur, wr, wc, fr, fq);
        if (!has_next) break;
#pragma unroll
        for (int a = 0; a < 2; ++a)
#pragma unroll
            for (int b = 0; b < 2; ++b)
#pragma unroll
                for (int m = 0; m < 4; ++m)
#pragma unroll
                    for (int n = 0; n < 2; ++n) acc[a][b][m][n] = (f32x4){0.f, 0.f, 0.f, 0.f};
        cur = nxt; cA = nA; cB = nB; ++ui;
        if constexpr (GATHER) {
#pragma unroll
            for (int i = 0; i < 2; ++i) { voffA0[i] = nvA0[i]; voffA1[i] = nvA1[i]; }
        }
        if constexpr (ALIGN_EPI) { if (wr == 1) PG8_BAR; }
    }
    PG8_WAIT_V(0);
    if constexpr (!ALIGN_EPI) { if (wr == 0) PG8_BAR; }
    PG8_BAR;
#undef PG8_SA
#undef PG8_SB
#undef PG8_STAGE
#undef PG8_LDA
#undef PG8_LDB
#undef PG8_MMA
#undef PG8_WAIT_V
#undef PG8_WAIT_L
#undef PG8_BAR
#undef PG8_SCHED
}
}
namespace attn_body {
using bf16=__hip_bfloat16;
using bf16x8=__attribute__((ext_vector_type(8)))short;
using s16x4=__attribute__((ext_vector_type(4)))short;
using f32x16=__attribute__((ext_vector_type(16)))float;
using u32x4=__attribute__((ext_vector_type(4)))unsigned;
constexpr int BATCH=2,NHEAD=16,SEQ=8192,D=64,DM=NHEAD*D;
constexpr int NW=8,QBLK=32,QB=QBLK*NW,KVBLK=64,NQB=SEQ/QB;
constexpr int ATTN_PITCH=DM, ATTN_UNIT_ROWS=QB, OPITCH=2048;
__device__ __forceinline__ int crow(int r,int hi){return (r&3)+8*(r>>2)+4*hi;}
#define SBAR() __builtin_amdgcn_sched_barrier(0)
__device__ __forceinline__ void cmask(f32x16&p0,f32x16&p1,int jb,int qrel,int hi){
  const float NEG=-INFINITY; int dq=qrel-(64*jb+4*hi); asm volatile("":"+v"(dq));
  #pragma unroll
  for(int r=0;r<16;++r){const int cr=(r&3)+8*(r>>2); if(cr>dq)p0[r]=NEG; if(cr+32>dq)p1[r]=NEG;}
}

constexpr int NSLOT=3, SLOTB=8192;
constexpr int VSLOTB=2*SLOTB;
constexpr int LDS_K=0, LDS_V=NSLOT*SLOTB, LDS_WS=LDS_V+NSLOT*VSLOTB, LDS_OST=LDS_WS+NW*64*4, LDS_STASH=LDS_OST, LDS_BYTES=LDS_STASH+NW*8192;
constexpr float C2=0.125f*1.4426950408889634f;
__device__ __forceinline__ void glds16(const void*gsrc,unsigned lds_dst){unsigned keep;
  asm volatile("s_mov_b32 %0, m0\n\ts_mov_b32 m0, %2\n\ts_nop 0\n\tglobal_load_lds_dwordx4 %1, off\n\ts_mov_b32 m0, %0":"=&s"(keep):"v"(gsrc),"s"(lds_dst):"memory");}
__device__ __forceinline__ float max3f(float a,float b,float c){float r;asm("v_max3_f32 %0, %1, %2, %3":"=v"(r):"v"(a),"v"(b),"v"(c));return r;}
__device__ __forceinline__ float max2f(float a,float b){float r;asm("v_max_f32_e32 %0, %1, %2":"=v"(r):"v"(a),"v"(b));return r;}
__device__ __forceinline__ float fadd_s(float a,float b){float r;asm("v_add_f32_e32 %0, %1, %2":"=v"(r):"v"(a),"v"(b));return r;}
__device__ __forceinline__ float fsub_s(float a,float b){float r;asm("v_sub_f32_e32 %0, %1, %2":"=v"(r):"v"(a),"v"(b));return r;}
typedef float f32x2_t __attribute__((ext_vector_type(2))); typedef __bf16 bf16x2_t __attribute__((ext_vector_type(2)));
__device__ __forceinline__ unsigned cvtpk_s(float lo,float hi){f32x2_t v={lo,hi};bf16x2_t b=__builtin_convertvector(v,bf16x2_t);return __builtin_bit_cast(unsigned,b);}
#define WAIT_BAR(N) asm volatile("s_waitcnt vmcnt(" #N ") lgkmcnt(0)\n\ts_barrier":::"memory")

__device__ __forceinline__ void qkt(f32x16&p0,f32x16&p1,const char*Kslot,const bf16x8*qr,const f32x16&negm,int r32,int hi){
  const char*kb=Kslot+hi*1024+r32*16;
  #pragma unroll
  for(int d0=0;d0<4;++d0){
    const bf16x8 b0=*reinterpret_cast<const bf16x8*>(kb+d0*2048);
    const bf16x8 b1=*reinterpret_cast<const bf16x8*>(kb+d0*2048+512);
    if(d0==0){p0=__builtin_amdgcn_mfma_f32_32x32x16_bf16(b0,qr[0],negm,0,0,0);p1=__builtin_amdgcn_mfma_f32_32x32x16_bf16(b1,qr[0],negm,0,0,0);}
    else{p0=__builtin_amdgcn_mfma_f32_32x32x16_bf16(b0,qr[d0],p0,0,0,0);p1=__builtin_amdgcn_mfma_f32_32x32x16_bf16(b1,qr[d0],p1,0,0,0);}}
}
typedef __attribute__((address_space(3))) const char* lds_cptr;
typedef short v4i16_t __attribute__((ext_vector_type(4)));
__device__ __forceinline__ void kload8(bf16x8*kf,lds_cptr kp){
  kf[0]=*(const __attribute__((address_space(3))) bf16x8*)(kp);      kf[1]=*(const __attribute__((address_space(3))) bf16x8*)(kp+512);
  kf[2]=*(const __attribute__((address_space(3))) bf16x8*)(kp+2048); kf[3]=*(const __attribute__((address_space(3))) bf16x8*)(kp+2560);
  kf[4]=*(const __attribute__((address_space(3))) bf16x8*)(kp+4096); kf[5]=*(const __attribute__((address_space(3))) bf16x8*)(kp+4608);
  kf[6]=*(const __attribute__((address_space(3))) bf16x8*)(kp+6144); kf[7]=*(const __attribute__((address_space(3))) bf16x8*)(kp+6656);
}
__device__ __forceinline__ void kload2(bf16x8*kf,lds_cptr kp,int j){ kf[2*j]=*(const __attribute__((address_space(3))) bf16x8*)(kp+j*2048); kf[2*j+1]=*(const __attribute__((address_space(3))) bf16x8*)(kp+j*2048+512); }
__device__ __forceinline__ s16x4 vtr(lds_cptr p){ return __builtin_bit_cast(s16x4,__builtin_amdgcn_ds_read_tr16_b64_v4i16((__attribute__((address_space(3))) v4i16_t*)p)); }
__device__ __forceinline__ float rowmax(const f32x16&p0,const f32x16&p1){
  float a=max3f(p0[0],p0[1],p1[0]),b=max3f(p0[2],p0[3],p1[1]);a=max3f(a,p1[2],p1[3]);
  #pragma unroll
  for(int r=4;r<16;r+=4){a=max3f(a,p0[r],p0[r+1]);b=max3f(b,p0[r+2],p0[r+3]);a=max3f(a,p1[r],p1[r+1]);b=max3f(b,p1[r+2],p1[r+3]);}
  const float m=max2f(a,b);
  auto rr=__builtin_amdgcn_permlane32_swap(__float_as_uint(m),__float_as_uint(m),false,false);
  return max2f(__uint_as_float(rr[0]),__uint_as_float(rr[1]));
}
__device__ __forceinline__ void pv(f32x16*o,int vb,bf16x8 pa0,bf16x8 pa1,bf16x8 pa2,bf16x8 pa3){
  #pragma unroll
  for(int d0=0;d0<4;++d0){s16x4 lo[4],hi[4];
    #pragma unroll
    for(int ks=0;ks<4;++ks){
      asm volatile("ds_read_b64_tr_b16 %0,%1 offset:%c2":"=&v"(lo[ks]):"v"(vb),"i"(d0*4096+ks*1024):"memory");
      asm volatile("ds_read_b64_tr_b16 %0,%1 offset:%c2":"=&v"(hi[ks]):"v"(vb),"i"(d0*4096+ks*1024+512):"memory");}
    asm volatile("s_waitcnt lgkmcnt(0)":::"memory");SBAR();
    #define PK(k) (bf16x8){lo[k][0],lo[k][1],lo[k][2],lo[k][3],hi[k][0],hi[k][1],hi[k][2],hi[k][3]}
    o[d0]=__builtin_amdgcn_mfma_f32_32x32x16_bf16(pa0,PK(0),o[d0],0,0,0);
    o[d0]=__builtin_amdgcn_mfma_f32_32x32x16_bf16(pa1,PK(1),o[d0],0,0,0);
    o[d0]=__builtin_amdgcn_mfma_f32_32x32x16_bf16(pa2,PK(2),o[d0],0,0,0);
    o[d0]=__builtin_amdgcn_mfma_f32_32x32x16_bf16(pa3,PK(3),o[d0],0,0,0);
    #undef PK
  }
}

#ifndef ATTN_STORE16
#define ATTN_STORE16(p,v) (*(u32x4*)(p)=(v))
#endif
template<int THRL,bool COMB> __device__ __forceinline__ void attn_unit(int b,int cq,int cv,int co,int qb,const bf16*Q,const bf16*__restrict__ K,const bf16*__restrict__ V,bf16*O,char*shm,float lam,const float*gain,bf16*YC,int yc,int wave_){
  const int lane=lane_id(),r32=lane&31,hi=lane>>5; const int wid=wave_; const int tid=wid*64+lane; (void)tid;
  const long rowbase=(long)b*SEQ; const int q0=qb*QB;
  const bf16*Qw=Q+(rowbase+q0+wid*QBLK)*DM+cq;
  const bf16*Kh=K+rowbase*DM+cq,*Vh=V+rowbase*DM+cv;
  const unsigned lds0=(unsigned)(uintptr_t)shm;
  float*wsf=(float*)(shm+LDS_WS)+wid*64;
  const bf16*ksrc=Kh+(long)lane*DM+wid*8;
  const bf16*vsrc=Vh+(long)(16*(wid&3)+(lane>>2))*DM+(wid>>2)*32+(lane&3)*8;
  const unsigned kdst=lds0+LDS_K+wid*1024, vdst=lds0+LDS_V+wid*1024;
  #define DMA_K(t,slot) glds16(ksrc+(long)(t)*KVBLK*DM,(unsigned)__builtin_amdgcn_readfirstlane(kdst+(slot)))
  #define DMA_V(t,slot) do{ glds16(vsrc+(long)(t)*KVBLK*DM,(unsigned)__builtin_amdgcn_readfirstlane(vdst+2*(slot))); glds16(vsrc+64+(long)(t)*KVBLK*DM,(unsigned)__builtin_amdgcn_readfirstlane(vdst+2*(slot)+8192)); }while(0)
  const char*Kbase=shm+LDS_K; bf16x8 kf[8];
  const lds_cptr shm3=(lds_cptr)shm; const lds_cptr kp0=shm3+LDS_K+hi*1024+r32*16; const lds_cptr vp0=shm3+LDS_V+((lane>>4)&1)*32+(lane&3)*8+(4*hi+((lane&15)>>2))*64;
  const int NT=(q0+QB)/KVBLK;
  DMA_K(0,0);DMA_V(0,0);DMA_K(1,SLOTB);
  bf16x8 qr[4];
  #pragma unroll
  for(int d0=0;d0<4;++d0)qr[d0]=*reinterpret_cast<const bf16x8*>(&Qw[(long)r32*DM+d0*16+hi*8]);
  float mhat=0.f,l_reg=0.f;f32x16 o[4];o[0]=f32x16{};o[1]=f32x16{};o[2]=f32x16{};o[3]=f32x16{};f32x16 negm=f32x16{};asm volatile("":"+v"(negm));
  const int qrel=wid*QBLK+r32;
  #define CMASK(P0,P1,t) do{int jb_=(t)-(NT-4); if(jb_>=0)cmask(P0,P1,jb_,qrel,hi);}while(0)
  bool resc=false;
  #define START(P0,P1) do{ const float rm=rowmax(P0,P1); resc=false; \
    { const float dl=rm; mhat=fadd_s(mhat,dl); \
      _Pragma("unroll") for(int r=0;r<16;++r){P0[r]=fsub_s(P0[r],dl);P1[r]=fsub_s(P1[r],dl);} \
      _Pragma("unroll") for(int r=0;r<16;++r)negm[r]=-mhat; asm volatile("":"+v"(negm)); } \
    _Pragma("unroll") for(int r=0;r<16;++r){P0[r]=__builtin_amdgcn_exp2f(P0[r]);P1[r]=__builtin_amdgcn_exp2f(P1[r]);} }while(0)
  #define RESC() do{ if(resc){ asm volatile("s_waitcnt lgkmcnt(0)":::"memory"); \
      _Pragma("unroll") for(int d_=0;d_<4;++d_) _Pragma("unroll") for(int r=0;r<16;++r)o[d_][r]*=wsf[crow(r,hi)]; } }while(0)
  f32x16 pA0,pA1,pB0,pB1;
  int sl_prev=0,sl_cur=0,sl_next=SLOTB;
  #define ROT() do{sl_prev=sl_cur;sl_cur=sl_next;sl_next=(sl_next==(NSLOT-1)*SLOTB)?0:sl_next+SLOTB;}while(0)
  DMA_K(2,2*SLOTB);
  WAIT_BAR(4);
  qkt(pA0,pA1,Kbase,qr,negm,r32,hi);asm volatile("s_nop 15\n\ts_nop 7":"+v"(pA0),"+v"(pA1));CMASK(pA0,pA1,0);
  START(pA0,pA1);
  WAIT_BAR(0);
  DMA_K(3,0);DMA_V(1,SLOTB);
  ROT();
  kload8(kf,kp0+sl_cur);
  WAIT_BAR(3);
  s16x4 vlo[4],vhi[4]; u32x4 pw0,pw1,pw2,pw3;
  #define PKW(P,B) cvtpk_s(P[B],P[B+1])
  #define PAF(k) __builtin_bit_cast(bf16x8,pw##k)
  #define VFR(i) (bf16x8){vlo[i][0],vlo[i][1],vlo[i][2],vlo[i][3],vhi[i][0],vhi[i][1],vhi[i][2],vhi[i][3]}
  #define PIN(x) asm volatile("":"+v"(x))
  #define MX3(a,b,c) __builtin_fmaxf(__builtin_fmaxf((a),(b)),(c))
  #define GAPA(MF,A0,A1,A2,A3,W0,W1,PW) do{ MF; sacc+=A0; sacc+=A1; sacc+=A2; sacc+=A3; PIN(sacc); W0; W1; PIN(PW); SBAR(); }while(0)
  #define EX(v) __builtin_amdgcn_exp2f(v)
  #define GAPB(MF,X,B) do{ MF; X[B]=EX(X[B]); X[B+1]=EX(X[B+1]); PIN(X); SBAR(); }while(0)
  #define VRD(sl,m) do{ vlo[sl]=vtr(vp_+((((m)&3))*4096+((m)>>2)*1024)); vhi[sl]=vtr(vp_+((((m)&3))*4096+((m)>>2)*1024+512)); }while(0)
  #define KRD(G,j) do{ if(G){ kload2(kf,kp0+sl_next,j); SBAR(); } }while(0)
  #define ZC (f32x16{})
  #define STEP(C0,C1,P0,P1,t,GK,GV,GL) do{ SBAR(); \
    const lds_cptr vp_=vp0+2*sl_prev; \
    float sacc=(P0[0]+P0[1]); \
    GAPA(C0=__builtin_amdgcn_mfma_f32_32x32x16_bf16(kf[0],qr[0],negm,0,0,0), P0[2],P0[3],P0[4],P0[5],     pw0[0]=PKW(P0,0), pw0[1]=PKW(P0,2), pw0); \
    GAPA(C1=__builtin_amdgcn_mfma_f32_32x32x16_bf16(kf[1],qr[0],negm,0,0,0), P0[6],P0[7],P0[8],P0[9],     pw0[2]=PKW(P0,4), pw0[3]=PKW(P0,6), pw0); \
    GAPA(C0=__builtin_amdgcn_mfma_f32_32x32x16_bf16(kf[2],qr[1],C0,0,0,0),   P0[10],P0[11],P0[12],P0[13], pw1[0]=PKW(P0,8), pw1[1]=PKW(P0,10), pw1); \
    GAPA(C1=__builtin_amdgcn_mfma_f32_32x32x16_bf16(kf[3],qr[1],C1,0,0,0),   P0[14],P0[15],P1[0],P1[1],   pw1[2]=PKW(P0,12),pw1[3]=PKW(P0,14), pw1); \
    GAPA(C0=__builtin_amdgcn_mfma_f32_32x32x16_bf16(kf[4],qr[2],C0,0,0,0),   P1[2],P1[3],P1[4],P1[5],     pw2[0]=PKW(P1,0), pw2[1]=PKW(P1,2), pw2); \
    GAPA(C1=__builtin_amdgcn_mfma_f32_32x32x16_bf16(kf[5],qr[2],C1,0,0,0),   P1[6],P1[7],P1[8],P1[9],     pw2[2]=PKW(P1,4), pw2[3]=PKW(P1,6), pw2); \
    GAPA(C0=__builtin_amdgcn_mfma_f32_32x32x16_bf16(kf[6],qr[3],C0,0,0,0),   P1[10],P1[11],P1[12],P1[13], pw3[0]=PKW(P1,8), pw3[1]=PKW(P1,10), pw3); \
    GAPA(C1=__builtin_amdgcn_mfma_f32_32x32x16_bf16(kf[7],qr[3],C1,0,0,0),   P1[14],P1[15],0.f,0.f,       pw3[2]=PKW(P1,12),pw3[3]=PKW(P1,14), pw3); \
    l_reg+=sacc; \
    VRD(0,0); VRD(1,1); VRD(2,2); VRD(3,3); SBAR(); \
    if(GK){DMA_K((t)+3,sl_cur);} if(GV){DMA_V((t)+1,sl_next);} \
    CMASK(C0,C1,t); \
    { float a=MX3(C0[0],C0[1],C1[0]),b=MX3(C0[2],C0[3],C1[1]); a=MX3(a,C1[2],C1[3]); \
      _Pragma("unroll") for(int r=4;r<16;r+=4){a=MX3(a,C0[r],C0[r+1]);b=MX3(b,C0[r+2],C0[r+3]);a=MX3(a,C1[r],C1[r+1]);b=MX3(b,C1[r+2],C1[r+3]);} \
      float rm=__builtin_fmaxf(a,b); { auto rr=__builtin_amdgcn_permlane32_swap(__float_as_uint(rm),__float_as_uint(rm),false,false); rm=__builtin_fmaxf(__uint_as_float(rr[0]),__uint_as_float(rr[1])); } \
      resc=false; \
      if(__builtin_expect(__any(rm>(float)THRL),0)){ const float dl=__builtin_fmaxf(rm,0.f); mhat+=dl; \
        _Pragma("unroll") for(int r=0;r<16;++r){C0[r]-=dl;C1[r]-=dl;} \
        _Pragma("unroll") for(int r=0;r<16;++r)negm[r]=-mhat; asm volatile("":"+v"(negm)); \
        const float f=__builtin_amdgcn_exp2f(-dl); l_reg*=f; if(hi==0)wsf[r32]=f; resc=true; } } \
    SBAR(); \
    GAPB(o[0]=__builtin_amdgcn_mfma_f32_32x32x16_bf16(PAF(0),VFR(0),o[0],0,0,0), C0,0);  VRD(0,4);  SBAR(); \
    GAPB(o[1]=__builtin_amdgcn_mfma_f32_32x32x16_bf16(PAF(0),VFR(1),o[1],0,0,0), C0,2);  VRD(1,5);  SBAR(); \
    GAPB(o[2]=__builtin_amdgcn_mfma_f32_32x32x16_bf16(PAF(0),VFR(2),o[2],0,0,0), C0,4);  VRD(2,6);  SBAR(); \
    GAPB(o[3]=__builtin_amdgcn_mfma_f32_32x32x16_bf16(PAF(0),VFR(3),o[3],0,0,0), C0,6);  VRD(3,7);  SBAR(); \
    GAPB(o[0]=__builtin_amdgcn_mfma_f32_32x32x16_bf16(PAF(1),VFR(0),o[0],0,0,0), C0,8);  VRD(0,8);  SBAR(); \
    GAPB(o[1]=__builtin_amdgcn_mfma_f32_32x32x16_bf16(PAF(1),VFR(1),o[1],0,0,0), C0,10);  VRD(1,9);  SBAR(); \
    KRD(GL,0); GAPB(o[2]=__builtin_amdgcn_mfma_f32_32x32x16_bf16(PAF(1),VFR(2),o[2],0,0,0), C0,12);  VRD(2,10);  SBAR(); \
    KRD(GL,1); GAPB(o[3]=__builtin_amdgcn_mfma_f32_32x32x16_bf16(PAF(1),VFR(3),o[3],0,0,0), C0,14);  VRD(3,11);  SBAR(); \
    KRD(GL,2); GAPB(o[0]=__builtin_amdgcn_mfma_f32_32x32x16_bf16(PAF(2),VFR(0),o[0],0,0,0), C1,0);  VRD(0,12);  SBAR(); \
    KRD(GL,3); GAPB(o[1]=__builtin_amdgcn_mfma_f32_32x32x16_bf16(PAF(2),VFR(1),o[1],0,0,0), C1,2);  VRD(1,13);  SBAR(); \
    GAPB(o[2]=__builtin_amdgcn_mfma_f32_32x32x16_bf16(PAF(2),VFR(2),o[2],0,0,0), C1,4);  VRD(2,14);  SBAR(); \
    GAPB(o[3]=__builtin_amdgcn_mfma_f32_32x32x16_bf16(PAF(2),VFR(3),o[3],0,0,0), C1,6);  VRD(3,15);  SBAR(); \
    GAPB(o[0]=__builtin_amdgcn_mfma_f32_32x32x16_bf16(PAF(3),VFR(0),o[0],0,0,0), C1,8); \
    GAPB(o[1]=__builtin_amdgcn_mfma_f32_32x32x16_bf16(PAF(3),VFR(1),o[1],0,0,0), C1,10); \
    GAPB(o[2]=__builtin_amdgcn_mfma_f32_32x32x16_bf16(PAF(3),VFR(2),o[2],0,0,0), C1,12); \
    GAPB(o[3]=__builtin_amdgcn_mfma_f32_32x32x16_bf16(PAF(3),VFR(3),o[3],0,0,0), C1,14); \
    }while(0)
  int t=1;
  #undef CMASK
  #define CMASK(P0,P1,t) do{}while(0)
  for(;t+5<NT;t+=2){
    STEP(pB0,pB1,pA0,pA1,t,true,true,true);     WAIT_BAR(3); RESC(); ROT();
    STEP(pA0,pA1,pB0,pB1,t+1,true,true,true);   WAIT_BAR(3); RESC(); ROT();
  }
  #undef CMASK
  #define CMASK(P0,P1,t) do{int jb_=(t)-(NT-4); if(jb_>=0)cmask(P0,P1,jb_,qrel,hi);}while(0)
  #define ENDW(tt) do{ if((tt)+3<NT){WAIT_BAR(3);} else if((tt)+2<NT){WAIT_BAR(2);} else {WAIT_BAR(0);} }while(0)
  for(;t+1<NT;t+=2){
    STEP(pB0,pB1,pA0,pA1,t,(t+3<NT),(t+1<NT),(t+1<NT));       ENDW(t);   RESC(); ROT();
    STEP(pA0,pA1,pB0,pB1,t+1,(t+4<NT),(t+2<NT),(t+2<NT));     ENDW(t+1); RESC(); ROT();
  }
  STEP(pB0,pB1,pA0,pA1,NT-1,false,false,false); RESC();
  { float sacc=pB0[0]+pB0[1]; _Pragma("unroll") for(int r=2;r<16;++r)sacc+=pB0[r]; _Pragma("unroll") for(int r=0;r<16;++r)sacc+=pB1[r]; l_reg+=sacc;
    pw0=(u32x4){PKW(pB0,0),PKW(pB0,2),PKW(pB0,4),PKW(pB0,6)};pw1=(u32x4){PKW(pB0,8),PKW(pB0,10),PKW(pB0,12),PKW(pB0,14)};pw2=(u32x4){PKW(pB1,0),PKW(pB1,2),PKW(pB1,4),PKW(pB1,6)};pw3=(u32x4){PKW(pB1,8),PKW(pB1,10),PKW(pB1,12),PKW(pB1,14)};
    const int le_=lane_id();
    const int vb0=(int)(lds0+LDS_V)+((le_>>4)&1)*32+(le_&3)*8+(4*(le_>>5)+((le_&15)>>2))*64;
    SBAR(); pv(o,vb0+2*sl_cur,PAF(0),PAF(1),PAF(2),PAF(3)); }
  #undef PKW
  #undef PAF
  #undef VFR
  #undef PIN
  #undef MX3
  #undef GAPA
  #undef GAPB
  #undef EX
  #undef VRD
  #undef KRD
  #undef ZC
  #undef STEP
  #undef ENDW
  {auto rr=__builtin_amdgcn_permlane32_swap(__float_as_uint(l_reg),__float_as_uint(l_reg),false,false);l_reg=__uint_as_float(rr[0])+__uint_as_float(rr[1]);}
  const int le=lane_id(); const int r32e=le&31,hie=le>>5;
  if(hie==0)wsf[32+r32e]=l_reg;asm volatile("s_waitcnt lgkmcnt(0)":::"memory");
  float rli[16];
  #pragma unroll
  for(int r=0;r<16;++r)rli[r]=__builtin_amdgcn_rcpf(wsf[32+crow(r,hie)]);
  bf16*Ow=O+(rowbase+q0+wid*QBLK)*OPITCH+co;
  { bf16*stash=(bf16*)(shm+LDS_STASH)+wid*4096;
    float dd[2][4][8]; float ssq[4]={0.f,0.f,0.f,0.f};
    if(!COMB){
      #pragma unroll
      for(int h2=0;h2<2;++h2){
        #pragma unroll
        for(int r=0;r<16;++r){const int orow=crow(r,hie);
          #pragma unroll
          for(int d0=0;d0<2;++d0)stash[h2*2048+orow*64+d0*32+r32e]=__float2bfloat16(o[2*h2+d0][r]*rli[r]);} }
    } else {
      bf16*stg=(bf16*)(shm+LDS_K)+wid*1024;
      #pragma unroll
      for(int h4=0;h4<4;++h4){ const int h2=h4>>1,q=h4&1;
        #pragma unroll
        for(int r=0;r<16;++r)stg[crow(r,hie)*32+r32e]=__float2bfloat16(o[h4][r]*rli[r]);
        asm volatile("s_waitcnt lgkmcnt(0)":::"memory");
        if(((le&7)>>2)==q){
          #pragma unroll
          for(int i=0;i<4;++i){const int row=i*8+(le>>3),ch=le&7; const u32x4 v=*(const u32x4*)(stg+row*32+(ch&3)*8);
            const u32x4 w=*(const u32x4*)(stash+h2*2048+row*64+ch*8);
            #pragma unroll
            for(int k=0;k<4;++k){ const float a0=__uint_as_float(w[k]<<16),a1=__uint_as_float(w[k]&0xffff0000u),b0=__uint_as_float(v[k]<<16),b1=__uint_as_float(v[k]&0xffff0000u);
              const float e0=a0-lam*b0,e1=a1-lam*b1; dd[h2][i][2*k]=e0; dd[h2][i][2*k+1]=e1; ssq[i]+=e0*e0+e1*e1; } } }
        asm volatile("s_waitcnt lgkmcnt(0)":::"memory"); } }
    if(COMB){
      #pragma unroll
      for(int i=0;i<4;++i){ float sq=ssq[i]; sq+=__shfl_xor(sq,1); sq+=__shfl_xor(sq,2); sq+=__shfl_xor(sq,4);
        const float rs=0.8f/sqrtf(sq*(1.f/128.f)+1e-6f); const int row=i*8+(le>>3),ch=le&7;
        #pragma unroll
        for(int h2=0;h2<2;++h2){ const float*gp=gain+h2*64+ch*8; u32x4 y;
          #pragma unroll
          for(int k=0;k<4;++k) y[k]=cvtpk_s(dd[h2][i][2*k]*rs*gp[2*k],dd[h2][i][2*k+1]*rs*gp[2*k+1]);
          *(u32x4*)(YC+(rowbase+q0+wid*QBLK+row)*1024+yc+h2*64+ch*8)=y; } } } }
  asm volatile("s_waitcnt lgkmcnt(0)\n\ts_barrier":::"memory");
  #undef DMA_K
  #undef DMA_V
  #undef CMASK
  #undef START
  #undef RESC
  #undef ROT
}
constexpr int ATTN_LDS_BYTES=LDS_BYTES;
struct AttnTensors { const bf16* Q; const bf16* K; const bf16* V; bf16* O; float lam; const float* gain; bf16* YC; };
struct AttnUnit { int grp; int qb; };
struct StaticOrder {
  int vcu, G, bx;
  __device__ __forceinline__ explicit StaticOrder(int grid,int block):vcu((grid%8==0)?(block%8)*(grid/8)+block/8:block),G(grid),bx(block){}
  __device__ __forceinline__ bool next(int i,AttnUnit&u)const{
    if(G==256){ if(i>=2)return false; const int s=vcu&15; u.grp=vcu>>4; u.qb=(i==0)?s:31-s; return true; }
    const int idx=bx+i*G; if(idx>=512)return false; u.grp=idx>>5; u.qb=idx&31; return true; }
};
template<class Sched,int THRL=8> __device__ __forceinline__ void attn_phase(char*lds,const AttnTensors&T,const Sched&S,int wave_){
  AttnUnit u;
  for(int i=0;S.next(i,u);++i){ const int b=u.grp>>3,vh=(u.grp&7)*2;
    attn_unit<THRL,false>(b,vh*64,(vh>>1)*128,vh*128,u.qb,T.Q,T.K,T.V,T.O,lds,0.f,nullptr,nullptr,0,wave_);
    attn_unit<THRL,true>(b,(vh+1)*64,(vh>>1)*128,(vh+1)*128,u.qb,T.Q,T.K,T.V,T.O,lds,T.lam,T.gain,T.YC,(vh>>1)*128,wave_); }
}
#undef SBAR
#undef WAIT_BAR
}
#define XB_TMO      128
#define XB_XCNT(j)  (256  + 64 * (j))
#define XB_XSUB(j)  (1280 + 64 * (j))
#define XB_XGEN(j)  (2304 + 64 * (j))
#define XB_TOP      3328
#define XB_TOPGEN   3392
#define XCD_BAR_WORDS 3456
#define XB_SPIN_CAP (1u << 18)

__device__ __forceinline__ unsigned xb_ld(unsigned* p)              { return __hip_atomic_load(p, __ATOMIC_RELAXED, __HIP_MEMORY_SCOPE_AGENT); }
__device__ __forceinline__ unsigned xb_add(unsigned* p, unsigned v) { return __hip_atomic_fetch_add(p, v, __ATOMIC_RELAXED, __HIP_MEMORY_SCOPE_AGENT); }
__device__ __forceinline__ unsigned xb_xcc_id() { return (unsigned)__builtin_amdgcn_s_getreg((3 << 11) | 20) & 0xFu; }
#define XB_SPIN(cond, bar) do { unsigned _sp = 0; while (cond) { __builtin_amdgcn_s_sleep(1); \
    if ((++_sp & 255u) == 0u) { if (xb_ld(&(bar)[XB_TMO])) break; if (_sp > XB_SPIN_CAP) { atomicAdd(&(bar)[XB_TMO], 1u); break; } } } } while (0)

struct XcdBarrier {
    unsigned* bar; unsigned x;
    volatile LAS unsigned* st;
};

__device__ __forceinline__ XcdBarrier xcd_barrier_post(unsigned* bar, volatile LAS unsigned* st, bool leader) {
    XcdBarrier b; b.bar = bar; b.x = xb_xcc_id(); b.st = st;
    if (leader) (void)xb_add(&bar[XB_XCNT(b.x)], 1u);
    return b;
}
__device__ __forceinline__ void xcd_barrier_complete(unsigned* bar, unsigned x, unsigned& nloc, unsigned& nx) {
    const unsigned G = gridDim.x * gridDim.y * gridDim.z;
    unsigned sum, cnt, mine, sp = 0u;
    for (;;) {
        sum = 0u; cnt = 0u; mine = 0u;
#pragma unroll
        for (unsigned j = 0; j < 16; ++j) { const unsigned c = xb_ld(&bar[XB_XCNT(j)]); sum += c; cnt += (c > 0u) ? 1u : 0u; mine = (j == x) ? c : mine; }
        if (sum == G) break;
        __builtin_amdgcn_s_sleep(1);
        if ((++sp & 255u) == 0u) { if (xb_ld(&bar[XB_TMO])) break; if (sp > XB_SPIN_CAP) { atomicAdd(&bar[XB_TMO], 1u); break; } }
    }
    nloc = mine > 0u ? mine : 1u; nx = cnt > 0u ? cnt : 1u;
}

__device__ __forceinline__ void xcd_barrier(const XcdBarrier& b, bool leader) {
    asm volatile("s_waitcnt vmcnt(0)" ::: "memory");
    __syncthreads();
    if (leader) {
        unsigned* bar = b.bar;
        __builtin_amdgcn_s_waitcnt(0);
        unsigned nloc = b.st[0], nx = b.st[1];
        if (nloc == 0u) { xcd_barrier_complete(bar, b.x, nloc, nx); b.st[0] = nloc; b.st[1] = nx; }
        const unsigned old = xb_add(&bar[XB_XSUB(b.x)], 1u);
        const unsigned gen = old / nloc;
        if (old + 1u == (gen + 1u) * nloc) {
            __builtin_amdgcn_fence(__ATOMIC_RELEASE, "agent");
            asm volatile("s_waitcnt vmcnt(0)" ::: "memory");
            const unsigned og = xb_add(&bar[XB_TOP], 1u);
            const unsigned tg = og / nx;
            if (og + 1u == (tg + 1u) * nx) xb_add(&bar[XB_TOPGEN], 1u);
            else XB_SPIN(xb_ld(&bar[XB_TOPGEN]) == tg, bar);
            __builtin_amdgcn_fence(__ATOMIC_ACQUIRE, "agent");
            xb_add(&bar[XB_XGEN(b.x)], 1u);
            asm volatile("s_waitcnt vmcnt(0)" ::: "memory");
        } else {
            XB_SPIN(xb_ld(&bar[XB_XGEN(b.x)]) == gen, bar);
            __builtin_amdgcn_fence(__ATOMIC_ACQUIRE, "agent");
            asm volatile("s_waitcnt vmcnt(0)" ::: "memory");
        }
    }
    __syncthreads();
}
struct Args { const void* in[32]; float* out; unsigned char* ws; int ph_lo, ph_hi, G, pad; };
typedef const __attribute__((address_space(4))) Args* KA;
__device__ __forceinline__ KA ka_fresh() { KA p = (KA)__builtin_amdgcn_kernarg_segment_ptr(); asm volatile("" : "+s"(p)); return p; }
__device__ __forceinline__ int tid_fresh(int wave) { return wave * 64 + lane_id(); }
#define INF(k) ((const float*)a->in[k])
enum { I_X = 0, I_C, I_POS, I_WADA, I_BADA, I_NMIX, I_WIN, I_BGATE, I_LQ1, I_LK1, I_LQ2, I_LK2, I_HNORM, I_CONVW, I_CONVB, I_DTB, I_ALOG, I_DSKIP, I_SSDN,
       I_WBA, I_WBS, I_WOUT, I_NFFN, I_WR, I_RB, I_WEG, I_WEU, I_WED, I_WSG, I_WSU, I_WSD, I_NFIN };

__device__ __forceinline__ void ph0_mod(KA a, LAS unsigned char* lds, int tid) {
    const float* c = INF(I_C); const float* w_ada = INF(I_WADA); const float* b_ada = INF(I_BADA); float* mod = (float*)(a->ws + WS_MOD);
    LAS float* scr = (LAS float*)lds;
    for (int wg = blockIdx.x; wg < 192; wg += gridDim.x) {
        const int kg = tid >> 3, cq = tid & 7;
        f32x4 a0 = {0.f, 0.f, 0.f, 0.f}, a1 = {0.f, 0.f, 0.f, 0.f};
#pragma unroll 4
        for (int it = 0; it < 16; ++it) { const int k = kg + 64 * it; const f32x4 w = *(const f32x4*)(w_ada + (size_t)k * 6144 + 32 * wg + 4 * cq);
            const float s0 = silu_f(c[k]), s1 = silu_f(c[1024 + k]); a0 += s0 * w; a1 += s1 * w; }
        *(LAS f32x4*)(scr + (kg * 8 + cq) * 8) = a0; *(LAS f32x4*)(scr + (kg * 8 + cq) * 8 + 4) = a1;
        __syncthreads();
        if (tid < 64) { const int b = tid >> 5, col = tid & 31; float s = 0.f;
            for (int g = 0; g < 64; ++g) s += scr[(g * 8 + (col >> 2)) * 8 + b * 4 + (col & 3)];
            mod[b * 6144 + 32 * wg + col] = s + b_ada[32 * wg + col]; }
        __syncthreads();
    }
}
__device__ __forceinline__ void ph0_misc(KA a, gu32* ctl, int gtid, int gthreads) {
    const int* pos = (const int*)a->in[I_POS]; float* cs = (float*)(a->ws + WS_CS);
    const float invf[8] = {1.0f, 0.193922758102417f, 0.03760603070259094f, 0.00729266507551074f, 0.001414213445968926f, 0.00027424818836152554f, 5.318296462064609e-05f, 1.0313385246263351e-05f};
    for (int it = gtid; it < M * 8; it += gthreads) {
        const int tok = it >> 3, i = it & 7;
        float f = invf[0];
#pragma unroll
        for (int j = 1; j < 8; ++j) f = (i == j) ? invf[j] : f;
        const float ang = (float)pos[tok] * f;
        const double ad = (double)ang; const double kk = rint(ad * 0.15915494309189535); const float r = (float)(ad - kk * 6.283185307179586);
        cs[tok * 16 + i] = __cosf(r); cs[tok * 16 + 8 + i] = __sinf(r);
    }
    if (gtid == 0) {
        float s1 = 0.f, s2 = 0.f;
        for (int i = 0; i < 64; ++i) { s1 += INF(I_LQ1)[i] * INF(I_LK1)[i]; s2 += INF(I_LQ2)[i] * INF(I_LK2)[i]; }
        const float lam = expf(s1) - expf(s2) + LAMBDA_INIT;
        ctl[CW_LAM] = __builtin_bit_cast(unsigned, lam);
    }
}
struct TrDesc { const float* src; bf16* dst; const float* ksc; int ldw, ldo; };
__device__ __forceinline__ int gu_row(int n0, int is_up) { return (n0 < 128 ? n0 : 256 + (n0 - 128)) + (is_up ? 128 : 0); }
constexpr int TR_I1 = 16 * 321, TR_I2 = 16 * 32, TR_I3 = 32 * 32, TR_I4 = 16 * 32, TR_I5 = 16 * 8, TR_I5B = 16 * 8, TR_I6 = 2 * 16 * 8, TR_I7 = 4 * 32, TR_I8 = 256 * 2 * 16 * 8, TR_I9 = 256 * 4 * 32;
constexpr int TR_NSMALL = TR_I1 + TR_I2 + TR_I3 + TR_I4 + TR_I5 + TR_I5B + TR_I6 + TR_I7;
constexpr int TR_NITEMS = TR_NSMALL + TR_I8 + TR_I9;
__device__ __forceinline__ TrDesc tr_decode(KA a, int it) {
    unsigned char* ws = a->ws; TrDesc d; int r = it;
#define TRD(W_, ldw_, k0_, n0_, WT_, ldo_, orow_) do { d.src = (W_) + (size_t)(k0_) * (ldw_) + (n0_); d.ldw = (ldw_); d.dst = (WT_) + (size_t)(orow_) * (ldo_) + (k0_); d.ldo = (ldo_); d.ksc = nullptr; return d; } while (0)
    if (r < TR_I1) { const int kb = r / 321, nb = r % 321, n0 = 32 * nb; const int orow = n0 < 8192 ? n0 : (n0 < 8224 ? 10240 : n0 - 32);
        TRD(INF(I_WIN), IN_COLS, 64 * kb, n0, (bf16*)(ws + WS_WIN), 1024, orow); } r -= TR_I1;
    if (r < TR_I2) TRD(INF(I_WBA), 1024, 64 * (r / 32), 32 * (r % 32), (bf16*)(ws + WS_WA), 1024, 32 * (r % 32)); r -= TR_I2;
    if (r < TR_I3) { const int k0 = 64 * (r / 32), n0 = 32 * (r % 32);
        d.src = INF(I_WBS) + (size_t)k0 * 1024 + n0; d.ldw = 1024; d.dst = (bf16*)(ws + WS_WS) + (size_t)n0 * 2048 + k0; d.ldo = 2048; d.ksc = INF(I_SSDN) + k0; return d; } r -= TR_I3;
    if (r < TR_I4) TRD(INF(I_WOUT), 1024, 64 * (r / 32), 32 * (r % 32), (bf16*)(ws + WS_WO), 1024, 32 * (r % 32)); r -= TR_I4;
    if (r < TR_I5) TRD(INF(I_WR), 256, 64 * (r / 8), 32 * (r % 8), (bf16*)(ws + WS_WRS), 1024, 32 * (r % 8)); r -= TR_I5;
    if (r < TR_I5B) TRD(INF(I_WR), 256, 64 * (r / 8), 32 * (r % 8), (bf16*)(ws + WS_WRS), 1024, 768 + 32 * (r % 8)); r -= TR_I5B;
    if (r < TR_I6) { const int up = r / 128, q = r % 128, n0 = 32 * (q % 8); TRD(up ? INF(I_WSU) : INF(I_WSG), 256, 64 * (q / 8), n0, (bf16*)(ws + WS_WRS), 1024, 256 + gu_row(n0, up)); } r -= TR_I6;
    if (r < TR_I7) TRD(INF(I_WSD), 1024, 64 * (r / 32), 32 * (r % 32), (bf16*)(ws + WS_WSHD), 256, 32 * (r % 32)); r -= TR_I7;
    if (r < TR_I8) { const int e = r / 256, q = r % 256, up = q / 128, q2 = q % 128, n0 = 32 * (q2 % 8);
        TRD((up ? INF(I_WEU) : INF(I_WEG)) + (size_t)e * 1024 * 256, 256, 64 * (q2 / 8), n0, (bf16*)(ws + WS_WEGU) + (size_t)e * 512 * 1024, 1024, gu_row(n0, up)); } r -= TR_I8;
    { const int e = r / 128, q = r % 128; TRD(INF(I_WED) + (size_t)e * 256 * 1024, 1024, 64 * (q / 32), 32 * (q % 32), (bf16*)(ws + WS_WED) + (size_t)e * 1024 * 256, 256, 32 * (q % 32)); }
#undef TRD
}
__device__ __forceinline__ void tr_load(const TrDesc& d, float (&v)[32], int lane) {
#pragma unroll
    for (int i = 0; i < 32; ++i) { const int kk = 2 * i + (lane >> 5); v[i] = __builtin_nontemporal_load(d.src + (size_t)kk * d.ldw + (lane & 31)); }
    if (d.ksc) {
#pragma unroll
        for (int i = 0; i < 32; ++i) v[i] *= d.ksc[2 * i + (lane >> 5)]; }
}
__device__ __forceinline__ void tr_store(const TrDesc& d, const float (&v)[32], LAS float* scr, int lane) {
#pragma unroll
    for (int i = 0; i < 32; ++i) { const int kk = 2 * i + (lane >> 5); scr[kk * 33 + (lane & 31)] = v[i]; }
    LDS_WAIT(); asm volatile("" ::: "memory");
    const int c = lane & 7;
#pragma unroll
    for (int j = 0; j < 4; ++j) { const int n = (lane >> 3) + 8 * j; const LAS float* s = scr + (8 * c) * 33 + n;
        v4u o; o.x = pk2(s[0 * 33], s[1 * 33]); o.y = pk2(s[2 * 33], s[3 * 33]); o.z = pk2(s[4 * 33], s[5 * 33]); o.w = pk2(s[6 * 33], s[7 * 33]);
        __builtin_nontemporal_store(o, (GAS v4u*)(d.dst + (size_t)n * d.ldo + 8 * c)); }
    LDS_WAIT(); asm volatile("" ::: "memory");
}
constexpr int HELPER_CUS = 64;
constexpr int TR_SPLIT = TR_I1;
__device__ __forceinline__ void ph0_weights(KA a, LAS unsigned char* lds, int gw, int NGW, int wave, int lane, int it_lo, int it_hi) {
    LAS float* scr = (LAS float*)(lds + wave * 16384);
    for (int it = it_lo + gw; it < it_hi; it += 4 * NGW) {
        const int i1 = it + NGW, i2 = it + 2 * NGW, i3 = it + 3 * NGW;
        const bool h1 = i1 < it_hi, h2 = i2 < it_hi, h3 = i3 < it_hi;
        const TrDesc d0 = tr_decode(a, it), d1 = tr_decode(a, h1 ? i1 : it), d2 = tr_decode(a, h2 ? i2 : it), d3 = tr_decode(a, h3 ? i3 : it);
        float v0[32], v1[32], v2[32], v3[32];
        tr_load(d0, v0, lane); tr_load(d1, v1, lane); tr_load(d2, v2, lane); tr_load(d3, v3, lane);
        tr_store(d0, v0, scr, lane);
        if (h1) tr_store(d1, v1, scr, lane);
        if (h2) tr_store(d2, v2, scr, lane);
        if (h3) tr_store(d3, v3, scr, lane);
    }
}
__device__ __forceinline__ void convert_queue(KA a, LAS unsigned char* lds, gu32* qhead, int wave, int lane, int it_lo, int it_hi) {
    LAS float* scr = (LAS float*)(lds + wave * 16384);
    for (;;) {
        unsigned got = 0u; if (lane == 0) got = __hip_atomic_fetch_add(qhead, 16u, RLX_AGENT);
        const int base = it_lo + (int)__builtin_amdgcn_readfirstlane((int)got);
        if (base >= it_hi) break;
        for (int it = base; it < base + 16 && it < it_hi; it += 4) {
            const int i1 = it + 1, i2 = it + 2, i3 = it + 3;
            const bool h1 = i1 < it_hi, h2 = i2 < it_hi, h3 = i3 < it_hi;
            const TrDesc d0 = tr_decode(a, it), d1 = tr_decode(a, h1 ? i1 : it), d2 = tr_decode(a, h2 ? i2 : it), d3 = tr_decode(a, h3 ? i3 : it);
            float v0[32], v1[32], v2[32], v3[32];
            tr_load(d0, v0, lane); tr_load(d1, v1, lane); tr_load(d2, v2, lane); tr_load(d3, v3, lane);
            tr_store(d0, v0, scr, lane);
            if (h1) tr_store(d1, v1, scr, lane);
            if (h2) tr_store(d2, v2, scr, lane);
            if (h3) tr_store(d3, v3, scr, lane);
        }
    }
}
__device__ __forceinline__ v4u pack8(const f32x4 v0, const f32x4 v1) { v4u w; w.x = pk2(v0[0], v0[1]); w.y = pk2(v0[2], v0[3]); w.z = pk2(v1[0], v1[1]); w.w = pk2(v1[2], v1[3]); return w; }
__device__ __forceinline__ void unpack8(const v4u w, float* f) { f[0] = bflo(w.x); f[1] = bfhi(w.x); f[2] = bflo(w.y); f[3] = bfhi(w.y); f[4] = bflo(w.z); f[5] = bfhi(w.z); f[6] = bflo(w.w); f[7] = bfhi(w.w); }
template <bool BF16IN> __device__ __forceinline__ void norm_rows(const void* xin_, const float* gain, const float* mod, int shift_off, int scale_off, bf16* out, int gw, int NGW, int lane) {
    for (int b = 0; b < BATCH; ++b) {
        f32x4 ga[4], sh[4];
#pragma unroll
        for (int q = 0; q < 4; ++q) { const int col = 8 * lane + 512 * (q >> 1) + 4 * (q & 1);
            const f32x4 g = *(const f32x4*)(gain + col), sc = *(const f32x4*)(mod + b * 6144 + scale_off + col); sh[q] = *(const f32x4*)(mod + b * 6144 + shift_off + col); ga[q] = g * (1.f + sc); }
        int m = gw; while (m < b * SEQ) m += NGW;
        const int mend = (b + 1) * SEQ;
        f32x4 v[4], nx[4];
#define NR_LOAD(m_) do { if (BF16IN) { _Pragma("unroll") for (int jj = 0; jj < 2; ++jj) { float t_[8]; unpack8(*(const GAS v4u*)((const bf16*)xin_ + (size_t)(m_) * D + 8 * lane + 512 * jj), t_); \
                nx[2 * jj] = (f32x4){t_[0], t_[1], t_[2], t_[3]}; nx[2 * jj + 1] = (f32x4){t_[4], t_[5], t_[6], t_[7]}; } } \
            else { _Pragma("unroll") for (int q = 0; q < 4; ++q) nx[q] = *(const GAS f32x4*)((const float*)xin_ + (size_t)(m_) * D + 8 * lane + 512 * (q >> 1) + 4 * (q & 1)); } } while (0)
        if (m < mend) NR_LOAD(m);
        for (; m < mend; m += NGW) {
            float s = 0.f;
#pragma unroll
            for (int q = 0; q < 4; ++q) { v[q] = nx[q]; s += (v[q].x * v[q].x + v[q].y * v[q].y) + (v[q].z * v[q].z + v[q].w * v[q].w); }
            if (m + NGW < mend) NR_LOAD(m + NGW);
            const float rstd = 1.f / sqrtf(wave_sum(s) * (1.f / D) + EPS);
#pragma unroll
            for (int jj = 0; jj < 2; ++jj) { const f32x4 y0 = v[2 * jj] * rstd * ga[2 * jj] + sh[2 * jj], y1 = v[2 * jj + 1] * rstd * ga[2 * jj + 1] + sh[2 * jj + 1];
                v4u o; o.x = pk2(y0.x, y0.y); o.y = pk2(y0.z, y0.w); o.z = pk2(y1.x, y1.y); o.w = pk2(y1.z, y1.w);
                *(GAS v4u*)(out + (size_t)m * D + 8 * lane + 512 * jj) = o; }
        }
#undef NR_LOAD
    }
}
using pg8::Unit;

struct EpiInProj {
    KA a0;
    __device__ __forceinline__ void operator()(const f32x4 (&acc)[2][2][4][2], const Unit& u, int wr, int wc, int fr, int fq) const {
        KA a = a0; asm volatile("" : "+s"(a));
        unsigned char* ws = a->ws;
        const int pn = u.pn; const int row0 = u.pm * 256 + wr * 64 + fr, tc0 = 32 * wc + 8 * fq;
        if (pn < 8) {
            bf16* dst = (bf16*)(ws + (pn < 4 ? WS_Q : WS_K)) + (pn & 3) * 256; const float sc = pn < 4 ? QSCALE : 1.f;
            if ((wc & 1) == 0) {
                const float* cs = (const float*)(ws + WS_CS);
                constexpr int KD = 2; f32x4 c0[KD + 1], c1[KD + 1], s0[KD + 1], s1[KD + 1]; const float sg = (fq == 0) ? -1.f : 1.f; const bool rot = fq < 2;
#define EPI_LD(ir) do { const float* p_ = cs + (size_t)(row0 + ((ir) >> 2) * 128 + ((ir) & 3) * 16) * 16; c0[(ir) % (KD + 1)] = *(const f32x4*)(p_); c1[(ir) % (KD + 1)] = *(const f32x4*)(p_ + 4); \
                    s0[(ir) % (KD + 1)] = *(const f32x4*)(p_ + 8); s1[(ir) % (KD + 1)] = *(const f32x4*)(p_ + 12); } while (0)
#pragma unroll
                for (int ir = 0; ir < KD; ++ir) EPI_LD(ir);
#pragma unroll
                for (int ir = 0; ir < 8; ++ir) {
                    if (ir + KD < 8) EPI_LD(ir + KD);
                    const int ai = ir >> 2, m = ir & 3; const int row = row0 + ai * 128 + m * 16;
                    f32x4 cc0 = c0[ir % (KD + 1)], cc1 = c1[ir % (KD + 1)], ss0 = s0[ir % (KD + 1)], ss1 = s1[ir % (KD + 1)];
#pragma unroll
                    for (int jj = 0; jj < 4; ++jj) { cc0[jj] = rot ? cc0[jj] : 1.f; cc1[jj] = rot ? cc1[jj] : 1.f; ss0[jj] = rot ? ss0[jj] * sg : 0.f; ss1[jj] = rot ? ss1[jj] * sg : 0.f; }
#pragma unroll
                    for (int bj = 0; bj < 2; ++bj) {
                        f32x4 v0 = acc[ai][bj][m][0], v1 = acc[ai][bj][m][1], o0, o1;
#pragma unroll
                        for (int jj = 0; jj < 4; ++jj) { o0[jj] = __shfl_xor(v0[jj], 16); o1[jj] = __shfl_xor(v1[jj], 16); }
                        v0 = (v0 * cc0 + o0 * ss0) * sc; v1 = (v1 * cc1 + o1 * ss1) * sc;
                        *(v4u*)(dst + (size_t)row * 1024 + 128 * bj + tc0) = pack8(v0, v1);
                    }
                }
#undef EPI_LD
            } else {
#pragma unroll
                for (int it = 0; it < 16; ++it) { const int ai = it >> 3, m = (it >> 1) & 3, bj = it & 1; const int row = row0 + ai * 128 + m * 16;
                    *(v4u*)(dst + (size_t)row * 1024 + 128 * bj + tc0) = pack8(acc[ai][bj][m][0] * sc, acc[ai][bj][m][1] * sc); }
            }
        } else if (pn < 12) {
            bf16* V = (bf16*)(ws + WS_V) + (pn - 8) * 256;
#pragma unroll
            for (int it = 0; it < 16; ++it) { const int ai = it >> 3, m = (it >> 1) & 3, bj = it & 1; const int row = row0 + ai * 128 + m * 16;
                *(v4u*)(V + (size_t)row * 1024 + 128 * bj + tc0) = pack8(acc[ai][bj][m][0], acc[ai][bj][m][1]); }
        } else if (pn < 20) {
            bf16* ZS = (bf16*)(ws + WS_ZS) + (pn - 12) * 256;
#pragma unroll
            for (int it = 0; it < 16; ++it) { const int ai = it >> 3, m = (it >> 1) & 3, bj = it & 1; const int row = row0 + ai * 128 + m * 16;
                f32x4 v0 = acc[ai][bj][m][0], v1 = acc[ai][bj][m][1];
#pragma unroll
                for (int jj = 0; jj < 4; ++jj) { v0[jj] = silu_f(v0[jj]); v1[jj] = silu_f(v1[jj]); }
                *(v4u*)(ZS + (size_t)row * 2048 + 128 * bj + tc0) = pack8(v0, v1); }
        } else if (pn < 32) {
            bf16* XBC = (bf16*)(ws + WS_XBC) + (pn - 20) * 256;
#pragma unroll
            for (int it = 0; it < 16; ++it) { const int ai = it >> 3, m = (it >> 1) & 3, bj = it & 1; const int row = row0 + ai * 128 + m * 16;
                *(v4u*)(XBC + (size_t)row * 3072 + 128 * bj + tc0) = pack8(acc[ai][bj][m][0], acc[ai][bj][m][1]); }
        } else if (pn < 40) {
            bf16* GATES = (bf16*)(ws + WS_GATES) + (pn - 32) * 256; const float* b_gate = INF(I_BGATE) + (pn - 32) * 256 + tc0;
            f32x4 bg[2][2];
#pragma unroll
            for (int bj = 0; bj < 2; ++bj) { bg[bj][0] = *(const f32x4*)(b_gate + 128 * bj); bg[bj][1] = *(const f32x4*)(b_gate + 128 * bj + 4); }
#pragma unroll
            for (int it = 0; it < 16; ++it) { const int ai = it >> 3, m = (it >> 1) & 3, bj = it & 1; const int row = row0 + ai * 128 + m * 16;
                f32x4 v0 = acc[ai][bj][m][0], v1 = acc[ai][bj][m][1];
#pragma unroll
                for (int jj = 0; jj < 4; ++jj) { v0[jj] = sigmoid_f(v0[jj] + bg[bj][0][jj]); v1[jj] = sigmoid_f(v1[jj] + bg[bj][1][jj]); }
                *(v4u*)(GATES + (size_t)row * 2048 + 128 * bj + tc0) = pack8(v0, v1); }
        } else {
            if (wc == 0) {
                float* DT = (float*)(ws + WS_DT); const float* dt_bias = INF(I_DTB);
                const f32x4 b0 = *(const f32x4*)(dt_bias + tc0), b1 = *(const f32x4*)(dt_bias + tc0 + 4);
#pragma unroll
                for (int ir = 0; ir < 8; ++ir) { const int ai = ir >> 2, m = ir & 3; const int row = row0 + ai * 128 + m * 16;
                    f32x4 v0 = acc[ai][0][m][0], v1 = acc[ai][0][m][1];
#pragma unroll
                    for (int jj = 0; jj < 4; ++jj) { v0[jj] = softplus_f(v0[jj] + b0[jj]); v1[jj] = softplus_f(v1[jj] + b1[jj]); }
                    *(f32x4*)(DT + (size_t)row * 32 + tc0) = v0; *(f32x4*)(DT + (size_t)row * 32 + tc0 + 4) = v1; }
            }
        }
    }
};
struct EpiMixA {
    KA a0; LAS const float* rs;
    __device__ __forceinline__ void operator()(f32x4 (&acc)[2][2][4][2], const Unit& u, int wr, int wc, int fr, int fq) const {
        KA a = a0; asm volatile("" : "+s"(a));
        const bf16* GATES = (const bf16*)(a->ws + WS_GATES);
        const int row0 = u.pm * 256 + wr * 64 + fr, col0 = u.pn * 256 + 32 * wc + 8 * fq;
        constexpr int KD = 7; v4u ga[KD + 1], gs[KD + 1];
#define EPI_LD(it) do { const bf16* p_ = GATES + (size_t)(row0 + ((it) >> 3) * 128 + (((it) >> 1) & 3) * 16) * 2048 + col0 + 128 * ((it) & 1); ga[(it) % (KD + 1)] = *(const v4u*)p_; gs[(it) % (KD + 1)] = *(const v4u*)(p_ + 1024); } while (0)
#pragma unroll
        for (int it = 0; it < KD; ++it) EPI_LD(it);
#pragma unroll
        for (int it = 0; it < 16; ++it) {
            if (it + KD < 16) EPI_LD(it + KD);
            const int ai = it >> 3, m = (it >> 1) & 3, bj = it & 1;
            const float r0i = __builtin_amdgcn_rcpf(rs[(ai * 128 + wr * 64 + m * 16 + fr) * 4]);
            float fa[8], fs[8]; unpack8(ga[it % (KD + 1)], fa); unpack8(gs[it % (KD + 1)], fs);
#pragma unroll
            for (int j = 0; j < 4; ++j) { acc[ai][bj][m][0][j] *= fa[j] * __builtin_amdgcn_rcpf(fmaxf(fs[j], 1e-30f)) * r0i; acc[ai][bj][m][1][j] *= fa[4 + j] * __builtin_amdgcn_rcpf(fmaxf(fs[4 + j], 1e-30f)) * r0i; }
            asm volatile("" : "+v"(acc[ai][bj][m][0]), "+v"(acc[ai][bj][m][1]));
        }
#undef EPI_LD
    }
};
struct HookGrp {
    static constexpr bool ON = true; LAS const float* rs;
    __device__ __forceinline__ void operator()(f32x4 (&acc)[2][2][4][2], int t, int wr) const {
        if (t == 8 || t == 16 || t == 24) {
            const int gi = (t >> 3) - 1; const int fr = lane_id() & 15;
#pragma unroll
            for (int ai = 0; ai < 2; ++ai)
#pragma unroll
                for (int m = 0; m < 4; ++m) { const int rl = ai * 128 + wr * 64 + m * 16 + fr; const float f = rs[rl * 4 + gi] * __builtin_amdgcn_rcpf(rs[rl * 4 + gi + 1]);
#pragma unroll
                    for (int bj = 0; bj < 2; ++bj) { acc[ai][bj][m][0] = acc[ai][bj][m][0] * f; acc[ai][bj][m][1] = acc[ai][bj][m][1] * f; } }
        }
    }
};
struct EpiMixB {
    KA a0; LAS const float* rs;
    __device__ __forceinline__ void operator()(const f32x4 (&acc)[2][2][4][2], const Unit& u, int wr, int wc, int fr, int fq) const {
        KA a = a0; asm volatile("" : "+s"(a));
        unsigned char* ws = a->ws; const bf16* GATES = (const bf16*)(ws + WS_GATES); bf16* MIXED = (bf16*)(ws + WS_MIXED);
        const int row0 = u.pm * 256 + wr * 64 + fr, col0 = u.pn * 256 + 32 * wc + 8 * fq;
        v4u g[16];
#pragma unroll
        for (int it = 0; it < 16; ++it) g[it] = *(const v4u*)(GATES + (size_t)(row0 + (it >> 3) * 128 + ((it >> 1) & 3) * 16) * 2048 + 1024 + col0 + 128 * (it & 1));
#pragma unroll
        for (int it = 0; it < 16; ++it) { const int ai = it >> 3, m = (it >> 1) & 3, bj = it & 1; const int row = row0 + ai * 128 + m * 16, col = col0 + 128 * bj;
            const float r3 = rs[(ai * 128 + wr * 64 + m * 16 + fr) * 4 + 3];
            float gf[8]; unpack8(g[it], gf);
            f32x4 v0 = acc[ai][bj][m][0], v1 = acc[ai][bj][m][1];
#pragma unroll
            for (int jj = 0; jj < 4; ++jj) { v0[jj] = v0[jj] * fmaxf(gf[jj], 1e-30f) * r3; v1[jj] = v1[jj] * fmaxf(gf[4 + jj], 1e-30f) * r3; }
            *(v4u*)(MIXED + (size_t)row * 1024 + col) = pack8(v0, v1); }
    }
};
struct EpiOut {
    KA a0;
    __device__ __forceinline__ void operator()(const f32x4 (&acc)[2][2][4][2], const Unit& u, int wr, int wc, int fr, int fq) const {
        KA a = a0; asm volatile("" : "+s"(a));
        const float* X = INF(I_X); const float* mod = (const float*)(a->ws + WS_MOD); bf16* X1 = (bf16*)(a->ws + WS_X1H);
        const int row0 = u.pm * 256 + wr * 64 + fr, col0 = u.pn * 256 + 32 * wc + 8 * fq; const int b = (u.pm * 256) >> 13;
        f32x4 gm[2][2];
#pragma unroll
        for (int bj = 0; bj < 2; ++bj) { gm[bj][0] = *(const f32x4*)(mod + b * 6144 + 2048 + col0 + 128 * bj); gm[bj][1] = *(const f32x4*)(mod + b * 6144 + 2048 + col0 + 128 * bj + 4); }
#pragma unroll
        for (int ai = 0; ai < 2; ++ai) {
            f32x4 x0[8], x1[8];
#pragma unroll
            for (int k = 0; k < 8; ++k) { const float* p = X + (size_t)(row0 + ai * 128 + (k >> 1) * 16) * 1024 + col0 + 128 * (k & 1); x0[k] = *(const f32x4*)p; x1[k] = *(const f32x4*)(p + 4); }
#pragma unroll
            for (int k = 0; k < 8; ++k) { const int m = k >> 1, bj = k & 1; const int row = row0 + ai * 128 + m * 16, col = col0 + 128 * bj;
                *(v4u*)(X1 + (size_t)row * 1024 + col) = pack8(x0[k] + gm[bj][0] * acc[ai][bj][m][0], x1[k] + gm[bj][1] * acc[ai][bj][m][1]); }
        }
    }
};
struct EpiRS {
    KA a0;
    __device__ __forceinline__ void operator()(const f32x4 (&acc)[2][2][4][2], const Unit& u, int wr, int wc, int fr, int fq) const {
        KA a = a0; asm volatile("" : "+s"(a));
        unsigned char* ws = a->ws; float* LOGITS = (float*)(ws + WS_LOGITS); bf16* HS = (bf16*)(ws + WS_HS);
        const int row0 = u.pm * 256 + wr * 64 + fr;
#pragma unroll
        for (int ai = 0; ai < 2; ++ai)
#pragma unroll
            for (int m = 0; m < 4; ++m) { const int row = row0 + ai * 128 + m * 16;
                if (u.pn == 0 || u.pn == 3) {
                    if (ai == (u.pn == 3 ? 1 : 0)) {
#pragma unroll
                        for (int bj = 0; bj < 2; ++bj) { const int col = 128 * bj + 32 * wc + 8 * fq;
                            *(f32x4*)(LOGITS + (size_t)row * 256 + col) = acc[ai][bj][m][0]; *(f32x4*)(LOGITS + (size_t)row * 256 + col + 4) = acc[ai][bj][m][1]; } }
                } else {
                    f32x4 v0, v1;
#pragma unroll
                    for (int j = 0; j < 4; ++j) { v0[j] = silu_f(acc[ai][0][m][0][j]) * acc[ai][1][m][0][j]; v1[j] = silu_f(acc[ai][0][m][1][j]) * acc[ai][1][m][1][j]; }
                    *(v4u*)(HS + (size_t)row * 256 + (u.pn - 1) * 128 + 32 * wc + 8 * fq) = pack8(v0, v1);
                }
            }
    }
};
struct EpiStore {
    KA a0; size_t off; int ldc;
    __device__ __forceinline__ void operator()(const f32x4 (&acc)[2][2][4][2], const Unit& u, int wr, int wc, int fr, int fq) const {
        KA a = a0; asm volatile("" : "+s"(a));
        bf16* O = (bf16*)(a->ws + off);
        const int row0 = u.pm * 256 + wr * 64 + fr;
#pragma unroll
        for (int ai = 0; ai < 2; ++ai)
#pragma unroll
            for (int m = 0; m < 4; ++m) { const int row = row0 + ai * 128 + m * 16;
#pragma unroll
                for (int bj = 0; bj < 2; ++bj) *(v4u*)(O + (size_t)row * ldc + u.pn * 256 + 128 * bj + 32 * wc + 8 * fq) = pack8(acc[ai][bj][m][0], acc[ai][bj][m][1]); }
    }
};
struct MoeTab { LAS int* tile; LAS unsigned* rowoff; int ntiles; };
__device__ __forceinline__ int moe_build_tiles(gu32* ctl, LAS unsigned char* lds, LAS int* tile, int tid) {
    LAS int* sc = (LAS int*)lds;
    int nt = 0;
    if (tid < 256) { const int c = (int)__hip_atomic_load(ctl + CW_CNT + tid, RLX_AGENT); nt = (c + 255) >> 8; sc[tid] = nt; ((LAS int*)(lds + 2048))[tid] = c; }
    __syncthreads();
    int cur = 0;
    for (int o = 1; o < 256; o <<= 1) {
        int v = 0;
        if (tid < 256) { v = sc[cur * 256 + tid]; if (tid >= o) v += sc[cur * 256 + tid - o]; sc[(cur ^ 1) * 256 + tid] = v; }
        __syncthreads(); cur ^= 1;
    }
    const int total = sc[cur * 256 + 255];
    if (tid < 256) { const int end = sc[cur * 256 + tid], start = end - nt; for (int t = 0; t < nt; ++t) tile[start + t] = tid | (t << 16); }
    __syncthreads();
    return total;
}
struct MoeOrder1 {
    const char* H2; const char* W; LAS const int* tile; LAS const unsigned* rtab; int ntiles, G, c;
    static constexpr bool GATHER = true;
    __device__ __forceinline__ bool next(int i, Unit& u) const { const int idx = i * G + c; if (idx >= 2 * ntiles) return false; const int t = tile[idx >> 1]; u.pm = idx >> 1; u.pn = idx & 1; u.aux = t; u.ui = i; return true; }
    __device__ __forceinline__ const char* abase(const Unit&) const { return H2; }
    __device__ __forceinline__ const char* bbase(const Unit& u) const { return W + ((size_t)(u.aux & 0xffff) * 512 + (size_t)u.pn * 256) * 1024 * 2; }
    __device__ __forceinline__ unsigned rowoff(int ui, int r) const { return rtab[ui * 256 + r]; }
    __device__ __forceinline__ bool full(const Unit& u) const { return ((u.aux >> 30) & 1) == 0; }
};
struct EpiMoe1 {
    KA a0;
    __device__ __forceinline__ void operator()(const f32x4 (&acc)[2][2][4][2], const Unit& u, int wr, int wc, int fr, int fq) const {
        KA a = a0; asm volatile("" : "+s"(a));
        bf16* HE = (bf16*)(a->ws + WS_HE);
        const int row0 = u.pm * 256 + wr * 64 + fr; const bool half = (u.aux >> 30) & 1;
#pragma unroll
        for (int ai = 0; ai < 2; ++ai)
#pragma unroll
            for (int m = 0; m < 4; ++m) { const int row = row0 + ai * 128 + m * 16;
                f32x4 v0, v1;
#pragma unroll
                for (int j = 0; j < 4; ++j) { v0[j] = silu_f(acc[ai][0][m][0][j]) * acc[ai][1][m][0][j]; v1[j] = silu_f(acc[ai][0][m][1][j]) * acc[ai][1][m][1][j]; }
                *(v4u*)(HE + (size_t)row * 256 + u.pn * 128 + 32 * wc + 8 * fq) = pack8(v0, v1); }
    }
};
constexpr int MOE2_MAXU = 12;
struct MoeOrder2 {
    const char* HE; const char* W; LAS const unsigned* utab; int ntiles, G, c;
    static constexpr bool GATHER = false;
    __device__ __forceinline__ bool next(int i, Unit& u) const { const int idx = i * G + c; if (i >= MOE2_MAXU || idx >= 4 * ntiles) return false; u.pm = idx >> 2; u.pn = idx & 3; u.aux = (int)utab[i * 257 + 256]; u.ui = i; return true; }
    __device__ __forceinline__ const char* abase(const Unit& u) const { return HE + (size_t)u.pm * 256 * 256 * 2; }
    __device__ __forceinline__ const char* bbase(const Unit& u) const { return W + ((size_t)(u.aux & 0xffff) * 1024 + (size_t)u.pn * 256) * 256 * 2; }
    __device__ __forceinline__ unsigned rowoff(int, int) const { return 0u; }
    __device__ __forceinline__ bool full(const Unit& u) const { return ((u.aux >> 30) & 1) == 0; }
};
struct EpiMoe2 {
    KA a0; LAS const unsigned* utab;
    __device__ __forceinline__ void operator()(const f32x4 (&acc)[2][2][4][2], const Unit& u, int wr, int wc, int fr, int fq) const {
        KA a = a0; asm volatile("" : "+s"(a));
        unsigned char* YPAIR = a->ws + WS_YPAIR + u.pn * 256 + 32 * wc + 8 * (fq & ~1);
        const bool odd = (fq & 1) != 0;
#pragma unroll
        for (int ai = 0; ai < 2; ++ai)
#pragma unroll
            for (int k = 0; k < 2; ++k) {
                const unsigned entA = utab[u.ui * 257 + ai * 128 + wr * 64 + (2 * k) * 16 + fr], entB = utab[u.ui * 257 + ai * 128 + wr * 64 + (2 * k + 1) * 16 + fr];
                const float wA = 16.f * (float)__builtin_bit_cast(_Float16, (unsigned short)(entA & 0x7fffu)), wB = 16.f * (float)__builtin_bit_cast(_Float16, (unsigned short)(entB & 0x7fffu));
                const unsigned ent = odd ? entB : entA;
#pragma unroll
                for (int bj = 0; bj < 2; ++bj) {
                    const f32x4 a0v = acc[ai][bj][2 * k][0] * wA, a1v = acc[ai][bj][2 * k][1] * wA, b0v = acc[ai][bj][2 * k + 1][0] * wB, b1v = acc[ai][bj][2 * k + 1][1] * wB;
                    int A0 = __builtin_amdgcn_cvt_pk_fp8_f32(a0v[0], a0v[1], 0, false); A0 = __builtin_amdgcn_cvt_pk_fp8_f32(a0v[2], a0v[3], A0, true);
                    int A1 = __builtin_amdgcn_cvt_pk_fp8_f32(a1v[0], a1v[1], 0, false); A1 = __builtin_amdgcn_cvt_pk_fp8_f32(a1v[2], a1v[3], A1, true);
                    int B0 = __builtin_amdgcn_cvt_pk_fp8_f32(b0v[0], b0v[1], 0, false); B0 = __builtin_amdgcn_cvt_pk_fp8_f32(b0v[2], b0v[3], B0, true);
                    int B1 = __builtin_amdgcn_cvt_pk_fp8_f32(b1v[0], b1v[1], 0, false); B1 = __builtin_amdgcn_cvt_pk_fp8_f32(b1v[2], b1v[3], B1, true);
                    const auto r0 = __builtin_amdgcn_permlane16_swap((unsigned)A0, (unsigned)B0, false, false), r1 = __builtin_amdgcn_permlane16_swap((unsigned)A1, (unsigned)B1, false, false);
                    if (ent != 0xffffffffu) *(v4u*)(YPAIR + (size_t)(ent >> 15) * 1024 + 128 * bj) = (v4u){r0[0], r1[0], r0[1], r1[1]};
                }
            }
    }
};
typedef short v4i16_t __attribute__((ext_vector_type(4)));
__device__ __forceinline__ s16x4 trd(const LAS bf16* p) { return __builtin_bit_cast(s16x4, __builtin_amdgcn_ds_read_tr16_b64_v4i16((LAS v4i16_t*)p)); }
__device__ __forceinline__ bf16x8 frag_tr(const LAS bf16* T, int pitch, int l0, int c0, int lane) {
    const int g4 = lane >> 4, i = lane & 15, q = i >> 2, pp = i & 3;
    const LAS bf16* p = T + (l0 + 8 * g4 + q) * pitch + c0 + 4 * pp;
    const s16x4 lo = trd(p), hi = trd(p + 4 * pitch);
    return (bf16x8){lo[0], lo[1], lo[2], lo[3], hi[0], hi[1], hi[2], hi[3]};
}
__device__ __forceinline__ bf16x8 frag_nat(const LAS bf16* T, int pitch, int r0, int k0, int lane) {
    return *(const LAS bf16x8*)(T + (r0 + (lane & 15)) * pitch + k0 + 8 * (lane >> 4));
}
#define MFMA16(a, b, c) __builtin_amdgcn_mfma_f32_16x16x32_bf16((a), (b), (c), 0, 0, 0)

constexpr int S_BP = 136;
constexpr int S_XP4 = 264;
constexpr int S_XP = 72;

__device__ __forceinline__ void conv_part(KA a, int tok0, int c, int g, int cg_lo, int ncg, LAS unsigned char* lds, int tid) {
    const bf16* XBC = (const bf16*)(a->ws + WS_XBC); bf16* XS = (bf16*)(a->ws + WS_XS); bf16* BC = (bf16*)(a->ws + WS_BC);
    LAS bf16* sB = (LAS bf16*)lds; LAS bf16* sX = (LAS bf16*)(lds + 34816); const LAS float* sW = (const LAS float*)(lds + 106496);
    const int cg = cg_lo + tid % ncg, tg = tid / ncg, ntok = 128 / (512 / ncg);
    int gch; if (cg < 64) gch = g * 512 + cg * 8; else if (cg < 80) gch = 2048 + g * 128 + (cg - 64) * 8; else gch = 2560 + g * 128 + (cg - 80) * 8;
    float w[4][8], bias[8];
    asm volatile("" ::: "memory");
#pragma unroll
    for (int j = 0; j < 4; ++j) { const f32x4 w0 = *(const f32x4*)(INF(I_CONVW) + j * 3072 + gch), w1 = *(const f32x4*)(INF(I_CONVW) + j * 3072 + gch + 4);
#pragma unroll
        for (int i = 0; i < 4; ++i) { w[j][i] = w0[i]; w[j][4 + i] = w1[i]; } }
    { const f32x4 b0 = *(const f32x4*)(INF(I_CONVB) + gch), b1 = *(const f32x4*)(INF(I_CONVB) + gch + 4);
#pragma unroll
        for (int i = 0; i < 4; ++i) { bias[i] = b0[i]; bias[4 + i] = b1[i]; } }
    const int l_lo = tg * ntok;
    v4u r0, r1, r2;
    const bf16* src = XBC + (size_t)(tok0 + l_lo) * 3072 + gch;
    { const int sp = c * 128 + l_lo;
      const v4u z = {0u, 0u, 0u, 0u};
      r0 = sp >= 3 ? *(const v4u*)(src - 3 * 3072) : z;
      r1 = sp >= 2 ? *(const v4u*)(src - 2 * 3072) : z;
      r2 = sp >= 1 ? *(const v4u*)(src - 1 * 3072) : z; }
    v4u rn[4];
#pragma unroll
    for (int k = 0; k < 4; ++k) rn[k] = *(const v4u*)(src + (size_t)k * 3072);
    for (int tb = 0; tb < ntok; tb += 4) {
        v4u rr[4];
#pragma unroll
        for (int k = 0; k < 4; ++k) rr[k] = rn[k];
        if (tb + 4 < ntok) {
#pragma unroll
            for (int k = 0; k < 4; ++k) rn[k] = *(const v4u*)(src + (size_t)(tb + 4 + k) * 3072);
        }
#pragma unroll
        for (int k = 0; k < 4; ++k) {
            const int l = l_lo + tb + k; const v4u r3 = rr[k];
            float x0[8], x1[8], x2[8], x3[8], o[8];
            unpack8(r0, x0); unpack8(r1, x1); unpack8(r2, x2); unpack8(r3, x3);
#pragma unroll
            for (int i = 0; i < 8; ++i) { const float v = bias[i] + w[0][i] * x0[i] + w[1][i] * x1[i] + w[2][i] * x2[i] + w[3][i] * x3[i]; o[i] = silu_f(v); }
            v4u pk; pk.x = pk2(o[0], o[1]); pk.y = pk2(o[2], o[3]); pk.z = pk2(o[4], o[5]); pk.w = pk2(o[6], o[7]);
            if (cg < 64) {
                *(v4u*)(XS + (size_t)(tok0 + l) * 2048 + g * 512 + cg * 8) = pk;
                const float sc = sW[(cg >> 3) * 128 + l];
                v4u ps; ps.x = pk2(o[0] * sc, o[1] * sc); ps.y = pk2(o[2] * sc, o[3] * sc); ps.z = pk2(o[4] * sc, o[5] * sc); ps.w = pk2(o[6] * sc, o[7] * sc);
                *(LAS v4u*)(sX + l * S_XP4 + (cg & 31) * 8) = ps;
            } else if (cg < 80) {
                *(v4u*)(BC + (size_t)(tok0 + l) * 1024 + g * 128 + (cg - 64) * 8) = pk;
                *(LAS v4u*)(sB + l * S_BP + (cg - 64) * 8) = pk;
            } else {
                *(v4u*)(BC + (size_t)(tok0 + l) * 1024 + 512 + g * 128 + (cg - 80) * 8) = pk;
            }
            r0 = r1; r1 = r2; r2 = r3;
        }
    }
}
__device__ __forceinline__ void ssd_s1_unit(KA a, int unit, LAS unsigned char* lds, int tid, int wave, int lane) {
    const int g = unit & 3, c = (unit >> 2) & 63, b = unit >> 8; const int tok0 = b * SEQ + c * 128;
    const float* DT = (const float*)(a->ws + WS_DT); float* ACUM = (float*)(a->ws + WS_ACUM); bf16* CHST = (bf16*)(a->ws + WS_CHST);
    LAS bf16* sB = (LAS bf16*)lds; LAS bf16* sX = (LAS bf16*)(lds + 34816); LAS float* sAc = (LAS float*)(lds + 102400); LAS float* sW = (LAS float*)(lds + 106496);
    { const int hh = g * 8 + wave; const float a_neg = -expf(INF(I_ALOG)[hh]);
      const float d0 = DT[(size_t)(tok0 + lane) * 32 + hh], d1 = DT[(size_t)(tok0 + 64 + lane) * 32 + hh];
      float v0 = d0 * a_neg, v1 = d1 * a_neg;
#pragma unroll
      for (int o = 1; o < 64; o <<= 1) { const float t0 = __shfl_up(v0, o), t1 = __shfl_up(v1, o); if (lane >= o) { v0 += t0; v1 += t1; } }
      v1 += __shfl(v0, 63);
      const float alast = __shfl(v1, 63);
      ACUM[(size_t)(tok0 + lane) * 32 + hh] = v0; ACUM[(size_t)(tok0 + 64 + lane) * 32 + hh] = v1;
      sAc[wave * 128 + lane] = v0; sAc[wave * 128 + 64 + lane] = v1;
      sW[wave * 128 + lane] = d0 * __expf(alast - v0); sW[wave * 128 + 64 + lane] = d1 * __expf(alast - v1); }
    __syncthreads();
    for (int pass = 0; pass < 2; ++pass) {
        if (pass == 0) conv_part(a, tok0, c, g, 0, 32, lds, tid);
        else           conv_part(a, tok0, c, g, 32, 32, lds, tid);
        if (pass == 0) conv_part(a, tok0, c, g, 64, 32, lds, tid);
        __syncthreads();
        const int hl = wave >> 1, pt0 = 2 * (wave & 1);
        f32x4 acc[2][8];
#pragma unroll
        for (int i = 0; i < 2; ++i)
#pragma unroll
            for (int j = 0; j < 8; ++j) acc[i][j] = (f32x4){0.f, 0.f, 0.f, 0.f};
#pragma unroll
        for (int ks = 0; ks < 4; ++ks) {
            bf16x8 bx[2];
#pragma unroll
            for (int i = 0; i < 2; ++i) bx[i] = frag_tr(sX, S_XP4, 32 * ks, hl * 64 + 16 * (pt0 + i), lane);
#pragma unroll
            for (int nt = 0; nt < 8; ++nt) { const bf16x8 an = frag_tr(sB, S_BP, 32 * ks, 16 * nt, lane);
#pragma unroll
                for (int i = 0; i < 2; ++i) acc[i][nt] = MFMA16(an, bx[i], acc[i][nt]); }
        }
        { const int hh = g * 8 + pass * 4 + hl; bf16* dst = CHST + ((size_t)((b * 64 + c) * 32 + hh) * 64) * 128;
          const int g4 = lane >> 4; bf16* drow = dst + (size_t)(16 * (pt0 + (g4 & 1)) + (lane & 15)) * 128 + 4 * (g4 & ~1);
#pragma unroll
          for (int nt = 0; nt < 8; ++nt) {
              const unsigned ax = pk2(acc[0][nt][0], acc[0][nt][1]), ay = pk2(acc[0][nt][2], acc[0][nt][3]), bx_ = pk2(acc[1][nt][0], acc[1][nt][1]), by = pk2(acc[1][nt][2], acc[1][nt][3]);
              const auto r0 = __builtin_amdgcn_permlane16_swap(ax, bx_, false, false), r1 = __builtin_amdgcn_permlane16_swap(ay, by, false, false);
              *(v4u*)(drow + 16 * nt) = (v4u){r0[0], r1[0], r0[1], r1[1]}; } }
        __syncthreads();
    }
}
__device__ __forceinline__ void ssd_s2_item(KA a, int item, int tid) {
    const int pq = item & 3, hh = (item >> 2) & 31, b = item >> 7;
    const bf16* CHST = (const bf16*)(a->ws + WS_CHST); bf16* STIN = (bf16*)(a->ws + WS_STIN); const float* ACUM = (const float*)(a->ws + WS_ACUM);
    const size_t off = (size_t)(pq * 16) * 128 + (size_t)tid * 4;
    float s[4] = {0.f, 0.f, 0.f, 0.f};
    v2u wn[8]; float decn[8];
#define S2_LOAD(c0_) do { _Pragma("unroll") for (int j = 0; j < 8; ++j) { const size_t base = ((size_t)((b * 64 + (c0_) + j) * 32 + hh) * 64) * 128 + off; \
        wn[j] = *(const v2u*)(CHST + base); decn[j] = ACUM[(size_t)(b * SEQ + ((c0_) + j) * 128 + 127) * 32 + hh]; } } while (0)
    S2_LOAD(0);
    for (int c0 = 0; c0 < 64; c0 += 8) {
        v2u w[8]; float dec[8];
#pragma unroll
        for (int j = 0; j < 8; ++j) { w[j] = wn[j]; dec[j] = decn[j]; }
        if (c0 + 8 < 64) S2_LOAD(c0 + 8);
#pragma unroll
        for (int j = 0; j < 8; ++j) { const size_t base = ((size_t)((b * 64 + c0 + j) * 32 + hh) * 64) * 128 + off;
            v2u o; o.x = pk2(s[0], s[1]); o.y = pk2(s[2], s[3]); *(v2u*)(STIN + base) = o;
            const float d = __expf(dec[j]);
            s[0] = s[0] * d + bflo(w[j].x); s[1] = s[1] * d + bfhi(w[j].x); s[2] = s[2] * d + bflo(w[j].y); s[3] = s[3] * d + bfhi(w[j].y); }
    }
#undef S2_LOAD
}
template <int NHEADS> __device__ __forceinline__ void ssd_s3_unit_t(KA a, int unit, LAS unsigned char* lds, int tid, int wave, int lane) {
    const int g = unit & 3, c = (unit >> 2) & 63, b = unit >> 8; const int tok0 = b * SEQ + c * 128;
    const bf16* XS = (const bf16*)(a->ws + WS_XS); const bf16* BC = (const bf16*)(a->ws + WS_BC); const bf16* ZS = (const bf16*)(a->ws + WS_ZS);
    const bf16* STIN = (const bf16*)(a->ws + WS_STIN); const float* DT = (const float*)(a->ws + WS_DT); const float* ACUM = (const float*)(a->ws + WS_ACUM);
    bf16* YC = (bf16*)(a->ws + WS_YCAT);
    LAS bf16* sBn = (LAS bf16*)lds; LAS bf16* sG = (LAS bf16*)lds; LAS bf16* sC = (LAS bf16*)(lds + 34816); LAS bf16* sX = (LAS bf16*)(lds + 69632); LAS bf16* sS = (LAS bf16*)(lds + 88064);
    LAS float* sAc = (LAS float*)(lds + 105472); LAS float* sDt = (LAS float*)(lds + 109568); LAS float* sSS = (LAS float*)(lds + 113664);
    const int g4 = lane >> 4, li_ = lane & 15;
    const int pt = wave & 3, par = wave >> 2;
    v4u px[2], ps[2];
#define S3_LOADHEAD(hg_) do { _Pragma("unroll") for (int k = 0; k < 2; ++k) { const int piece = tid + 512 * k; \
        px[k] = *(const v4u*)(XS + (size_t)(tok0 + (piece >> 3)) * 2048 + (hg_) * 64 + (piece & 7) * 8); \
        ps[k] = *(const v4u*)(STIN + ((size_t)((b * 64 + c) * 32 + (hg_)) * 64 + (piece >> 4)) * 128 + (piece & 15) * 8); } } while (0)
    S3_LOADHEAD(g * 8);
#pragma unroll
    for (int k = 0; k < 4; ++k) { const int piece = tid + 512 * k, row = piece >> 4, ch = piece & 15;
        *(LAS v4u*)(sBn + row * S_BP + ch * 8) = *(const v4u*)(BC + (size_t)(tok0 + row) * 1024 + g * 128 + ch * 8);
        *(LAS v4u*)(sC + row * S_BP + ch * 8) = *(const v4u*)(BC + (size_t)(tok0 + row) * 1024 + 512 + g * 128 + ch * 8); }
#pragma unroll
    for (int k = 0; k < 2; ++k) { const int idx = tid + 512 * k, hh = idx >> 7, l = idx & 127;
        sAc[idx] = ACUM[(size_t)(tok0 + l) * 32 + g * 8 + hh]; sDt[idx] = DT[(size_t)(tok0 + l) * 32 + g * 8 + hh]; }
    __syncthreads();
    f32x4 GT[5]; int pli[5], psi[5];
#pragma unroll
    for (int j = 0; j < 5; ++j) { const int q = wave + 8 * j; int L = 0; while ((L + 1) * (L + 2) / 2 <= q) ++L; pli[j] = L; psi[j] = q - L * (L + 1) / 2;
        GT[j] = (f32x4){0.f, 0.f, 0.f, 0.f};
        if (q < 36) {
#pragma unroll
            for (int ks = 0; ks < 4; ++ks) GT[j] = MFMA16(frag_nat(sBn, S_BP, 16 * psi[j], 32 * ks, lane), frag_nat(sC, S_BP, 16 * pli[j], 32 * ks, lane), GT[j]); } }
    float ss[4] = {0.f, 0.f, 0.f, 0.f};
    for (int hh = 0; hh < NHEADS; ++hh) {
        const int hg = g * 8 + hh;
        __syncthreads();
        if (hh == 0) { const int blk = tid >> 7, r = (tid >> 3) & 15, cc = tid & 7;
            *(LAS unsigned*)(sG + (32 * blk + r) * S_BP + 32 * blk + 16 + 2 * cc) = 0u; }
#pragma unroll
        for (int k = 0; k < 2; ++k) { const int piece = tid + 512 * k;
            *(LAS v4u*)(sX + (piece >> 3) * S_XP + (piece & 7) * 8) = px[k];
            *(LAS v4u*)(sS + (piece >> 4) * S_BP + (piece & 15) * 8) = ps[k]; }
        if (hh < NHEADS - 1) S3_LOADHEAD(hg + 1);
        v2u zw[4];
#pragma unroll
        for (int j = 0; j < 4; ++j) zw[j] = *(const v2u*)(ZS + (size_t)(tok0 + 16 * (par + 2 * j) + li_) * 2048 + hg * 64 + 16 * pt + 4 * g4);
#pragma unroll
        for (int j = 0; j < 5; ++j) {
            if (wave + 8 * j < 36) {
                const int l = 16 * pli[j] + li_, s0 = 16 * psi[j] + 4 * g4;
                const float al = sAc[hh * 128 + l];
                const f32x4 as = *(const LAS f32x4*)(sAc + hh * 128 + s0), ds = *(const LAS f32x4*)(sDt + hh * 128 + s0);
                float v[4];
#pragma unroll
                for (int r = 0; r < 4; ++r) v[r] = (s0 + r <= l) ? GT[j][r] * __expf(al - as[r]) * ds[r] : 0.f;
                v2u w; w.x = pk2(v[0], v[1]); w.y = pk2(v[2], v[3]);
                *(LAS v2u*)(sG + l * S_BP + s0) = w;
            }
        }
        __syncthreads();
        bf16x8 xa[4], sa[4];
#pragma unroll
        for (int ks = 0; ks < 4; ++ks) { xa[ks] = frag_tr(sX, S_XP, 32 * ks, 16 * pt, lane); sa[ks] = frag_nat(sS, S_BP, 16 * pt, 32 * ks, lane); }
        const float dsk = INF(I_DSKIP)[hg];
        v2u yw[4];
#pragma unroll
        for (int j = 0; j < 4; ++j) {
            const int lt = par + 2 * j, l = 16 * lt + li_;
            f32x4 yd = {0.f, 0.f, 0.f, 0.f}, yo = {0.f, 0.f, 0.f, 0.f};
#pragma unroll
            for (int ks = 0; ks < 4; ++ks) { if (ks <= (lt >> 1)) yd = MFMA16(xa[ks], frag_nat(sG, S_BP, 16 * lt, 32 * ks, lane), yd); }
#pragma unroll
            for (int ks = 0; ks < 4; ++ks) yo = MFMA16(sa[ks], frag_nat(sC, S_BP, 16 * lt, 32 * ks, lane), yo);
            const float el = __expf(sAc[hh * 128 + l]);
            const int p0 = 16 * pt + 4 * g4;
            const v2u xw = *(const LAS v2u*)(sX + l * S_XP + p0);
            const float xs[4] = {bflo(xw.x), bfhi(xw.x), bflo(xw.y), bfhi(xw.y)}, zs[4] = {bflo(zw[j].x), bfhi(zw[j].x), bflo(zw[j].y), bfhi(zw[j].y)};
            float y[4];
#pragma unroll
            for (int r = 0; r < 4; ++r) { y[r] = (yd[r] + el * yo[r] + dsk * xs[r]) * zs[r]; ss[j] += y[r] * y[r]; }
            yw[j].x = pk2(y[0], y[1]); yw[j].y = pk2(y[2], y[3]);
        }
#pragma unroll
        for (int q = 0; q < 2; ++q) {
            const auto r0 = __builtin_amdgcn_permlane16_swap(yw[2 * q].x, yw[2 * q + 1].x, false, false), r1 = __builtin_amdgcn_permlane16_swap(yw[2 * q].y, yw[2 * q + 1].y, false, false);
            const int l = 16 * (par + 2 * (2 * q + (g4 & 1))) + li_;
            *(v4u*)(YC + (size_t)(tok0 + l) * 3072 + 1024 + hg * 64 + 16 * pt + 4 * (g4 & ~1)) = (v4u){r0[0], r1[0], r0[1], r1[1]};
        }
    }
#undef S3_LOADHEAD
#pragma unroll
    for (int j = 0; j < 4; ++j) { float s = ss[j]; s += __shfl_xor(s, 16); s += __shfl_xor(s, 32); if (g4 == 0) sSS[(16 * (par + 2 * j) + li_) * 4 + pt] = s; }
    __syncthreads();
    if (tid < 128) { const f32x4 p4 = *(const LAS f32x4*)(sSS + tid * 4);
        ((float*)(a->ws + WS_RSTD))[(size_t)(tok0 + tid) * 4 + g] = 1.f / sqrtf(((p4[0] + p4[1]) + (p4[2] + p4[3])) * (1.f / 512.f) + EPS); }
    __syncthreads();
}
__device__ __forceinline__ void ssd_s3_unit(KA a, int unit, LAS unsigned char* lds, int tid, int wave, int lane) { ssd_s3_unit_t<8>(a, unit, lds, tid, wave, lane); }
__device__ __forceinline__ void attn_combine(KA a, float lam, int gw, int NGW, int lane) {
    const bf16* O = (const bf16*)(a->ws + WS_O); bf16* YC = (bf16*)(a->ws + WS_YA);
    const int h8 = lane >> 3, jj = lane & 7;
    float gn[16];
#pragma unroll
    for (int k = 0; k < 4; ++k) { const f32x4 t = *(const f32x4*)(INF(I_HNORM) + 16 * jj + 4 * k); gn[4 * k] = t[0]; gn[4 * k + 1] = t[1]; gn[4 * k + 2] = t[2]; gn[4 * k + 3] = t[3]; }
    for (int m0 = gw; m0 < M; m0 += 4 * NGW) {
        v4u ra[4][4];
#pragma unroll
        for (int u = 0; u < 4; ++u) { const int m = m0 + u * NGW; const bf16* o0 = O + (size_t)(m < M ? m : m0) * 2048 + (2 * h8) * 128 + 16 * jj;
            ra[u][0] = *(const v4u*)o0; ra[u][1] = *(const v4u*)(o0 + 8); ra[u][2] = *(const v4u*)(o0 + 128); ra[u][3] = *(const v4u*)(o0 + 136); }
#pragma unroll
        for (int u = 0; u < 4; ++u) { const int m = m0 + u * NGW; if (m >= M) continue;
            float a0[16], a1[16], d[16];
            unpack8(ra[u][0], a0); unpack8(ra[u][1], a0 + 8); unpack8(ra[u][2], a1); unpack8(ra[u][3], a1 + 8);
            float s = 0.f;
#pragma unroll
            for (int k = 0; k < 16; ++k) { d[k] = a0[k] - lam * a1[k]; s += d[k] * d[k]; }
            s += __shfl_xor(s, 1); s += __shfl_xor(s, 2); s += __shfl_xor(s, 4);
            const float rstd = (1.f - LAMBDA_INIT) / sqrtf(s * (1.f / 128.f) + EPS);
            v4u w0, w1;
            w0.x = pk2(d[0] * rstd * gn[0], d[1] * rstd * gn[1]); w0.y = pk2(d[2] * rstd * gn[2], d[3] * rstd * gn[3]); w0.z = pk2(d[4] * rstd * gn[4], d[5] * rstd * gn[5]); w0.w = pk2(d[6] * rstd * gn[6], d[7] * rstd * gn[7]);
            w1.x = pk2(d[8] * rstd * gn[8], d[9] * rstd * gn[9]); w1.y = pk2(d[10] * rstd * gn[10], d[11] * rstd * gn[11]); w1.z = pk2(d[12] * rstd * gn[12], d[13] * rstd * gn[13]); w1.w = pk2(d[14] * rstd * gn[14], d[15] * rstd * gn[15]);
            bf16* y = YC + (size_t)m * 1024 + h8 * 128 + 16 * jj;
            *(v4u*)y = w0; *(v4u*)(y + 8) = w1; }
    }
}
template <bool DRY> __device__ __forceinline__ void route_tokens_t(KA a, gu32* ctl, int gw, int NGW, int lane) {
    const float* LOG = (const float*)(a->ws + WS_LOGITS); int* LIST = (int*)(a->ws + WS_LIST); float* PAIRW = (float*)(a->ws + WS_PAIRW);
    const int sl = lane & 15, tk = lane >> 4, lbase = lane & 48;
    float bias[16];
#pragma unroll
    for (int q = 0; q < 4; ++q) { const f32x4 t = *(const f32x4*)(INF(I_RB) + 16 * sl + 4 * q); bias[4 * q] = t[0]; bias[4 * q + 1] = t[1]; bias[4 * q + 2] = t[2]; bias[4 * q + 3] = t[3]; }
    const float NEG = -INFINITY;
    f32x4 lgn[4]; bool have = false; unsigned ppos = 0u; int pe = 0, pm = 0; float pw = 0.f;
    if (gw < M / 4) {
#pragma unroll
        for (int q = 0; q < 4; ++q) lgn[q] = *(const f32x4*)(LOG + (size_t)(4 * gw + tk) * 256 + 16 * sl + 4 * q); }
    for (int task = gw; task < M / 4; task += NGW) {
        const int m = 4 * task + tk;
        float sc[16], cm[16];
        f32x4 lgc[4];
#pragma unroll
        for (int q = 0; q < 4; ++q) lgc[q] = lgn[q];
        if (task + NGW < M / 4) {
#pragma unroll
            for (int q = 0; q < 4; ++q) lgn[q] = *(const f32x4*)(LOG + (size_t)(4 * (task + NGW) + tk) * 256 + 16 * sl + 4 * q); }
#pragma unroll
        for (int q = 0; q < 4; ++q) { const f32x4 lg = lgc[q];
#pragma unroll
            for (int r = 0; r < 4; ++r) { sc[4 * q + r] = sigmoid_f(lg[r]); cm[4 * q + r] = sc[4 * q + r] + bias[4 * q + r]; } }
        float t1 = NEG, t2 = NEG;
#pragma unroll
        for (int j = 0; j < 16; ++j) { const float v = cm[j]; const float n2 = fmaxf(fminf(t1, v), t2); t1 = fmaxf(t1, v); t2 = n2; }
        { const float o1 = __shfl_xor(t1, 1), o2 = __shfl_xor(t2, 1); const float n1 = fmaxf(t1, o1), n2 = fmaxf(fminf(t1, o1), fmaxf(t2, o2)); t1 = n1; t2 = n2; }
        const float gs = t1 + t2; const int mygrp = sl >> 1;
        int rank = 0;
#pragma unroll
        for (int gg = 0; gg < 8; ++gg) { const float o = __shfl(gs, lbase + 2 * gg); rank += ((o > gs) || (o == gs && gg < mygrp)) ? 1 : 0; }
        if (rank >= 4) {
#pragma unroll
            for (int j = 0; j < 16; ++j) cm[j] = NEG; }
        float my_s = 0.f, sum = 0.f; int my_e = 0;
#pragma unroll
        for (int k = 0; k < 8; ++k) {
            float bv = cm[0], bs = sc[0]; int bi = 16 * sl;
#pragma unroll
            for (int j = 1; j < 16; ++j) { const bool g = cm[j] > bv; bv = g ? cm[j] : bv; bs = g ? sc[j] : bs; bi = g ? 16 * sl + j : bi; }
#pragma unroll
            for (int o = 1; o < 16; o <<= 1) { const float ov = __shfl_xor(bv, o), os = __shfl_xor(bs, o); const int oi = __shfl_xor(bi, o);
                const bool g = (ov > bv) || (ov == bv && oi < bi); bv = g ? ov : bv; bs = g ? os : bs; bi = g ? oi : bi; }
#pragma unroll
            for (int j = 0; j < 16; ++j) cm[j] = (bi == 16 * sl + j) ? NEG : cm[j];
            sum += bs;
            if (sl == k) { my_e = bi; my_s = bs; }
        }
        if (sl < 8) {
            const float w = my_s / (sum + 1e-20f) * 2.5f;
            if (DRY) { asm volatile("" :: "v"(w), "v"(my_e)); }
            else {
                if (have) { LIST[(size_t)pe * M + ppos] = pm * 8 + sl; PAIRW[pm * 8 + sl] = pw; }
                ppos = __hip_atomic_fetch_add(ctl + CW_CNT + my_e, 1u, RLX_AGENT); pe = my_e; pm = m; pw = w; }
        }
        have = true;
    }
    if (!DRY && have && sl < 8) { LIST[(size_t)pe * M + ppos] = pm * 8 + sl; PAIRW[pm * 8 + sl] = pw; }
}
__device__ __forceinline__ void route_tokens(KA a, gu32* ctl, int gw, int NGW, int lane) { route_tokens_t<false>(a, ctl, gw, NGW, lane); }
template <bool DRY> __device__ __forceinline__ void final_rows_t(KA a, int gw, int NGW, int lane) {
    float* outp = DRY ? (float*)(a->ws + WS_Q) : a->out;
    const bf16* SH = (const bf16*)(a->ws + WS_SHARED); const unsigned char* YP = a->ws + WS_YPAIR; const float* mod = (const float*)(a->ws + WS_MOD); const bf16* X1H = (const bf16*)(a->ws + WS_X1H);
    typedef float f2_ __attribute__((ext_vector_type(2)));
    for (int b = 0; b < BATCH; ++b) {
        f32x4 gm[4], nf[4];
#pragma unroll
        for (int q = 0; q < 4; ++q) { const int col = 8 * lane + 512 * (q >> 1) + 4 * (q & 1); gm[q] = *(const f32x4*)(mod + b * 6144 + 5120 + col); nf[q] = *(const f32x4*)(INF(I_NFIN) + col); }
        int m = gw; while (m < b * SEQ) m += NGW;
        for (; m < (b + 1) * SEQ; m += NGW) {
            float v[2][8]; float s = 0.f;
#pragma unroll
            for (int j = 0; j < 2; ++j) { const int col = 8 * lane + 512 * j;
                float xv[8]; unpack8(*(const v4u*)(X1H + (size_t)m * D + col), xv);
                float acc[8]; unpack8(*(const v4u*)(SH + (size_t)m * D + col), acc);
                float ry[8] = {0.f, 0.f, 0.f, 0.f, 0.f, 0.f, 0.f, 0.f};
#pragma unroll
                for (int k = 0; k < 8; ++k) { const v2u yw = *(const v2u*)(YP + ((size_t)m * 8 + k) * D + col);
                    const f2_ p0 = __builtin_amdgcn_cvt_pk_f32_fp8((int)yw.x, false), p1 = __builtin_amdgcn_cvt_pk_f32_fp8((int)yw.x, true);
                    const f2_ p2 = __builtin_amdgcn_cvt_pk_f32_fp8((int)yw.y, false), p3 = __builtin_amdgcn_cvt_pk_f32_fp8((int)yw.y, true);
                    ry[0] += p0.x; ry[1] += p0.y; ry[2] += p1.x; ry[3] += p1.y; ry[4] += p2.x; ry[5] += p2.y; ry[6] += p3.x; ry[7] += p3.y; }
#pragma unroll
                for (int e = 0; e < 4; ++e) { v[j][e] = xv[e] + gm[2 * j][e] * (acc[e] + ry[e] * 0.0625f); v[j][4 + e] = xv[4 + e] + gm[2 * j + 1][e] * (acc[4 + e] + ry[4 + e] * 0.0625f); }
#pragma unroll
                for (int e = 0; e < 8; ++e) s += v[j][e] * v[j][e]; }
            const float rstd = 1.f / sqrtf(wave_sum(s) * (1.f / D) + EPS);
#pragma unroll
            for (int j = 0; j < 2; ++j) { const int col = 8 * lane + 512 * j;
                *(f32x4*)(outp + (size_t)m * D + col) = (f32x4){v[j][0], v[j][1], v[j][2], v[j][3]} * rstd * nf[2 * j];
                *(f32x4*)(outp + (size_t)m * D + col + 4) = (f32x4){v[j][4], v[j][5], v[j][6], v[j][7]} * rstd * nf[2 * j + 1]; }
        }
    }
}
__device__ __forceinline__ void final_rows(KA a, int gw, int NGW, int lane) { final_rows_t<false>(a, gw, NGW, lane); }

constexpr int NPHASE = 14;
__global__ void __launch_bounds__(NWAVES * 64, 2) mega(Args a_byval) {
    extern __shared__ __attribute__((aligned(16))) unsigned char lds_raw[];
    LAS unsigned char* lds = (LAS unsigned char*)lds_raw;
    const int wave = __builtin_amdgcn_readfirstlane((int)threadIdx.x >> 6);
    const int bx = blockIdx.x;
    { const int tid = tid_fresh(wave); for (int u = tid; u < (LDS_BYTES - LDSCTL_OFF) / 4; u += NWAVES * 64) ((LAS unsigned*)(lds + LDSCTL_OFF))[u] = 0u; }
    __syncthreads();
    const int lo = a_byval.ph_lo, hi = a_byval.ph_hi;
    if (hi - lo > 1) { KA a = ka_fresh(); (void)xcd_barrier_post((unsigned*)(a->ws + WS_CTL) + CW_BAR, (volatile LAS unsigned*)(lds + MISC_OFF) + 8, wave == 0 && lane_id() == 0); }
#ifndef PHMASK
#define PHMASK 0x7fff
#endif
#define IN(k) (((PHMASK >> (k)) & 1) && lo <= (k) && (k) < hi)
#define SEAM(k) do { if (IN(k) && IN((k) + 1)) { KA a_ = ka_fresh(); XcdBarrier b_; b_.bar = (unsigned*)(a_->ws + WS_CTL) + CW_BAR; b_.x = xb_xcc_id(); b_.st = (volatile LAS unsigned*)(lds + MISC_OFF) + 8; xcd_barrier(b_, wave == 0 && lane_id() == 0); } } while (0)
#define PHASE_BEGIN KA a = ka_fresh(); const int tid = tid_fresh(wave), lane = tid & 63; (void)lane; unsigned char* ws = a->ws; const float* mod = (const float*)(ws + WS_MOD); (void)mod; gu32* ctl = (gu32*)(ws + WS_CTL); (void)ctl; \
    const int G = a->G; const int vcu = (G % 8 == 0) ? (bx % 8) * (G / 8) + bx / 8 : bx; (void)vcu; const int gw = bx * NWAVES + wave, NGW = G * NWAVES; (void)gw; (void)NGW;

    if (IN(0)) { PHASE_BEGIN ph0_mod(a, lds, tid); ph0_misc(a, ctl, bx * NWAVES * 64 + tid, G * NWAVES * 64); ph0_weights(a, lds, gw, NGW, wave, lane, 0, (G == 256) ? TR_SPLIT : TR_NITEMS); }
    SEAM(0);
    if (IN(1)) { PHASE_BEGIN norm_rows<false>(INF(I_X), INF(I_NMIX), mod, 0, 1024, (bf16*)(ws + WS_H), gw, NGW, lane); }
    SEAM(1);
    if (IN(2)) { PHASE_BEGIN
        if (G == 256 && bx >= 256 - HELPER_CUS) {
            convert_queue(a, lds, ctl + CW_QCONV, wave, lane, TR_SPLIT, TR_NITEMS);
        } else {
            pg8::GridOrder S; S.init(ws + WS_H, ws + WS_WIN, 1024, 1024, M, NIN, (G == 256) ? 256 - HELPER_CUS : G, bx);
            EpiInProj E{a};
            pg8::gemm_phase<EpiInProj, pg8::GridOrder, true>(lds, pg8::GemmDesc{1024, 1024, 1024}, S, E, wave);
            if (G == 256) convert_queue(a, lds, ctl + CW_QCONV, wave, lane, TR_SPLIT, TR_NITEMS);
        }
    }
    SEAM(2);
    if (IN(3)) { PHASE_BEGIN for (int u = bx; u < 512; u += G) ssd_s1_unit(a, u, lds, tid, wave, lane); }
    SEAM(3);
    if (IN(4)) { PHASE_BEGIN
        for (int it = bx; it < 256; it += G) ssd_s2_item(a, it, tid);
        const attn_body::bf16* Qp = (const attn_body::bf16*)(ws + WS_Q); const attn_body::bf16* Kp = (const attn_body::bf16*)(ws + WS_K); const attn_body::bf16* Vp = (const attn_body::bf16*)(ws + WS_V);
        attn_body::bf16* Op = (attn_body::bf16*)(ws + WS_O);
        { const float lam = __builtin_bit_cast(float, __builtin_amdgcn_readfirstlane((int)__hip_atomic_load(ctl + CW_LAM, RLX_AGENT)));
          const attn_body::AttnTensors AT{Qp, Kp, Vp, Op, lam, INF(I_HNORM), (attn_body::bf16*)(ws + WS_YA)}; const attn_body::StaticOrder S((int)G, (int)bx);
          attn_body::attn_phase<attn_body::StaticOrder>((char*)lds_raw, AT, S, wave); }
    }
    SEAM(4);
    if (IN(5)) { PHASE_BEGIN
        for (int u = bx; u < 512; u += G) ssd_s3_unit(a, u, lds, tid, wave, lane);
        const float lam = __builtin_bit_cast(float, __hip_atomic_load(ctl + CW_LAM, RLX_AGENT));
    }
    SEAM(5);
    if (IN(6)) { PHASE_BEGIN
        LAS float* rs = (LAS float*)(lds + TAB_OFF);
        pg8::AccBox xacc;
        { pg8::GridOrder S; S.init(ws + WS_YA, ws + WS_WA, 1024, 1024, M, 1024, G, bx);
          { pg8::Unit u0; if (S.next(0, u0)) { const float* RSTD = (const float*)(ws + WS_RSTD);
                for (int k = tid; k < 1024; k += NWAVES * 64) rs[k] = RSTD[(size_t)u0.pm * 1024 + k]; } }
          __syncthreads();
          EpiMixA E{a, rs};
          pg8::gemm_phase<EpiMixA, pg8::GridOrder, true, pg8::NoHook, 1>(lds, pg8::GemmDesc{1024, 1024, 1024}, S, E, wave, pg8::NoHook(), &xacc); }
        { pg8::GridOrder S; S.init(ws + WS_YCAT + 1024 * 2, ws + WS_WS, 3072, 2048, M, 1024, G, bx);
          EpiMixB E{a, rs}; HookGrp H{rs};
          pg8::gemm_phase<EpiMixB, pg8::GridOrder, true, HookGrp, 2>(lds, pg8::GemmDesc{3072, 2048, 2048}, S, E, wave, H, &xacc); }
    }
    SEAM(6);
    if (IN(7)) { PHASE_BEGIN
        pg8::GridOrder S; S.init(ws + WS_MIXED, ws + WS_WO, 1024, 1024, M, 1024, G, bx);
        EpiOut E{a};
        pg8::gemm_phase<EpiOut, pg8::GridOrder, true>(lds, pg8::GemmDesc{1024, 1024, 1024}, S, E, wave);
    }
    SEAM(7);
    if (IN(8)) { PHASE_BEGIN norm_rows<true>(ws + WS_X1H, INF(I_NFFN), mod, 3072, 4096, (bf16*)(ws + WS_H), gw, NGW, lane); }
    SEAM(8);
    if (IN(9)) { PHASE_BEGIN
        pg8::GridOrder S; S.init(ws + WS_H, ws + WS_WRS, 1024, 1024, M, 1024, G, bx);
        EpiRS E{a};
        pg8::gemm_phase<EpiRS, pg8::GridOrder, true>(lds, pg8::GemmDesc{1024, 1024, 1024}, S, E, wave);
    }
    SEAM(9);
    if (IN(10)) { PHASE_BEGIN
        route_tokens(a, ctl, gw, NGW, lane);
        pg8::GridOrder S; S.init(ws + WS_HS, ws + WS_WSHD, 256, 256, M, 1024, G, bx);
        EpiStore E{a, WS_SHARED, 1024};
        pg8::gemm_phase<EpiStore, pg8::GridOrder, true>(lds, pg8::GemmDesc{256, 256, 256}, S, E, wave);
    }
    SEAM(10);
    if (IN(11)) { PHASE_BEGIN
        LAS int* tile = (LAS int*)(lds + TAB_OFF); LAS unsigned* rowoff = (LAS unsigned*)(lds + TAB_OFF + 4096);
        const int ntiles = moe_build_tiles(ctl, lds, tile, tid);
        const int* LIST = (const int*)(ws + WS_LIST);
        { LAS const int* scnt = (LAS const int*)(lds + 2048); int lv[3]; bool ok[3];
#pragma unroll
          for (int i = 0; i < 3; ++i) { const int k = tid + 512 * i, ui = k >> 8, r = k & 255, idx = ui * G + vcu; ok[i] = idx < 2 * ntiles;
              const int t = tile[ok[i] ? (idx >> 1) : 0], e = t & 0xffff, slot = ((t >> 16) & 0xff) * 256 + r; ok[i] = ok[i] && slot < scnt[e];
              lv[i] = ok[i] ? LIST[(size_t)e * M + slot] : 0; }
#pragma unroll
          for (int i = 0; i < 3; ++i) rowoff[tid + 512 * i] = ok[i] ? (unsigned)(lv[i] >> 3) * 2048u : 0u; }
        __syncthreads();
        MoeOrder1 S{(const char*)(ws + WS_H), (const char*)(ws + WS_WEGU), tile, rowoff, ntiles, G, vcu};
        EpiMoe1 E{a};
        pg8::gemm_phase<EpiMoe1, MoeOrder1, true>(lds, pg8::GemmDesc{1024, 1024, 1024}, S, E, wave);
    }
    SEAM(11);
    if (IN(12)) { PHASE_BEGIN
        LAS int* tile = (LAS int*)(lds + 4096);
        LAS unsigned* utab = (LAS unsigned*)(lds + TAB_OFF);
        const int ntiles = moe_build_tiles(ctl, lds, tile, tid);
        { const int* LIST = (const int*)(ws + WS_LIST); const float* PAIRW = (const float*)(ws + WS_PAIRW);
          LAS const int* scnt = (LAS const int*)(lds + 2048);
          constexpr int NIT = (MOE2_MAXU * 257 + NWAVES * 64 - 1) / (NWAVES * 64);
          int pr[NIT]; float pwt[NIT]; unsigned ent0[NIT]; bool ok[NIT];
#pragma unroll
          for (int i = 0; i < NIT; ++i) { const int k = tid + NWAVES * 64 * i, ui = k / 257, r = k - ui * 257, idx = ui * G + vcu; const bool in = k < MOE2_MAXU * 257 && idx < 4 * ntiles;
              const int t = tile[in ? (idx >> 2) : 0], e = t & 0xffff, slot = ((t >> 16) & 0xff) * 256 + r;
              ent0[i] = (in && r == 256) ? (unsigned)t : 0xffffffffu; ok[i] = in && r < 256 && slot < scnt[e];
              pr[i] = ok[i] ? LIST[(size_t)e * M + slot] : 0; }
#pragma unroll
          for (int i = 0; i < NIT; ++i) pwt[i] = ok[i] ? PAIRW[pr[i]] : 0.f;
#pragma unroll
          for (int i = 0; i < NIT; ++i) { const int k = tid + NWAVES * 64 * i;
              if (k < MOE2_MAXU * 257) utab[k] = ok[i] ? (((unsigned)pr[i] << 15) | ((unsigned)__builtin_bit_cast(unsigned short, (_Float16)pwt[i]) & 0x7fffu)) : ent0[i]; } }
        __syncthreads();
        MoeOrder2 S{(const char*)(ws + WS_HE), (const char*)(ws + WS_WED), utab, ntiles, G, vcu};
        EpiMoe2 E{a, utab};
        pg8::gemm_phase<EpiMoe2, MoeOrder2, true>(lds, pg8::GemmDesc{256, 256, 256}, S, E, wave);
    }
    SEAM(12);
    if (IN(13)) { PHASE_BEGIN final_rows(a, gw, NGW, lane); }
#if MK_N_LAUNCHES == 0 && defined(MK_PROBE_S3)
    if (IN(14)) { PHASE_BEGIN for (int u = bx; u < 512; u += G) ssd_s3_unit_t<MK_PROBE_S3>(a, u, lds, tid, wave, lane); }
#endif
#if MK_N_LAUNCHES == 0 && defined(MK_PROBE_COMB)
    if (IN(14)) { PHASE_BEGIN attn_combine(a, 0.5f, gw, NGW, lane); }
#endif
#if MK_N_LAUNCHES == 0 && defined(MK_PROBE_ROUTE)
    if (IN(14)) { PHASE_BEGIN route_tokens_t<true>(a, ctl, gw, NGW, lane); }
#endif
#if MK_N_LAUNCHES == 0 && defined(MK_PROBE_FINAL)
    if (IN(14)) { PHASE_BEGIN final_rows_t<true>(a, gw, NGW, lane); }
#endif
#if MK_N_LAUNCHES == 0 && defined(MK_PROBE_GEMM)
    if (IN(14)) { PHASE_BEGIN
        pg8::GridOrder S; S.init(ws + WS_WEGU, ws + WS_WIN, 1024, 1024, M, NIN, G, bx);
        EpiStore E{a, WS_Q, NIN};
        pg8::gemm_phase<EpiStore, pg8::GridOrder, true>(lds, pg8::GemmDesc{1024, 1024, 1024}, S, E, wave);
    }
#endif
#undef IN
#undef SEAM
}

extern "C" void kernel_launch(void* const* d_in, const int* in_sizes, int n_in, void* d_out, int out_size, void* d_ws, size_t ws_size, hipStream_t stream) {
    static int grid = 0;
    if (grid == 0) {
        if (n_in != 32 || out_size != M * D || ws_size < WS_END) { fprintf(stderr, "kernel_launch: unexpected shapes (n_in %d out %d ws %zu)\n", n_in, out_size, ws_size); grid = -1; return; }
        int dev = 0, cus = 0, per_cu = 0;
        if (hipGetDevice(&dev) != hipSuccess || hipDeviceGetAttribute(&cus, hipDeviceAttributeMultiprocessorCount, dev) != hipSuccess) { grid = -1; return; }
        if (hipFuncSetAttribute((const void*)mega, hipFuncAttributeMaxDynamicSharedMemorySize, LDS_BYTES) != hipSuccess) { fprintf(stderr, "kernel_launch: hipFuncSetAttribute failed\n"); grid = -1; return; }
        if (hipOccupancyMaxActiveBlocksPerMultiprocessor(&per_cu, (const void*)mega, NWAVES * 64, LDS_BYTES) != hipSuccess || per_cu < 1) { fprintf(stderr, "kernel_launch: occupancy query says %d\n", per_cu); (void)hipGetLastError(); grid = -1; return; }
        grid = cus;
    }
    if (grid < 0) return;
    (void)hipMemsetAsync((char*)d_ws + WS_CTL, 0, CTL_ZERO_BYTES, stream);
    Args a{};
    for (int i = 0; i < 32; ++i) a.in[i] = d_in[i];
    a.out = (float*)d_out; a.ws = (unsigned char*)d_ws; a.G = grid;
#if MK_N_LAUNCHES == 1
    a.ph_lo = 0; a.ph_hi = NPHASE;
    hipLaunchKernelGGL(mega, dim3(grid), dim3(NWAVES * 64), LDS_BYTES, stream, a);
#else
    for (int p = 0; p < NPHASE; ++p) { a.ph_lo = p; a.ph_hi = p + 1; for (int r = 0; r < 1 + ((MK_DUPMASK >> p) & 1); ++r) hipLaunchKernelGGL(mega, dim3(grid), dim3(NWAVES * 64), LDS_BYTES, stream, a); }
#if defined(MK_PROBE_GEMM) || defined(MK_PROBE_S3) || defined(MK_PROBE_COMB) || defined(MK_PROBE_ROUTE) || defined(MK_PROBE_FINAL)
    a.ph_lo = 14; a.ph_hi = 15; hipLaunchKernelGGL(mega, dim3(grid), dim3(NWAVES * 64), LDS_BYTES, stream, a);
#endif
#endif
}
```
